# Optimizing an MI355X kernel written in HIP

```python
import jax, jax.numpy as jnp
from jax import lax
import numpy as np

D_MODEL = 1024
BATCH = 2
SEQ = 8192
DEPTH = 4

N_MIXERS = 3
HEAD_DIM = 64
MEM_TOKENS = 256
MEM_HEADS = 4
MEM_HEAD_DIM = D_MODEL // 16
MEM_WIDTH = MEM_HEADS * MEM_HEAD_DIM
MIX_WIDTH = D_MODEL - MEM_WIDTH
RMS_EPS = 1e-6
NEG_INF = -1e30

SWA_Q_HEADS = MIX_WIDTH // HEAD_DIM
SWA_KV_HEADS = 4
SWA_GROUP = SWA_Q_HEADS // SWA_KV_HEADS
SWA_WINDOW = 128
SWA_BLOCK = 128
SWA_IN_SIZES = (SWA_Q_HEADS * HEAD_DIM, SWA_KV_HEADS * HEAD_DIM, SWA_KV_HEADS * HEAD_DIM, MEM_WIDTH)

RET_HEADS = 6
RET_QK_DIM = 64
RET_V_DIM = MIX_WIDTH // RET_HEADS
RET_CHUNK = 128
RET_IN_SIZES = (RET_HEADS * RET_QK_DIM, RET_HEADS * RET_QK_DIM, MIX_WIDTH, MIX_WIDTH, MEM_WIDTH)

MLSTM_HEADS = 4
MLSTM_V_DIM = MIX_WIDTH // MLSTM_HEADS
MLSTM_QK_DIM = MLSTM_V_DIM // 2
MLSTM_CHUNK = 128
MLSTM_CONV = 4
MLSTM_IN_SIZES = (2 * MLSTM_HEADS * MLSTM_QK_DIM, MIX_WIDTH, MIX_WIDTH, MLSTM_HEADS, MLSTM_HEADS, MEM_WIDTH)

FFN_DIM = 7 * D_MODEL // 2
N_EXPERTS = 8
TOP_K = 2

N_SWA_LAYERS = (DEPTH + 2) // 3
N_RET_LAYERS = (DEPTH + 1) // 3
N_MLSTM_LAYERS = DEPTH // 3
N_DENSE_LAYERS = (DEPTH + 1) // 2
N_MOE_LAYERS = DEPTH // 2

kernel_name = "hybrid_swa_retention_mlstm_moe_trunk"


def rmsnorm(x, gain=None, eps=RMS_EPS):
    xf = x.astype(jnp.float32)
    y = xf * lax.rsqrt(jnp.mean(xf * xf, axis=-1, keepdims=True) + eps)
    if gain is not None:
        y = y * gain.astype(jnp.float32)
    return y.astype(x.dtype)


def split_cols(p, sizes):
    out, start = [], 0
    for s in sizes:
        out.append(p[..., start:start + s])
        start += s
    return out


def to_chunks(t, L):
    B, S, H, d = t.shape
    return t.reshape(B, S // L, L, H, d).transpose(1, 0, 3, 2, 4)


def from_chunks(t):
    NC, B, H, L, d = t.shape
    return t.transpose(1, 0, 3, 2, 4).reshape(B, NC * L, H, d)


def alibi_slopes(n):
    return jnp.exp2(-8.0 * jnp.arange(1, n + 1, dtype=jnp.float32) / n)


def swiglu(x, w_gate, w_up, w_down):
    return (jax.nn.silu(x @ w_gate) * (x @ w_up)) @ w_down


def causal_depthwise_conv(x, w, b):
    K, C = w.shape
    y = lax.conv_general_dilated(x, w[:, None, :].astype(x.dtype), window_strides=(1,),
                                 padding=[(K - 1, 0)], dimension_numbers=('NWC', 'WIO', 'NWC'),
                                 feature_group_count=C)
    return y + b.astype(x.dtype)


def sliding_window_attention(q, k, v, sink):
    B, S = q.shape[0], q.shape[1]
    L = SWA_BLOCK
    nb = S // L
    qb = q.reshape(B, nb, L, SWA_KV_HEADS, SWA_GROUP, HEAD_DIM)
    kb = k.reshape(B, nb, L, SWA_KV_HEADS, HEAD_DIM)
    vb = v.reshape(B, nb, L, SWA_KV_HEADS, HEAD_DIM)

    def band(t):
        prev = jnp.pad(t[:, :-1], ((0, 0), (1, 0), (0, 0), (0, 0), (0, 0)))
        return jnp.concatenate([prev, t], axis=2)

    kw, vw = band(kb), band(vb)
    scores = jnp.einsum('bnqhgd,bnkhd->bnhgqk', qb, kw).astype(jnp.float32) * (HEAD_DIM ** -0.5)
    qpos = jnp.arange(L) + L
    kpos = jnp.arange(2 * L)
    dist = qpos[:, None] - kpos[None, :]
    in_window = (dist >= 0) & (dist < SWA_WINDOW)
    has_prev = (jnp.arange(nb)[:, None, None] > 0) | (kpos[None, None, :] >= L)
    mask = in_window[None] & has_prev
    slopes = alibi_slopes(SWA_Q_HEADS).reshape(SWA_KV_HEADS, SWA_GROUP)
    scores = scores - slopes[:, :, None, None] * jnp.abs(dist).astype(jnp.float32)
    scores = jnp.where(mask[None, :, None, None], scores, NEG_INF)
    sink_logit = jnp.broadcast_to(sink.astype(jnp.float32).reshape(SWA_KV_HEADS, SWA_GROUP, 1, 1),
                                  scores.shape[:-1] + (1,))
    probs = jax.nn.softmax(jnp.concatenate([scores, sink_logit], axis=-1), axis=-1)[..., :-1]
    out = jnp.einsum('bnhgqk,bnkhd->bnqhgd', probs.astype(v.dtype), vw)
    return out.reshape(B, S, SWA_Q_HEADS * HEAD_DIM)


def memory_attention(qm, mk, mv):
    s = jnp.einsum('bshd,bmhd->bhsm', qm, mk).astype(jnp.float32) * (MEM_HEAD_DIM ** -0.5)
    p = jax.nn.softmax(s, axis=-1).astype(mv.dtype)
    out = jnp.einsum('bhsm,bmhd->bshd', p, mv)
    return out.reshape(qm.shape[0], qm.shape[1], MEM_WIDTH)


def retention_chunkwise(q, k, v):
    B, S, H, dk = q.shape
    dv = v.shape[-1]
    L = RET_CHUNK
    f32 = jnp.float32
    log_gamma = jnp.log1p(-jnp.exp2(-5.0 - jnp.arange(H, dtype=f32)))
    pos = jnp.arange(L, dtype=f32)
    rel = pos[:, None] - pos[None, :]
    intra_decay = jnp.exp(jnp.where(rel >= 0, log_gamma[:, None, None] * rel, -jnp.inf))
    q_decay = jnp.exp(log_gamma[:, None] * (pos + 1.0))[..., None]
    k_decay = jnp.exp(log_gamma[:, None] * (L - 1.0 - pos))[..., None]
    chunk_decay = jnp.exp(log_gamma * L)[:, None, None]
    qc = to_chunks(q.astype(f32), L)
    kc = to_chunks(k.astype(f32) * (dk ** -0.5), L)
    vc = to_chunks(v.astype(f32), L)

    def step(state, xs):
        qi, ki, vi = xs
        s = jnp.einsum('bhid,bhjd->bhij', qi, ki) * intra_decay
        o = jnp.einsum('bhij,bhjv->bhiv', s, vi) + jnp.einsum('bhid,bhdv->bhiv', qi, state) * q_decay
        state = state * chunk_decay + jnp.einsum('bhjd,bhjv->bhdv', ki * k_decay, vi)
        return state, o

    _, o = lax.scan(step, jnp.zeros((B, H, dk, dv), f32), (qc, kc, vc))
    return from_chunks(o)


def mlstm_chunkwise(q, k, v, log_i, log_f):
    B, S, H, dk = q.shape
    dv = v.shape[-1]
    L = MLSTM_CHUNK
    f32 = jnp.float32
    qc = to_chunks(q.astype(f32), L)
    kc = to_chunks(k.astype(f32) * (dk ** -0.5), L)
    vc = to_chunks(v.astype(f32), L)
    lic = to_chunks(log_i[..., None], L)[..., 0]
    lfc = to_chunks(log_f[..., None], L)[..., 0]
    pos = jnp.arange(L)
    causal = pos[:, None] >= pos[None, :]

    def step(carry, xs):
        C, n, m = carry
        qi, ki, vi, li, lf = xs
        b = jnp.cumsum(lf, axis=-1)
        g = b[..., -1]
        D = jnp.where(causal, b[..., :, None] - b[..., None, :] + li[..., None, :], -jnp.inf)
        inter_log = b + m[..., None]
        m_t = jnp.maximum(inter_log, jnp.max(D, axis=-1))
        w = jnp.exp(D - m_t[..., None])
        a = jnp.exp(inter_log - m_t)
        s = jnp.einsum('bhid,bhjd->bhij', qi, ki) * w
        num = jnp.einsum('bhij,bhjv->bhiv', s, vi) + a[..., None] * jnp.einsum('bhid,bhdv->bhiv', qi, C)
        den = jnp.sum(s, axis=-1) + a * jnp.einsum('bhid,bhd->bhi', qi, n)
        h = num / jnp.maximum(jnp.abs(den), jnp.exp(-m_t))[..., None]
        u = g[..., None] - b + li
        m_new = jnp.maximum(g + m, jnp.max(u, axis=-1))
        wk = jnp.exp(u - m_new[..., None])[..., None]
        decay = jnp.exp(g + m - m_new)
        C = decay[..., None, None] * C + jnp.einsum('bhjd,bhjv->bhdv', ki * wk, vi)
        n = decay[..., None] * n + jnp.sum(ki * wk, axis=2)
        return (C, n, m_new), h

    init = (jnp.zeros((B, H, dk, dv), f32), jnp.zeros((B, H, dk), f32), jnp.zeros((B, H), f32))
    _, h = lax.scan(step, init, (qc, kc, vc, lic, lfc))
    return from_chunks(h)


def moe_ffn(x, router, w_gate, w_up, w_down):
    B, S, D = x.shape
    xt = x.reshape(B * S, D)
    logits = (xt @ router).astype(jnp.float32)
    top_v, top_i = lax.top_k(logits, TOP_K)
    top_w = jax.nn.softmax(top_v, axis=-1)
    gates = jnp.sum(jax.nn.one_hot(top_i, N_EXPERTS, dtype=jnp.float32) * top_w[..., None], axis=1)
    gates = gates.astype(x.dtype)
    y = jnp.zeros_like(xt)
    for e in range(N_EXPERTS):
        y = y + gates[:, e:e + 1] * swiglu(xt, w_gate[e], w_up[e], w_down[e])
    return y.reshape(B, S, D)


def setup_inputs(seed: int = 0) -> dict:
    key = jax.random.key(seed)
    keys = iter(jax.random.split(key, 64))
    f32 = jnp.float32

    def nrm(shape, scale):
        return scale * jax.random.normal(next(keys), shape, f32)

    def gain(shape):
        return 1.0 + 0.02 * jax.random.normal(next(keys), shape, f32)

    D = D_MODEL
    swa_in = sum(SWA_IN_SIZES)
    ret_in = sum(RET_IN_SIZES)
    mlstm_in = sum(MLSTM_IN_SIZES)
    f_bias = jnp.broadcast_to(jnp.linspace(3.0, 6.0, MLSTM_HEADS, dtype=f32), (N_MLSTM_LAYERS, MLSTM_HEADS))
    return {
        "x": nrm((BATCH, SEQ, D), 1.0),
        "mem": nrm((BATCH, MEM_TOKENS, D), 1.0),
        "ln_mix": gain((DEPTH, D)),
        "ln_mem": gain((DEPTH, D)),
        "w_mem_kv": nrm((DEPTH, D, 2 * MEM_WIDTH), D ** -0.5),
        "mem_q_gain": gain((DEPTH, MEM_HEAD_DIM)),
        "mem_k_gain": gain((DEPTH, MEM_HEAD_DIM)),
        "w_out": nrm((DEPTH, D, D), 0.5 * D ** -0.5),
        "ln_ffn": gain((DEPTH, D)),
        "swa_w_in": nrm((N_SWA_LAYERS, D, swa_in), D ** -0.5),
        "swa_q_gain": gain((N_SWA_LAYERS, HEAD_DIM)),
        "swa_k_gain": gain((N_SWA_LAYERS, HEAD_DIM)),
        "swa_sink": nrm((N_SWA_LAYERS, SWA_Q_HEADS), 0.5),
        "ret_w_in": nrm((N_RET_LAYERS, D, ret_in), D ** -0.5),
        "mlstm_w_in": nrm((N_MLSTM_LAYERS, D, mlstm_in), D ** -0.5),
        "mlstm_conv_w": nrm((N_MLSTM_LAYERS, MLSTM_CONV, 2 * MLSTM_HEADS * MLSTM_QK_DIM), MLSTM_CONV ** -0.5),
        "mlstm_conv_b": nrm((N_MLSTM_LAYERS, 2 * MLSTM_HEADS * MLSTM_QK_DIM), 0.02),
        "mlstm_i_bias": nrm((N_MLSTM_LAYERS, MLSTM_HEADS), 0.1),
        "mlstm_f_bias": f_bias + nrm((N_MLSTM_LAYERS, MLSTM_HEADS), 0.1),
        "mlstm_out_gain": gain((N_MLSTM_LAYERS, MIX_WIDTH)),
        "ffn_w_gate": nrm((N_DENSE_LAYERS, D, FFN_DIM), D ** -0.5),
        "ffn_w_up": nrm((N_DENSE_LAYERS, D, FFN_DIM), D ** -0.5),
        "ffn_w_down": nrm((N_DENSE_LAYERS, FFN_DIM, D), 0.5 * FFN_DIM ** -0.5),
        "moe_router": nrm((N_MOE_LAYERS, D, N_EXPERTS), D ** -0.5),
        "moe_w_gate": nrm((N_MOE_LAYERS, N_EXPERTS, D, FFN_DIM), D ** -0.5),
        "moe_w_up": nrm((N_MOE_LAYERS, N_EXPERTS, D, FFN_DIM), D ** -0.5),
        "moe_w_down": nrm((N_MOE_LAYERS, N_EXPERTS, FFN_DIM, D), 0.5 * FFN_DIM ** -0.5),
    }


def reference(x, mem, ln_mix, ln_mem, w_mem_kv, mem_q_gain, mem_k_gain, w_out, ln_ffn,
              swa_w_in, swa_q_gain, swa_k_gain, swa_sink,
              ret_w_in,
              mlstm_w_in, mlstm_conv_w, mlstm_conv_b, mlstm_i_bias, mlstm_f_bias, mlstm_out_gain,
              ffn_w_gate, ffn_w_up, ffn_w_down,
              moe_router, moe_w_gate, moe_w_up, moe_w_down):
    B, S, _ = x.shape
    M = mem.shape[1]
    h = x
    for layer in range(DEPTH):
        kind = layer % N_MIXERS
        idx = layer // N_MIXERS
        xn = rmsnorm(h, ln_mix[layer])

        mkv = rmsnorm(mem, ln_mem[layer]) @ w_mem_kv[layer]
        mk = rmsnorm(mkv[..., :MEM_WIDTH].reshape(B, M, MEM_HEADS, MEM_HEAD_DIM), mem_k_gain[layer])
        mv = mkv[..., MEM_WIDTH:].reshape(B, M, MEM_HEADS, MEM_HEAD_DIM)

        if kind == 0:
            q, k, v, qm = split_cols(xn @ swa_w_in[idx], SWA_IN_SIZES)
            q = rmsnorm(q.reshape(B, S, SWA_Q_HEADS, HEAD_DIM), swa_q_gain[idx])
            k = rmsnorm(k.reshape(B, S, SWA_KV_HEADS, HEAD_DIM), swa_k_gain[idx])
            v = v.reshape(B, S, SWA_KV_HEADS, HEAD_DIM)
            mix = sliding_window_attention(q, k, v, swa_sink[idx])
        elif kind == 1:
            q, k, v, g, qm = split_cols(xn @ ret_w_in[idx], RET_IN_SIZES)
            o = retention_chunkwise(q.reshape(B, S, RET_HEADS, RET_QK_DIM),
                                    k.reshape(B, S, RET_HEADS, RET_QK_DIM),
                                    v.reshape(B, S, RET_HEADS, RET_V_DIM))
            o = rmsnorm(o.astype(x.dtype)).reshape(B, S, MIX_WIDTH)
            mix = jax.nn.silu(g) * o
        else:
            qk, v, og, ig, fg, qm = split_cols(xn @ mlstm_w_in[idx], MLSTM_IN_SIZES)
            qk = jax.nn.silu(causal_depthwise_conv(qk, mlstm_conv_w[idx], mlstm_conv_b[idx]))
            q, k = split_cols(qk, (MLSTM_HEADS * MLSTM_QK_DIM, MLSTM_HEADS * MLSTM_QK_DIM))
            log_i = (ig + mlstm_i_bias[idx]).astype(jnp.float32)
            log_f = jax.nn.log_sigmoid((fg + mlstm_f_bias[idx]).astype(jnp.float32))
            hc = mlstm_chunkwise(q.reshape(B, S, MLSTM_HEADS, MLSTM_QK_DIM),
                                 k.reshape(B, S, MLSTM_HEADS, MLSTM_QK_DIM),
                                 v.reshape(B, S, MLSTM_HEADS, MLSTM_V_DIM), log_i, log_f)
            hc = rmsnorm(hc.astype(x.dtype), mlstm_out_gain[idx].reshape(MLSTM_HEADS, MLSTM_V_DIM))
            mix = jax.nn.sigmoid(og) * hc.reshape(B, S, MIX_WIDTH)

        qm = rmsnorm(qm.reshape(B, S, MEM_HEADS, MEM_HEAD_DIM), mem_q_gain[layer])
        mem_out = memory_attention(qm, mk, mv)
        h = h + jnp.concatenate([mix, mem_out], axis=-1) @ w_out[layer]

        hn = rmsnorm(h, ln_ffn[layer])
        j = layer // 2
        if layer % 2 == 0:
            h = h + swiglu(hn, ffn_w_gate[j], ffn_w_up[j], ffn_w_down[j])
        else:
            h = h + moe_ffn(hn, moe_router[j], moe_w_gate[j], moe_w_up[j], moe_w_down[j])
    return h
```

```cpp
#include <hip/hip_runtime.h>
#include <cstdio>
#include <cstdint>
namespace pg8 {
#define PG8_LAS __attribute__((address_space(3)))
typedef unsigned short bf16_t;
typedef short bf16x8 __attribute__((ext_vector_type(8)));
typedef float f32x4 __attribute__((ext_vector_type(4)));
typedef unsigned u32x4 __attribute__((ext_vector_type(4)));
constexpr int BM = 256, BK = 64, HALF = 128, HTB = HALF * BK * 2  , STAGE_BYTES = 8 * HTB, NXCD = 8, WGM = 8;

__host__ __device__ __forceinline__ int lds_byte(int r, int c) { const int st = (r >> 4) * 2 + (c >> 5), rr = r & 15, cc = c & 31, ob = rr * 64 + cc * 2; return st * 1024 + (ob ^ (((ob >> 9) & 1) << 5)); }
__host__ __device__ __forceinline__ void stage_rc(int b, int& R, int& C) { const int st = b / 1024, sb = b % 1024, swz = sb ^ (((sb >> 9) & 1) << 5); R = (st >> 1) * 16 + swz / 64; C = (st & 1) * 32 + (swz % 64) / 2; }
__host__ __device__ __forceinline__ int perm32(int rho) { const int n = rho >> 4, i = rho & 15; return 8 * (i >> 2) + 4 * n + (i & 3); }

struct Unit { int pm, pn; };
struct Gemm { const bf16_t* A; const bf16_t* Bt; int M, N, K; };

struct StaticOrder {
    int nM, nN, nwg, G, c;
    __host__ __device__ void init(int M, int N, int G_, int c_) { nM = M / BM; nN = N / BM; nwg = nM * nN; G = G_; c = c_; }
    __host__ __device__ bool next(int i, Unit& u) const {
        const long L = (long)i * G + c; if (L >= nwg) return false;
        int wgid = (int)L; { const int q = nwg / NXCD, r = nwg % NXCD, xcd = wgid % NXCD, off = wgid / NXCD; wgid = (xcd < r ? xcd * (q + 1) : r * (q + 1) + (xcd - r) * q) + off; }
        const int nig = WGM * nN, gid = wgid / nig, fm = gid * WGM, gsz = (nM - fm) < WGM ? (nM - fm) : WGM;
        u.pm = fm + ((wgid % nig) % gsz); u.pn = (wgid % nig) / gsz; return true;
    }
    __device__ __forceinline__ void a_ready(const Unit&) const {}
    __device__ __forceinline__ void done(const Unit&) const {}
};

__device__ __forceinline__ unsigned cvt_pk_bf16(float lo, float hi) { unsigned r; asm volatile("v_cvt_pk_bf16_f32 %0, %1, %2" : "=v"(r) : "v"(lo), "v"(hi)); return r; }
__device__ __forceinline__ float row_rstd16(const float* SS, int row) {
    const f32x4* p = (const f32x4*)(SS + (size_t)row * 16);
    const f32x4 a = p[0], b = p[1], c = p[2], d = p[3];
    const float s = (((a[0] + a[1]) + (a[2] + a[3])) + ((b[0] + b[1]) + (b[2] + b[3]))) + (((c[0] + c[1]) + (c[2] + c[3])) + ((d[0] + d[1]) + (d[2] + d[3])));
    return 1.0f / sqrtf(s * (1.0f / 1024.0f) + 1e-6f);
}
__device__ __forceinline__ float silu_f(float x) { return x * __builtin_amdgcn_rcpf(1.0f + __expf(-x)); }

struct EpiPlainBf16 {
    static constexpr bool PERM = true, AFTER_DRAIN = false;
    bf16_t* O; int ldc;
    __device__ __forceinline__ void operator()(const f32x4 (&acc)[2][2][4][2], const Unit& u, int wr, int wc, int fr, int fq) const {
        const int row0 = u.pm * BM + wr * 64 + fr, col0 = u.pn * BM + wc * 32 + 8 * fq;
#pragma unroll
        for (int ai = 0; ai < 2; ++ai)
#pragma unroll
            for (int m = 0; m < 4; ++m) { bf16_t* rowp = O + (size_t)(row0 + ai * HALF + m * 16) * ldc + col0;
#pragma unroll
                for (int bj = 0; bj < 2; ++bj) { const f32x4 v0 = acc[ai][bj][m][0], v1 = acc[ai][bj][m][1];
                    u32x4 w; w.x = cvt_pk_bf16(v0[0], v0[1]); w.y = cvt_pk_bf16(v0[2], v0[3]); w.z = cvt_pk_bf16(v1[0], v1[1]); w.w = cvt_pk_bf16(v1[2], v1[3]);
                    *(u32x4*)(rowp + bj * HALF) = w; } }
    }
};
struct EpiScaleBf16 {
    static constexpr bool PERM = true, AFTER_DRAIN = false;
    bf16_t* O; int ldc; const float* SS;
    __device__ __forceinline__ void operator()(const f32x4 (&acc)[2][2][4][2], const Unit& u, int wr, int wc, int fr, int fq) const {
        const int row0 = u.pm * BM + wr * 64 + fr, col0 = u.pn * BM + wc * 32 + 8 * fq;
#pragma unroll
        for (int ai = 0; ai < 2; ++ai)
#pragma unroll
            for (int m = 0; m < 4; ++m) { const int row = row0 + ai * HALF + m * 16; const float sc = row_rstd16(SS, row); bf16_t* rowp = O + (size_t)row * ldc + col0;
#pragma unroll
                for (int bj = 0; bj < 2; ++bj) { const f32x4 v0 = acc[ai][bj][m][0] * sc, v1 = acc[ai][bj][m][1] * sc;
                    u32x4 w; w.x = cvt_pk_bf16(v0[0], v0[1]); w.y = cvt_pk_bf16(v0[2], v0[3]); w.z = cvt_pk_bf16(v1[0], v1[1]); w.w = cvt_pk_bf16(v1[2], v1[3]);
                    *(u32x4*)(rowp + bj * HALF) = w; } }
    }
};
struct EpiResid {
    static constexpr bool PERM = true, AFTER_DRAIN = false;
    float* H; bf16_t* HB; float* SS;
    __device__ __forceinline__ void operator()(const f32x4 (&acc)[2][2][4][2], const Unit& u, int wr, int wc, int fr, int fq) const {
        const int row0 = u.pm * BM + wr * 64 + fr, col0 = u.pn * BM + wc * 32 + 8 * fq;
#pragma unroll
        for (int ai = 0; ai < 2; ++ai)
#pragma unroll
            for (int m = 0; m < 4; ++m) { const int row = row0 + ai * HALF + m * 16; float* hp = H + (size_t)row * 1024 + col0; bf16_t* bp = HB + (size_t)row * 1024 + col0; float ss = 0.f;
#pragma unroll
                for (int bj = 0; bj < 2; ++bj) { f32x4 h0 = *(const f32x4*)(hp + bj * HALF), h1 = *(const f32x4*)(hp + bj * HALF + 4);
                    h0 = h0 + acc[ai][bj][m][0]; h1 = h1 + acc[ai][bj][m][1];
                    *(f32x4*)(hp + bj * HALF) = h0; *(f32x4*)(hp + bj * HALF + 4) = h1;
                    ss += ((h0[0] * h0[0] + h0[1] * h0[1]) + (h0[2] * h0[2] + h0[3] * h0[3])) + ((h1[0] * h1[0] + h1[1] * h1[1]) + (h1[2] * h1[2] + h1[3] * h1[3]));
                    u32x4 w; w.x = cvt_pk_bf16(h0[0], h0[1]); w.y = cvt_pk_bf16(h0[2], h0[3]); w.z = cvt_pk_bf16(h1[0], h1[1]); w.w = cvt_pk_bf16(h1[2], h1[3]);
                    *(u32x4*)(bp + bj * HALF) = w; }
                ss += __shfl_xor(ss, 16); ss += __shfl_xor(ss, 32);
                if (fq == 0) SS[(size_t)row * 16 + u.pn * 4 + wc] = ss; }
    }
};
template <bool MOE> struct EpiSwiglu {
    static constexpr bool PERM = true, AFTER_DRAIN = false;
    bf16_t* O; const float* RS;
    __device__ __forceinline__ void operator()(const f32x4 (&acc)[2][2][4][2], const Unit& u, int wr, int wc, int fr, int fq) const {
        const int pnl = MOE ? (u.pn % 28) : u.pn;
        const int row0 = u.pm * BM + wr * 64 + fr, col0 = pnl * HALF + wc * 32 + 8 * fq;
#pragma unroll
        for (int ai = 0; ai < 2; ++ai)
#pragma unroll
            for (int m = 0; m < 4; ++m) { const int row = row0 + ai * HALF + m * 16; const float sc = MOE ? RS[row] : row_rstd16(RS, row);
                const f32x4 g0 = acc[ai][0][m][0] * sc, g1 = acc[ai][0][m][1] * sc, u0 = acc[ai][1][m][0] * sc, u1 = acc[ai][1][m][1] * sc;
                u32x4 w;
                w.x = cvt_pk_bf16(silu_f(g0[0]) * u0[0], silu_f(g0[1]) * u0[1]); w.y = cvt_pk_bf16(silu_f(g0[2]) * u0[2], silu_f(g0[3]) * u0[3]);
                w.z = cvt_pk_bf16(silu_f(g1[0]) * u1[0], silu_f(g1[1]) * u1[1]); w.w = cvt_pk_bf16(silu_f(g1[2]) * u1[2], silu_f(g1[3]) * u1[3]);
                *(u32x4*)(O + (size_t)row * 3584 + col0) = w; }
    }
};
struct EpiYF32 {
    static constexpr bool PERM = true, AFTER_DRAIN = false;
    float* Y;
    __device__ __forceinline__ void operator()(const f32x4 (&acc)[2][2][4][2], const Unit& u, int wr, int wc, int fr, int fq) const {
        const int pnl = u.pn & 3;
        const int row0 = u.pm * BM + wr * 64 + fr, col0 = pnl * BM + wc * 32 + 8 * fq;
#pragma unroll
        for (int ai = 0; ai < 2; ++ai)
#pragma unroll
            for (int m = 0; m < 4; ++m) { float* yp = Y + (size_t)(row0 + ai * HALF + m * 16) * 1024 + col0;
#pragma unroll
                for (int bj = 0; bj < 2; ++bj) { *(f32x4*)(yp + bj * HALF) = acc[ai][bj][m][0]; *(f32x4*)(yp + bj * HALF + 4) = acc[ai][bj][m][1]; } }
    }
};
struct MoeOrder {
    StaticOrder so; const int* panel_e; int ntn;
    __device__ void init(const int* np_ptr, const int* panel_e_, int ntn_, int G, int c) { const int np = __builtin_amdgcn_readfirstlane(*np_ptr); so.init(np * BM, ntn_ * BM, G, c); panel_e = panel_e_; ntn = ntn_; }
    __device__ bool next(int i, Unit& u) const { if (!so.next(i, u)) return false; const int e = __builtin_amdgcn_readfirstlane(panel_e[u.pm]); u.pn += e * ntn; return true; }
    __device__ __forceinline__ void a_ready(const Unit&) const {}
    __device__ __forceinline__ void done(const Unit&) const {}
};
template <class Epi, class Sched, bool ALIGN_EPI = false, bool SP2 = false>
__device__ __forceinline__ void gemm_phase(PG8_LAS unsigned char* lds, const Gemm g, const Sched& S, const Epi& E) {
    const int tid = threadIdx.x, wid = __builtin_amdgcn_readfirstlane(tid >> 6), lane = tid & 63, wr = wid >> 2, wc = wid & 3, fr = lane & 15, fq = lane >> 4;
    const int K = g.K, nt = K / BK;
    unsigned voffA[2], voffB[2];
#pragma unroll
    for (int i = 0; i < 2; ++i) { int R, C; stage_rc(tid * 16 + i * 8192, R, C); const int Rb = Epi::PERM ? ((R & ~31) + perm32(R & 31)) : R;
        voffA[i] = (unsigned)(R * K + C) * 2u; voffB[i] = (unsigned)(Rb * K + C) * 2u; }
    const size_t kstep = (size_t)(BK * 2);
    const size_t hstep = (size_t)HALF * K * 2;
    const size_t tstep = 2 * hstep;
    const unsigned ldsw = (unsigned)wid * 1024u;
    const int aoff = lds_byte(wr * 64 + fr, fq * 8), boff = lds_byte(wc * 32 + fr, fq * 8);
#define PG8_SA(b, h) (((b) * 2 + (h)) * HTB)
#define PG8_SB(b, h) ((4 + (b) * 2 + (h)) * HTB)
#define PG8_STAGE(bufoff, gbase, voff) do { _Pragma("unroll") for (int _i = 0; _i < 2; ++_i) \
        __builtin_amdgcn_global_load_lds((const unsigned*)((const char*)(gbase) + (voff)[_i]), (PG8_LAS unsigned*)(lds + (bufoff) + ldsw + _i * 8192), 16, 0, 0); } while (0)
#define PG8_LDA(dst, b, h) do { _Pragma("unroll") for (int m = 0; m < 4; ++m) _Pragma("unroll") for (int k = 0; k < 2; ++k) dst[m][k] = *(const PG8_LAS bf16x8*)(lds + PG8_SA(b, h) + aoff + m * 2048 + k * 1024); } while (0)
#define PG8_LDB(dst, b, h) do { _Pragma("unroll") for (int n = 0; n < 2; ++n) _Pragma("unroll") for (int k = 0; k < 2; ++k) dst[n][k] = *(const PG8_LAS bf16x8*)(lds + PG8_SB(b, h) + boff + n * 2048 + k * 1024); } while (0)
#define PG8_MMA(ai, bj, At, Bt) do { __builtin_amdgcn_s_setprio(1); _Pragma("unroll") for (int m = 0; m < 4; ++m) _Pragma("unroll") for (int n = 0; n < 2; ++n) _Pragma("unroll") for (int k = 0; k < 2; ++k) \
        acc[ai][bj][m][n] = __builtin_amdgcn_mfma_f32_16x16x32_bf16(Bt[n][k], At[m][k], acc[ai][bj][m][n], 0, 0, 0); __builtin_amdgcn_s_setprio(0); } while (0)
#define PG8_WAIT_V(n) asm volatile("s_waitcnt vmcnt(" #n ")" ::: "memory")
#define PG8_WAIT_L(n) asm volatile("s_waitcnt lgkmcnt(" #n ")" ::: "memory")
#define PG8_BAR __builtin_amdgcn_s_barrier()
#define PG8_SCHED __builtin_amdgcn_sched_barrier(0)
    Unit cur, nxt; int ui = 0;
    if (!S.next(0, cur)) return;
    f32x4 acc[2][2][4][2];
#pragma unroll
    for (int a = 0; a < 2; ++a)
#pragma unroll
        for (int b = 0; b < 2; ++b)
#pragma unroll
            for (int m = 0; m < 4; ++m)
#pragma unroll
                for (int n = 0; n < 2; ++n) acc[a][b][m][n] = (f32x4){0.f, 0.f, 0.f, 0.f};
    bf16x8 At[4][2], B0[2][2], B1[2][2];
    const char* cA = (const char*)g.A + (size_t)cur.pm * tstep; const char* cB = (const char*)g.Bt + (size_t)cur.pn * tstep;
    S.a_ready(cur);
    if constexpr (SP2) {
        PG8_STAGE(PG8_SB(0, 0), cB, voffB); PG8_STAGE(PG8_SB(0, 1), cB + hstep, voffB); PG8_STAGE(PG8_SA(0, 0), cA, voffA); PG8_STAGE(PG8_SA(0, 1), cA + hstep, voffA);
        if (wr == 1) PG8_BAR;
        PG8_WAIT_V(2); PG8_BAR;
        PG8_STAGE(PG8_SB(1, 0), cB + kstep, voffB); PG8_STAGE(PG8_SA(1, 0), cA + kstep, voffA); PG8_STAGE(PG8_SB(1, 1), cB + hstep + kstep, voffB);
        PG8_WAIT_V(6); PG8_BAR;
    } else {
        PG8_STAGE(PG8_SB(0, 0), cB, voffB); PG8_STAGE(PG8_SA(0, 0), cA, voffA); PG8_STAGE(PG8_SB(0, 1), cB + hstep, voffB); PG8_STAGE(PG8_SA(0, 1), cA + hstep, voffA);
        if (wr == 1) PG8_BAR;
        PG8_WAIT_V(4); PG8_BAR;
        PG8_STAGE(PG8_SB(1, 0), cB + kstep, voffB); PG8_STAGE(PG8_SA(1, 0), cA + kstep, voffA); PG8_STAGE(PG8_SB(1, 1), cB + hstep + kstep, voffB);
        PG8_WAIT_V(6); PG8_BAR;
    }
    for (;;) {
        const bool has_next = S.next(ui + 1, nxt);
        const char* nA = has_next ? (const char*)g.A + (size_t)nxt.pm * tstep : cA; const char* nB = has_next ? (const char*)g.Bt + (size_t)nxt.pn * tstep : cB;
        for (int t = 0; t < nt; t += 2) {
            const bool last = (t == nt - 2);
            const char* a1 = cA + (size_t)(t + 1) * kstep;
            const char* a2 = last ? nA : cA + (size_t)(t + 2) * kstep; const char* b2 = last ? nB : cB + (size_t)(t + 2) * kstep;
            const char* a3 = a2 + kstep; const char* b3 = b2 + kstep;
            if (last && has_next) S.a_ready(nxt);
            if constexpr (SP2) {
            PG8_LDB(B0, 0, 0); PG8_LDB(B1, 0, 1); PG8_SCHED; PG8_LDA(At, 0, 0); PG8_STAGE(PG8_SA(1, 1), a1 + hstep, voffA);
            PG8_WAIT_V(8); PG8_WAIT_L(0); PG8_BAR; PG8_MMA(0, 0, At, B0); PG8_MMA(0, 1, At, B1); PG8_BAR; PG8_SCHED;
            PG8_LDA(At, 0, 1); PG8_STAGE(PG8_SB(0, 0), b2, voffB); PG8_STAGE(PG8_SB(0, 1), b2 + hstep, voffB); PG8_STAGE(PG8_SA(0, 0), a2, voffA);
            PG8_WAIT_V(8); PG8_WAIT_L(0); PG8_BAR; PG8_MMA(1, 0, At, B0); PG8_MMA(1, 1, At, B1); PG8_BAR; PG8_SCHED;
            PG8_LDB(B0, 1, 0); PG8_LDB(B1, 1, 1); PG8_SCHED; PG8_LDA(At, 1, 0); PG8_STAGE(PG8_SA(0, 1), a2 + hstep, voffA);
            PG8_WAIT_V(8); PG8_WAIT_L(0); PG8_BAR; PG8_MMA(0, 0, At, B0); PG8_MMA(0, 1, At, B1); PG8_BAR; PG8_SCHED;
            PG8_LDA(At, 1, 1); PG8_STAGE(PG8_SB(1, 0), b3, voffB); PG8_STAGE(PG8_SB(1, 1), b3 + hstep, voffB); PG8_STAGE(PG8_SA(1, 0), a3, voffA);
            PG8_WAIT_V(8); PG8_WAIT_L(0); PG8_BAR; PG8_MMA(1, 0, At, B0); PG8_MMA(1, 1, At, B1); PG8_BAR; PG8_SCHED;
            } else {
            PG8_LDB(B0, 0, 0); PG8_SCHED; PG8_LDA(At, 0, 0); PG8_STAGE(PG8_SA(1, 1), a1 + hstep, voffA);
            PG8_WAIT_L(8); PG8_BAR; PG8_WAIT_L(0); PG8_MMA(0, 0, At, B0); PG8_BAR; PG8_SCHED;
            PG8_LDB(B1, 0, 1); PG8_STAGE(PG8_SB(0, 0), b2, voffB);
            PG8_BAR; PG8_WAIT_L(0); PG8_MMA(0, 1, At, B1); PG8_BAR;
            PG8_LDA(At, 0, 1); PG8_STAGE(PG8_SA(0, 0), a2, voffA);
            PG8_BAR; PG8_WAIT_L(0); PG8_MMA(1, 0, At, B0); PG8_BAR; PG8_SCHED;
            PG8_STAGE(PG8_SB(0, 1), b2 + hstep, voffB);
            PG8_WAIT_V(6); PG8_BAR; PG8_MMA(1, 1, At, B1); PG8_BAR;
            PG8_LDB(B0, 1, 0); PG8_SCHED; PG8_LDA(At, 1, 0); PG8_STAGE(PG8_SA(0, 1), a2 + hstep, voffA);
            PG8_WAIT_L(8); PG8_BAR; PG8_WAIT_L(0); PG8_MMA(0, 0, At, B0); PG8_BAR; PG8_SCHED;
            PG8_LDB(B1, 1, 1); PG8_STAGE(PG8_SB(1, 0), b3, voffB);
            PG8_BAR; PG8_WAIT_L(0); PG8_MMA(0, 1, At, B1); PG8_BAR;
            PG8_LDA(At, 1, 1); PG8_STAGE(PG8_SA(1, 0), a3, voffA);
            PG8_BAR; PG8_WAIT_L(0); PG8_MMA(1, 0, At, B0); PG8_BAR; PG8_SCHED;
            PG8_STAGE(PG8_SB(1, 1), b3 + hstep, voffB);
            PG8_WAIT_V(6); PG8_BAR; PG8_MMA(1, 1, At, B1); PG8_BAR;
            }
        }
        if constexpr (ALIGN_EPI) { if (wr == 0) PG8_BAR; }
        if constexpr (!Epi::AFTER_DRAIN) { E(acc, cur, wr, wc, fr, fq); S.done(cur); }
        if (!has_next) break;
#pragma unroll
        for (int a = 0; a < 2; ++a)
#pragma unroll
            for (int b = 0; b < 2; ++b)
#pragma unroll
                for (int m = 0; m < 4; ++m)
#pragma unroll
                    for (int n = 0; n < 2; ++n) acc[a][b][m][n] = (f32x4){0.f, 0.f, 0.f, 0.f};
        cur = nxt; cA = nA; cB = nB; ++ui;
        if constexpr (ALIGN_EPI) { if (wr == 1) PG8_BAR; }
    }
    PG8_WAIT_V(0);
    if constexpr (!ALIGN_EPI) { if (wr == 0) PG8_BAR; }
    PG8_BAR;
    if constexpr (Epi::AFTER_DRAIN) { E.fused(acc, cur, wr, wc, fr, fq, lds, wid, lane); S.done(cur); }
#undef PG8_SA
#undef PG8_SB
#undef PG8_STAGE
#undef PG8_LDA
#undef PG8_LDB
#undef PG8_MMA
#undef PG8_WAIT_V
#undef PG8_WAIT_L
#undef PG8_BAR
#undef PG8_SCHED
}
}
constexpr int NWAVES = 8;
constexpr int BATCH = 2, SEQ = 8192, D = 1024, M = BATCH * SEQ, FF = 3584, NE = 8, MEMT = 256, MROWS = BATCH * MEMT;
constexpr int N_SWA = 1536, N_RET = 2560, N_MLS = 2560, MLS_SRC = 2568;
constexpr int MAXSLOT = 2 * M + NE * 256;
constexpr int NPHASE = 30;
#ifndef MK_SINGLE
#define MK_SINGLE 0
#endif
constexpr size_t MiB = 1u << 20, KiB = 1024;
constexpr size_t WS_CTL = 0, CTL_ZERO_BYTES = 1 * MiB;
constexpr size_t WS_SS = 1 * MiB, WS_MEMN = 2 * MiB, WS_MKV = 3 * MiB, WS_ROUTE = 5 * MiB;
constexpr size_t RT_SEL = 0, RT_RSTD = 256 * KiB, RT_CNT = 320 * KiB, RT_PANEL = 328 * KiB, RT_NP = 329 * KiB, RT_TOKSLOT = 384 * KiB, RT_ROWTOK = 512 * KiB, RT_SLOTRS = 704 * KiB, RT_GATES = 1 * MiB;
constexpr size_t WS_WIN = 8 * MiB, WS_WOUT = 24 * MiB, WS_WMEM = 32 * MiB, WS_WFD = 36 * MiB, WS_WMOE = 78 * MiB;
constexpr size_t WIN_OFF[4] = {0, 3 * MiB, 8 * MiB, 13 * MiB};
constexpr size_t FD_STRIDE = 21 * MiB, FD_WD = 14 * MiB, MOE_STRIDE = 168 * MiB, MOE_WD = 112 * MiB;
constexpr size_t WS_HB = 414 * MiB, WS_BIG = 446 * MiB, WS_Y = 684 * MiB, WS_END = 820 * MiB;
constexpr size_t BIG_P = 0, BIG_MIX = 80 * MiB, BIG_SCR1 = 112 * MiB, BIG_SCR2 = 160 * MiB;
constexpr int CW_BAR = 4096;
constexpr int RING_OFF = 0, RING_BYTES = 131072;
constexpr int LDSCTL_OFF = RING_BYTES, MISC_OFF = LDSCTL_OFF + 320;
constexpr int LDS_BYTES = 147456;


#define GAS __attribute__((address_space(1)))
#define LAS __attribute__((address_space(3)))
typedef unsigned short bf16;
typedef unsigned v4u __attribute__((ext_vector_type(4)));
typedef float f32x4 __attribute__((ext_vector_type(4)));
typedef short bf16x8 __attribute__((ext_vector_type(8)));
typedef GAS unsigned gu32;
typedef GAS unsigned long long gu64;
#define RLX_AGENT __ATOMIC_RELAXED, __HIP_MEMORY_SCOPE_AGENT
#define LDS_WAIT() asm volatile("s_waitcnt lgkmcnt(0)" ::: "memory")
#define VM_WAIT() asm volatile("s_waitcnt vmcnt(0)" ::: "memory")
__device__ __forceinline__ unsigned long long rt() { return __builtin_amdgcn_s_memrealtime(); }
__device__ __forceinline__ unsigned f2bf(float f) { unsigned u = __builtin_bit_cast(unsigned, f); return (u + 0x7fffu + ((u >> 16) & 1u)) >> 16; }
__device__ __forceinline__ unsigned pk2(float lo, float hi) { return f2bf(lo) | (f2bf(hi) << 16); }

#define XB_TMO      128
#define XB_XCNT(j)  (256  + 64 * (j))
#define XB_XSUB(j)  (1280 + 64 * (j))
#define XB_XGEN(j)  (2304 + 64 * (j))
#define XB_TOP      3328
#define XB_TOPGEN   3392
#define XCD_BAR_WORDS 3456
#define XB_SPIN_CAP (1u << 18)

__device__ __forceinline__ unsigned xb_ld(unsigned* p)              { return __hip_atomic_load(p, __ATOMIC_RELAXED, __HIP_MEMORY_SCOPE_AGENT); }
__device__ __forceinline__ unsigned xb_add(unsigned* p, unsigned v) { return __hip_atomic_fetch_add(p, v, __ATOMIC_RELAXED, __HIP_MEMORY_SCOPE_AGENT); }
__device__ __forceinline__ unsigned xb_xcc_id() { return (unsigned)__builtin_amdgcn_s_getreg((3 << 11) | 20) & 0xFu; }
#define XB_SPIN(cond, bar) do { unsigned _sp = 0; while (cond) { __builtin_amdgcn_s_sleep(1); \
    if ((++_sp & 255u) == 0u) { if (xb_ld(&(bar)[XB_TMO])) break; if (_sp > XB_SPIN_CAP) { atomicAdd(&(bar)[XB_TMO], 1u); break; } } } } while (0)

struct XcdBarrier {
    unsigned* bar; unsigned x;
    volatile LAS unsigned* st;
};

__device__ __forceinline__ XcdBarrier xcd_barrier_post(unsigned* bar, volatile LAS unsigned* st) {
    XcdBarrier b; b.bar = bar; b.x = xb_xcc_id(); b.st = st;
    if (threadIdx.x == 0) (void)xb_add(&bar[XB_XCNT(b.x)], 1u);
    return b;
}
__device__ __forceinline__ void xcd_barrier_complete(unsigned* bar, unsigned x, unsigned& nloc, unsigned& nx) {
    const unsigned G = gridDim.x * gridDim.y * gridDim.z;
    unsigned sum, cnt, mine, sp = 0u;
    for (;;) {
        sum = 0u; cnt = 0u; mine = 0u;
#pragma unroll
        for (unsigned j = 0; j < 16; ++j) { const unsigned c = xb_ld(&bar[XB_XCNT(j)]); sum += c; cnt += (c > 0u) ? 1u : 0u; mine = (j == x) ? c : mine; }
        if (sum == G) break;
        __builtin_amdgcn_s_sleep(1);
        if ((++sp & 255u) == 0u) { if (xb_ld(&bar[XB_TMO])) break; if (sp > XB_SPIN_CAP) { atomicAdd(&bar[XB_TMO], 1u); break; } }
    }
    nloc = mine > 0u ? mine : 1u; nx = cnt > 0u ? cnt : 1u;
}

__device__ __forceinline__ void xcd_barrier(const XcdBarrier& b) {
    asm volatile("s_waitcnt vmcnt(0)" ::: "memory");
    __syncthreads();
    if (threadIdx.x == 0) {
        unsigned* bar = b.bar;
        __builtin_amdgcn_s_waitcnt(0);
        unsigned nloc = b.st[0], nx = b.st[1];
        if (nloc == 0u) { xcd_barrier_complete(bar, b.x, nloc, nx); b.st[0] = nloc; b.st[1] = nx; }
        const unsigned old = xb_add(&bar[XB_XSUB(b.x)], 1u);
        const unsigned gen = old / nloc;
        if (old + 1u == (gen + 1u) * nloc) {
            __builtin_amdgcn_fence(__ATOMIC_RELEASE, "agent");
            asm volatile("s_waitcnt vmcnt(0)" ::: "memory");
            const unsigned og = xb_add(&bar[XB_TOP], 1u);
            const unsigned tg = og / nx;
            if (og + 1u == (tg + 1u) * nx) xb_add(&bar[XB_TOPGEN], 1u);
            else XB_SPIN(xb_ld(&bar[XB_TOPGEN]) == tg, bar);
            __builtin_amdgcn_fence(__ATOMIC_ACQUIRE, "agent");
            xb_add(&bar[XB_XGEN(b.x)], 1u);
            asm volatile("s_waitcnt vmcnt(0)" ::: "memory");
        } else {
            XB_SPIN(xb_ld(&bar[XB_XGEN(b.x)]) == gen, bar);
            __builtin_amdgcn_fence(__ATOMIC_ACQUIRE, "agent");
            asm volatile("s_waitcnt vmcnt(0)" ::: "memory");
        }
    }
    __syncthreads();
}


typedef unsigned short us16;
__device__ __forceinline__ float bflo(unsigned w) { return __uint_as_float(w << 16); }
__device__ __forceinline__ float bfhi(unsigned w) { return __uint_as_float(w & 0xffff0000u); }
__device__ __forceinline__ float wave_sum(float v) {
#pragma unroll
    for (int o = 1; o < 64; o <<= 1) v += __shfl_xor(v, o);
    return v;
}
__device__ __forceinline__ float silu1(float x) { return x / (1.0f + __expf(-x)); }
__device__ __forceinline__ float sigmoid1(float x) { return 1.0f / (1.0f + __expf(-x)); }

struct Ctx {
    LAS unsigned char* lds;
    int tid, lane, wave, gw, NGW, G, bid;
    const float* in[27];
    float* out;
    unsigned char* ws;
};
#define WSP(T, off) ((T*)(C.ws + (off)))

__device__ __forceinline__ void transpose_item(const float* W, int ldw, int k0, int c0, bf16* WT, int ldt, int drow0, const float* gain, LAS float* scr, int lane) {
#pragma unroll 8
    for (int i = 0; i < 32; ++i) { const int kk = 2 * i + (lane >> 5); const float g = gain ? gain[k0 + kk] : 1.0f; scr[kk * 33 + (lane & 31)] = W[(size_t)(k0 + kk) * ldw + c0 + (lane & 31)] * g; }
    LDS_WAIT(); asm volatile("" ::: "memory");
    const int c = lane & 7;
#pragma unroll
    for (int j = 0; j < 4; ++j) { const int n = (lane >> 3) + 8 * j; const LAS float* s = scr + (8 * c) * 33 + n;
        v4u o; o.x = pk2(s[0 * 33], s[1 * 33]); o.y = pk2(s[2 * 33], s[3 * 33]); o.z = pk2(s[4 * 33], s[5 * 33]); o.w = pk2(s[6 * 33], s[7 * 33]);
        *(GAS v4u*)(WT + (size_t)(drow0 + n) * ldt + k0 + 8 * c) = o; }
    LDS_WAIT(); asm volatile("" ::: "memory");
}
__device__ __forceinline__ void transpose_job(Ctx& C, const float* W, int ldw, int K, int c0, int ncols, bf16* WT, int mode, int drow0, const float* gain, LAS float* scr) {
    const int nblk = ncols / 32, items = (K / 64) * nblk;
    for (int it = C.gw; it < items; it += C.NGW) { const int kb = it / nblk, nb = it % nblk, n0 = nb * 32;
        const int dr = mode ? drow0 + (n0 >> 7) * 256 + (n0 & 127) : drow0 + n0;
        transpose_item(W, ldw, kb * 64, c0 + n0, WT, K, dr, gain, scr, C.lane); }
}
__device__ __forceinline__ void p_prologue(Ctx& C) {
    LAS float* scr = (LAS float*)(C.lds + RING_OFF + C.wave * 16384);
    {
        constexpr int IT = 1792, NJOB = 6 + 48;
        for (int it = C.gw; it < NJOB * IT; it += C.NGW) {
            const int job = it / IT, r = it % IT;
            const float* W; bf16* WT; const float* gain = nullptr; int which, ldw, K;
            if (job < 6) { const int j = job / 3; which = job % 3; const int layer = 2 * j;
                unsigned char* base = C.ws + WS_WFD + j * FD_STRIDE;
                if (which < 2) { W = (which == 0 ? C.in[20] : C.in[21]) + (size_t)j * D * FF; WT = (bf16*)base; gain = C.in[8] + layer * D; ldw = FF; K = D; }
                else { W = C.in[22] + (size_t)j * FF * D; WT = (bf16*)(base + FD_WD); ldw = D; K = FF; }
            } else { const int q = job - 6, j = q / 24, e = (q % 24) / 3; which = q % 3; const int layer = 2 * j + 1;
                unsigned char* base = C.ws + WS_WMOE + j * MOE_STRIDE;
                if (which < 2) { W = (which == 0 ? C.in[24] : C.in[25]) + (size_t)(j * NE + e) * D * FF; WT = (bf16*)base + (size_t)e * 7168 * D; gain = C.in[8] + layer * D; ldw = FF; K = D; }
                else { W = C.in[26] + (size_t)(j * NE + e) * FF * D; WT = (bf16*)(base + MOE_WD) + (size_t)e * D * FF; ldw = D; K = FF; }
            }
            if (which < 2) { const int nblk = FF / 32, kb = r / nblk, nb = r % nblk, n0 = nb * 32; const int dr = (n0 >> 7) * 256 + (n0 & 127) + (which ? 128 : 0);
                transpose_item(W, ldw, kb * 64, n0, WT, K, dr, gain, scr, C.lane); }
            else { const int nblk = D / 32, kb = r / nblk, nb = r % nblk; transpose_item(W, ldw, kb * 64, nb * 32, WT, K, nb * 32, nullptr, scr, C.lane); }
        }
    }
    transpose_job(C, C.in[9], N_SWA, D, 0, N_SWA, WSP(bf16, WS_WIN + WIN_OFF[0]), 0, 0, C.in[2] + 0 * D, scr);
    transpose_job(C, C.in[13], N_RET, D, 0, N_RET, WSP(bf16, WS_WIN + WIN_OFF[1]), 0, 0, C.in[2] + 1 * D, scr);
    transpose_job(C, C.in[14], MLS_SRC, D, 0, 2304, WSP(bf16, WS_WIN + WIN_OFF[2]), 0, 0, C.in[2] + 2 * D, scr);
    transpose_job(C, C.in[14], MLS_SRC, D, 2312, 256, WSP(bf16, WS_WIN + WIN_OFF[2]), 0, 2304, C.in[2] + 2 * D, scr);
    transpose_job(C, C.in[9] + (size_t)D * N_SWA, N_SWA, D, 0, N_SWA, WSP(bf16, WS_WIN + WIN_OFF[3]), 0, 0, C.in[2] + 3 * D, scr);
    for (int l = 0; l < 4; ++l) {
        transpose_job(C, C.in[7] + (size_t)l * D * D, D, D, 0, D, WSP(bf16, WS_WOUT + (size_t)l * 2 * MiB), 0, 0, nullptr, scr);
        transpose_job(C, C.in[4] + (size_t)l * D * 512, 512, D, 0, 512, WSP(bf16, WS_WMEM), 0, 512 * l, C.in[3] + l * D, scr);
    }
    for (int m = C.gw; m < M; m += C.NGW) {
        const GAS f32x4* xr = (const GAS f32x4*)(C.in[0] + (size_t)m * D) + C.lane; GAS f32x4* hr = (GAS f32x4*)(C.out + (size_t)m * D) + C.lane;
        GAS unsigned long long* o8 = (GAS unsigned long long*)(WSP(bf16, WS_HB) + (size_t)m * D) + C.lane; float s = 0.f;
#pragma unroll
        for (int j = 0; j < 4; ++j) { const f32x4 v = xr[64 * j]; hr[64 * j] = v; s += (v.x * v.x + v.y * v.y) + (v.z * v.z + v.w * v.w);
            o8[64 * j] = (unsigned long long)pk2(v.x, v.y) | ((unsigned long long)pk2(v.z, v.w) << 32); }
        s = wave_sum(s);
        if (C.lane < 16) WSP(float, WS_SS)[(size_t)m * 16 + C.lane] = C.lane == 0 ? s : 0.f;
    }
    for (int m = C.gw; m < MROWS; m += C.NGW) {
        const GAS f32x4* xr = (const GAS f32x4*)(C.in[1] + (size_t)m * D) + C.lane; f32x4 v[4]; float s = 0.f;
#pragma unroll
        for (int j = 0; j < 4; ++j) { v[j] = xr[64 * j]; s += (v[j].x * v[j].x + v[j].y * v[j].y) + (v[j].z * v[j].z + v[j].w * v[j].w); }
        const float rs = 1.0f / sqrtf(wave_sum(s) * (1.0f / D) + 1e-6f);
        GAS unsigned long long* o8 = (GAS unsigned long long*)(WSP(bf16, WS_MEMN) + (size_t)m * D) + C.lane;
#pragma unroll
        for (int j = 0; j < 4; ++j) o8[64 * j] = (unsigned long long)pk2(v[j].x * rs, v[j].y * rs) | ((unsigned long long)pk2(v[j].z * rs, v[j].w * rs) << 32);
    }
}

__device__ __forceinline__ void ld8(const bf16* p, float (&f)[8]) { const v4u w = *(const GAS v4u*)p; f[0] = bflo(w.x); f[1] = bfhi(w.x); f[2] = bflo(w.y); f[3] = bfhi(w.y); f[4] = bflo(w.z); f[5] = bfhi(w.z); f[6] = bflo(w.w); f[7] = bfhi(w.w); }
template <bool SWA>
__device__ __forceinline__ void attn_naive_unit(Ctx& C, int unit, const bf16* P, int ldp, int qcol, const float* qgain, const float* kgain, const float* sink, int layer, int swa_kcol, int swa_vcol, bf16* MIX) {
    LAS float* Ks = (LAS float*)(C.lds + RING_OFF); LAS float* Vs = Ks + 256 * 64;
    const int t = C.tid;
    int b, blk, hh; long krow0; const bf16 *Kb, *Vb; int ldk, kcol, vcol; bool prev_valid = true;
    if (SWA) { hh = unit & 3; blk = (unit >> 2) & 63; b = unit >> 8; krow0 = (long)b * SEQ + (long)blk * 128 - 128; Kb = P; Vb = P; ldk = ldp; kcol = swa_kcol + hh * 64; vcol = swa_vcol + hh * 64; prev_valid = blk > 0; }
    else { hh = unit & 3; blk = (unit >> 2) & 31; b = unit >> 7; krow0 = (long)b * MEMT; Kb = WSP(bf16, WS_MKV); Vb = Kb; ldk = 2048; kcol = layer * 512 + hh * 64; vcol = layer * 512 + 256 + hh * 64; }
    __syncthreads();
    {
        const int row = t >> 1, half = t & 1; const bool ok = SWA ? (prev_valid || row >= 128) : true;
        float kf[32], vf[32];
        if (ok) {
#pragma unroll
            for (int i = 0; i < 4; ++i) { float a[8], c[8]; ld8(Kb + (size_t)(krow0 + row) * ldk + kcol + half * 32 + i * 8, a); ld8(Vb + (size_t)(krow0 + row) * ldk + vcol + half * 32 + i * 8, c);
#pragma unroll
                for (int j = 0; j < 8; ++j) { kf[i * 8 + j] = a[j]; vf[i * 8 + j] = c[j]; } }
        } else {
#pragma unroll
            for (int i = 0; i < 32; ++i) { kf[i] = 0.f; vf[i] = 0.f; }
        }
        float ss = 0.f;
#pragma unroll
        for (int i = 0; i < 32; ++i) ss += kf[i] * kf[i];
        ss += __shfl_xor(ss, 1);
        const float rs = 1.0f / sqrtf(ss * (1.0f / 64.0f) + 1e-6f);
#pragma unroll
        for (int i = 0; i < 32; ++i) { Ks[row * 64 + half * 32 + i] = kf[i] * rs * kgain[half * 32 + i]; Vs[row * 64 + half * 32 + i] = vf[i]; }
    }
    __syncthreads();
    const int nq = SWA ? 384 : 256;
    if (t < nq) {
        const int row = SWA ? (t & 127) : t, gh = SWA ? (t >> 7) : 0;
        const int hq = SWA ? hh * 3 + gh : hh;
        const long tok = SWA ? (long)b * SEQ + (long)blk * 128 + row : (long)b * SEQ + (long)blk * 256 + row;
        float q[64], o[64];
        {
            float ss = 0.f;
#pragma unroll
            for (int i = 0; i < 8; ++i) { float a[8]; ld8(P + (size_t)tok * ldp + qcol + hq * 64 + i * 8, a);
#pragma unroll
                for (int j = 0; j < 8; ++j) { q[i * 8 + j] = a[j]; ss += a[j] * a[j]; } }
            const float rs = 1.0f / sqrtf(ss * (1.0f / 64.0f) + 1e-6f) * 0.125f;
#pragma unroll
            for (int i = 0; i < 64; ++i) { q[i] = q[i] * rs * qgain[i]; o[i] = 0.f; }
        }
        const float slope = SWA ? exp2f(-8.0f * (float)(hq + 1) / 12.0f) : 0.f;
        float mx = SWA ? sink[hq] : -1e30f, l = SWA ? 1.0f : 0.f;
        const int r0 = row & ~63;
        const int jlo = SWA ? (prev_valid ? r0 + 1 : 128) : 0, jhi = SWA ? (128 + r0 + 64) : 256;
        for (int j = jlo; j < jhi; ++j) {
            float s = 0.f;
#pragma unroll
            for (int dd = 0; dd < 64; dd += 4) { const f32x4 kv = *(const LAS f32x4*)(Ks + j * 64 + dd); s += q[dd] * kv.x + q[dd + 1] * kv.y + q[dd + 2] * kv.z + q[dd + 3] * kv.w; }
            bool valid = true;
            if (SWA) { const int dist = (j < 128) ? (row + 128 - j) : (row - (j - 128)); valid = (dist >= 0) && (dist < 128); s -= slope * (float)dist; }
            if (valid) {
                if (s > mx) { const float sc = __expf(mx - s); l *= sc;
#pragma unroll
                    for (int i = 0; i < 64; ++i) o[i] *= sc;
                    mx = s; }
                const float p = __expf(s - mx); l += p;
#pragma unroll
                for (int dd = 0; dd < 64; dd += 4) { const f32x4 vv = *(const LAS f32x4*)(Vs + j * 64 + dd); o[dd] += p * vv.x; o[dd + 1] += p * vv.y; o[dd + 2] += p * vv.z; o[dd + 3] += p * vv.w; }
            }
        }
        const float inv = 1.0f / l;
        bf16* op = MIX + (size_t)tok * D + (SWA ? hq * 64 : 768 + hq * 64);
#pragma unroll
        for (int i = 0; i < 8; ++i) { v4u w; w.x = pk2(o[i * 8 + 0] * inv, o[i * 8 + 1] * inv); w.y = pk2(o[i * 8 + 2] * inv, o[i * 8 + 3] * inv); w.z = pk2(o[i * 8 + 4] * inv, o[i * 8 + 5] * inv); w.w = pk2(o[i * 8 + 6] * inv, o[i * 8 + 7] * inv);
            *(GAS v4u*)(op + i * 8) = w; }
    }
}

__device__ __forceinline__ void ret_naive_unit(Ctx& C, int unit, const bf16* P, float* SCR1) {
    LAS float* qs = (LAS float*)(C.lds + RING_OFF); LAS float* ks = qs + 64 * 64; LAS float* vs = ks + 64 * 64;
    const int b = unit / 6, h = unit % 6, t = C.tid, v = t >> 2, dq = t & 3;
    const float gamma = 1.0f - exp2f(-5.0f - (float)h);
    float S[16];
#pragma unroll
    for (int i = 0; i < 16; ++i) S[i] = 0.f;
    for (int c = 0; c < SEQ / 64; ++c) {
        const size_t row0 = (size_t)b * SEQ + (size_t)c * 64;
        __syncthreads();
        { const int tk = t >> 3, d0 = (t & 7) * 8; float a[8];
          ld8(P + (row0 + tk) * N_RET + h * 64 + d0, a);
#pragma unroll
          for (int j = 0; j < 8; ++j) qs[tk * 64 + d0 + j] = a[j];
          ld8(P + (row0 + tk) * N_RET + 384 + h * 64 + d0, a);
#pragma unroll
          for (int j = 0; j < 8; ++j) ks[tk * 64 + d0 + j] = a[j] * 0.125f;
          const int d1 = (t & 7) * 16;
          ld8(P + (row0 + tk) * N_RET + 768 + h * 128 + d1, a);
#pragma unroll
          for (int j = 0; j < 8; ++j) vs[tk * 128 + d1 + j] = a[j];
          ld8(P + (row0 + tk) * N_RET + 768 + h * 128 + d1 + 8, a);
#pragma unroll
          for (int j = 0; j < 8; ++j) vs[tk * 128 + d1 + 8 + j] = a[j]; }
        __syncthreads();
#pragma unroll 2
        for (int tt = 0; tt < 64; ++tt) {
            const float vv = vs[tt * 128 + v]; float part = 0.f;
#pragma unroll
            for (int i = 0; i < 16; i += 4) { const f32x4 kk = *(const LAS f32x4*)(ks + tt * 64 + dq * 16 + i), qq = *(const LAS f32x4*)(qs + tt * 64 + dq * 16 + i);
                S[i] = gamma * S[i] + kk.x * vv; part += qq.x * S[i]; S[i + 1] = gamma * S[i + 1] + kk.y * vv; part += qq.y * S[i + 1];
                S[i + 2] = gamma * S[i + 2] + kk.z * vv; part += qq.z * S[i + 2]; S[i + 3] = gamma * S[i + 3] + kk.w * vv; part += qq.w * S[i + 3]; }
            part += __shfl_xor(part, 1); part += __shfl_xor(part, 2);
            if (dq == 0) SCR1[(row0 + tt) * 768 + h * 128 + v] = part;
        }
    }
}
__device__ __forceinline__ void ret_post(Ctx& C, const bf16* P, const float* SCR1, bf16* MIX) {
    for (int m = C.gw; m < M; m += C.NGW) {
#pragma unroll
        for (int h = 0; h < 6; ++h) {
            const float o0 = SCR1[(size_t)m * 768 + h * 128 + 2 * C.lane], o1 = SCR1[(size_t)m * 768 + h * 128 + 2 * C.lane + 1];
            const float rs = 1.0f / sqrtf(wave_sum(o0 * o0 + o1 * o1) * (1.0f / 128.0f) + 1e-6f);
            const unsigned gw2 = *(const GAS unsigned*)(P + (size_t)m * N_RET + 1536 + h * 128 + 2 * C.lane);
            *(GAS unsigned*)(MIX + (size_t)m * D + h * 128 + 2 * C.lane) = pk2(silu1(bflo(gw2)) * o0 * rs, silu1(bfhi(gw2)) * o1 * rs);
        }
    }
}

__device__ __forceinline__ void row_dots8(const float* hrow, const float* gain, const float* W, int ldw, int c0, int lane, float (&out)[8], float& rstd) {
    float acc[8]; float ss = 0.f;
#pragma unroll
    for (int e = 0; e < 8; ++e) acc[e] = 0.f;
#pragma unroll
    for (int j = 0; j < 4; ++j) { const int k0 = 4 * lane + 256 * j; const f32x4 hv = *(const GAS f32x4*)(hrow + k0), gv = *(const GAS f32x4*)(gain + k0);
        ss += (hv.x * hv.x + hv.y * hv.y) + (hv.z * hv.z + hv.w * hv.w);
#pragma unroll
        for (int i = 0; i < 4; ++i) { const float x = hv[i] * gv[i]; const float* wp = W + (size_t)(k0 + i) * ldw + c0;
#pragma unroll
            for (int e = 0; e < 8; ++e) acc[e] += x * wp[e]; } }
    rstd = 1.0f / sqrtf(wave_sum(ss) * (1.0f / D) + 1e-6f);
#pragma unroll
    for (int e = 0; e < 8; ++e) out[e] = wave_sum(acc[e]) * rstd;
}
__device__ __forceinline__ void mls_gates(Ctx& C) {
    float* GT = WSP(float, WS_ROUTE + RT_GATES);
    for (int m = C.gw; m < M; m += C.NGW) { float o[8], rs; row_dots8(C.out + (size_t)m * D, C.in[2] + 2 * D, C.in[14], MLS_SRC, 2304, C.lane, o, rs);
        if (C.lane < 8) { float v = o[0];
#pragma unroll
            for (int e = 1; e < 8; ++e) v = (C.lane == e) ? o[e] : v;
            GT[(size_t)m * 8 + C.lane] = v; } }
}
__device__ __forceinline__ void mls_conv(Ctx& C, const bf16* P, float* SCR2) {
    const float* cw = C.in[15]; const float* cb = C.in[16];
    const int nthr = C.G * NWAVES * 64, gt = C.bid * NWAVES * 64 + C.tid;
    for (int e = gt; e < M * 96; e += nthr) { const int m = e / 96, c0 = (e % 96) * 8, tpos = m & (SEQ - 1);
        float acc[8];
#pragma unroll
        for (int i = 0; i < 8; ++i) acc[i] = cb[c0 + i];
#pragma unroll
        for (int j = 0; j < 4; ++j) { if (tpos - 3 + j >= 0) { float a[8]; ld8(P + (size_t)(m - 3 + j) * N_MLS + c0, a);
#pragma unroll
            for (int i = 0; i < 8; ++i) acc[i] += cw[j * 768 + c0 + i] * a[i]; } }
#pragma unroll
        for (int i = 0; i < 8; ++i) SCR2[(size_t)m * 768 + c0 + i] = silu1(acc[i]);
    }
}
__device__ __forceinline__ void mls_naive_unit(Ctx& C, int unit, const bf16* P, const float* SCR2, float* SCR1) {
    LAS float* qs = (LAS float*)(C.lds + RING_OFF); LAS float* ks = qs + 64 * 96; LAS float* vs = ks + 64 * 96; LAS float* lis = vs + 64 * 96; LAS float* lfs = lis + 64;
    const int vh = unit & 1, h = (unit >> 1) & 3, b = unit >> 3, t = C.tid, v = t >> 2, dq = t & 3;
    const float* GT = WSP(float, WS_ROUTE + RT_GATES);
    const float ib = C.in[17][h], fb = C.in[18][h];
    float Cs[24], ns[24]; float mrun = 0.f;
#pragma unroll
    for (int i = 0; i < 24; ++i) { Cs[i] = 0.f; ns[i] = 0.f; }
    for (int c = 0; c < SEQ / 64; ++c) {
        const size_t row0 = (size_t)b * SEQ + (size_t)c * 64;
        __syncthreads();
        for (int e = t; e < 64 * 96; e += 512) { const int tk = e / 96, d = e % 96;
            qs[e] = SCR2[(row0 + tk) * 768 + h * 96 + d]; ks[e] = SCR2[(row0 + tk) * 768 + 384 + h * 96 + d] * 0.10206207261596577f;
            vs[e] = bflo((unsigned)P[(row0 + tk) * N_MLS + 768 + h * 192 + vh * 96 + d]); }
        if (t < 64) { lis[t] = GT[(row0 + t) * 8 + h] + ib; const float x = GT[(row0 + t) * 8 + 4 + h] + fb; lfs[t] = fminf(x, 0.f) - log1pf(__expf(-fabsf(x))); }
        __syncthreads();
        if (t < 384) {
            for (int tt = 0; tt < 64; ++tt) {
                const float lf = lfs[tt], li = lis[tt];
                const float mn = fmaxf(lf + mrun, li), fdec = __expf(lf + mrun - mn), iw = __expf(li - mn); mrun = mn;
                const float vv = vs[tt * 96 + v] * iw; float num = 0.f, den = 0.f;
#pragma unroll
                for (int i = 0; i < 24; i += 4) { const f32x4 kk = *(const LAS f32x4*)(ks + tt * 96 + dq * 24 + i), qq = *(const LAS f32x4*)(qs + tt * 96 + dq * 24 + i);
#pragma unroll
                    for (int u = 0; u < 4; ++u) { Cs[i + u] = fdec * Cs[i + u] + vv * kk[u]; ns[i + u] = fdec * ns[i + u] + iw * kk[u]; num += Cs[i + u] * qq[u]; den += ns[i + u] * qq[u]; } }
                num += __shfl_xor(num, 1); num += __shfl_xor(num, 2); den += __shfl_xor(den, 1); den += __shfl_xor(den, 2);
                if (dq == 0) SCR1[(row0 + tt) * 768 + h * 192 + vh * 96 + v] = num / fmaxf(fabsf(den), __expf(-mn));
            }
        }
    }
}
__device__ __forceinline__ void mls_post(Ctx& C, const bf16* P, const float* SCR1, bf16* MIX) {
    const float* og = C.in[19];
    for (int m = C.gw; m < M; m += C.NGW) {
#pragma unroll
        for (int h = 0; h < 4; ++h) {
            float x[3]; float ss = 0.f;
#pragma unroll
            for (int j = 0; j < 3; ++j) { x[j] = SCR1[(size_t)m * 768 + h * 192 + j * 64 + C.lane]; ss += x[j] * x[j]; }
            const float rs = 1.0f / sqrtf(wave_sum(ss) * (1.0f / 192.0f) + 1e-6f);
#pragma unroll
            for (int j = 0; j < 3; ++j) { const int col = h * 192 + j * 64 + C.lane; const float g = bflo((unsigned)P[(size_t)m * N_MLS + 1536 + col]);
                MIX[(size_t)m * D + col] = (bf16)pk2(x[j] * rs * og[col] * sigmoid1(g), 0.f); }
        }
    }
}

__device__ __forceinline__ void moe_route1(Ctx& C, int j, int layer) {
    f32x4* SEL = WSP(f32x4, WS_ROUTE + RT_SEL); float* RSTD = WSP(float, WS_ROUTE + RT_RSTD); int* CNT = WSP(int, WS_ROUTE + RT_CNT);
    LAS int* lc = (LAS int*)(C.lds + RING_OFF);
    for (int chunk = C.bid; chunk < M / 64; chunk += C.G) {
        __syncthreads();
        if (C.tid < 8) lc[C.tid] = 0;
        __syncthreads();
        for (int i = 0; i < 8; ++i) { const int m = chunk * 64 + C.wave * 8 + i; float o[8], rs;
            row_dots8(C.out + (size_t)m * D, C.in[8] + layer * D, C.in[23] + (size_t)j * D * NE, NE, 0, C.lane, o, rs);
            int e1 = 0; float v1 = o[0];
#pragma unroll
            for (int e = 1; e < 8; ++e) if (o[e] > v1) { v1 = o[e]; e1 = e; }
            int e2 = -1; float v2 = -3.0e38f;
#pragma unroll
            for (int e = 0; e < 8; ++e) if (e != e1 && o[e] > v2) { v2 = o[e]; e2 = e; }
            const float w1 = 1.0f / (1.0f + __expf(v2 - v1)), w2 = 1.0f - w1;
            if (C.lane == 0) { f32x4 s; s.x = __int_as_float(e1); s.y = __int_as_float(e2); s.z = w1; s.w = w2; SEL[m] = s; RSTD[m] = rs; atomicAdd((int*)&lc[e1], 1); atomicAdd((int*)&lc[e2], 1); }
        }
        __syncthreads();
        if (C.tid < 8) CNT[chunk * 8 + C.tid] = lc[C.tid];
    }
}
__device__ __forceinline__ void moe_route2(Ctx& C) {
    const f32x4* SEL = WSP(f32x4, WS_ROUTE + RT_SEL); const float* RSTD = WSP(float, WS_ROUTE + RT_RSTD); const int* CNT = WSP(int, WS_ROUTE + RT_CNT);
    int* PANEL = WSP(int, WS_ROUTE + RT_PANEL); int* NP = WSP(int, WS_ROUTE + RT_NP); int* TOKSLOT = WSP(int, WS_ROUTE + RT_TOKSLOT); float* SLOTRS = WSP(float, WS_ROUTE + RT_SLOTRS);
    const bf16* HB = WSP(bf16, WS_HB); bf16* XS = WSP(bf16, WS_Y);
    LAS int* lbase = (LAS int*)(C.lds + RING_OFF); LAS int* lslot = lbase + 16; LAS int* ltok = lslot + 128;
    for (int chunk = C.bid; chunk < M / 64; chunk += C.G) {
        __syncthreads();
        if (C.wave == 0) {
            const int e = C.lane & 7, sub = C.lane >> 3; int tot = 0, pre = 0;
            for (int bb = sub; bb < M / 64; bb += 8) { const int c = CNT[bb * 8 + e]; tot += c; pre += (bb < chunk) ? c : 0; }
            tot += __shfl_xor(tot, 8); tot += __shfl_xor(tot, 16); tot += __shfl_xor(tot, 32);
            pre += __shfl_xor(pre, 8); pre += __shfl_xor(pre, 16); pre += __shfl_xor(pre, 32);
            const int np = (tot + 255) >> 8; int pstart = 0;
#pragma unroll
            for (int k = 0; k < 8; ++k) { const int v = __shfl(np, k); pstart += (k < e) ? v : 0; }
            if (C.lane < 8) lbase[e] = pstart * 256 + pre;
            if (chunk == 0 && C.lane < 8) { for (int p = 0; p < np; ++p) PANEL[pstart + p] = e; if (e == 7) NP[0] = pstart + np; }
        }
        __syncthreads();
        if (C.wave == 0) {
            const int m = chunk * 64 + C.lane; const f32x4 s = SEL[m]; const int e1 = __float_as_int(s.x), e2 = __float_as_int(s.y);
            const unsigned long long lt = (1ull << C.lane) - 1ull; int s1 = 0, s2 = 0;
#pragma unroll
            for (int e = 0; e < 8; ++e) { const unsigned long long both = __ballot(e1 == e) | __ballot(e2 == e); const int r = __popcll(both & lt);
                if (e1 == e) s1 = lbase[e] + r; if (e2 == e) s2 = lbase[e] + r; }
            TOKSLOT[2 * m] = s1; TOKSLOT[2 * m + 1] = s2; const float rs = RSTD[m]; SLOTRS[s1] = rs; SLOTRS[s2] = rs;
            lslot[2 * C.lane] = s1; lslot[2 * C.lane + 1] = s2; ltok[2 * C.lane] = m; ltok[2 * C.lane + 1] = m;
        }
        __syncthreads();
        for (int i = 0; i < 16; ++i) { const int pr = C.wave * 16 + i; const int slot = lslot[pr], m = ltok[pr];
            const GAS v4u* src = (const GAS v4u*)(HB + (size_t)m * D) + C.lane; GAS v4u* dst = (GAS v4u*)(XS + (size_t)slot * D) + C.lane;
            dst[0] = src[0]; dst[64] = src[64]; }
    }
}
__device__ __forceinline__ void moe_combine(Ctx& C) {
    const f32x4* SEL = WSP(f32x4, WS_ROUTE + RT_SEL); const int* TOKSLOT = WSP(int, WS_ROUTE + RT_TOKSLOT); const float* Y = WSP(float, WS_Y);
    for (int m = C.gw; m < M; m += C.NGW) {
        const f32x4 s = SEL[m]; const int s1 = TOKSLOT[2 * m], s2 = TOKSLOT[2 * m + 1]; const float w1 = s.z, w2 = s.w;
        GAS f32x4* hr = (GAS f32x4*)(C.out + (size_t)m * D) + C.lane; const GAS f32x4* y1 = (const GAS f32x4*)(Y + (size_t)s1 * D) + C.lane; const GAS f32x4* y2 = (const GAS f32x4*)(Y + (size_t)s2 * D) + C.lane;
        GAS unsigned long long* o8 = (GAS unsigned long long*)(WSP(bf16, WS_HB) + (size_t)m * D) + C.lane; float ss = 0.f;
#pragma unroll
        for (int j = 0; j < 4; ++j) { f32x4 v = hr[64 * j]; const f32x4 a = y1[64 * j], b2 = y2[64 * j]; v = v + (a * w1 + b2 * w2); hr[64 * j] = v;
            ss += (v.x * v.x + v.y * v.y) + (v.z * v.z + v.w * v.w); o8[64 * j] = (unsigned long long)pk2(v.x, v.y) | ((unsigned long long)pk2(v.z, v.w) << 32); }
        ss = wave_sum(ss);
        if (C.lane < 16) WSP(float, WS_SS)[(size_t)m * 16 + C.lane] = C.lane == 0 ? ss : 0.f;
    }
}

struct Args { const float* in[27]; float* out; unsigned char* ws; int ph_lo, ph_hi; };
static_assert(sizeof(Args) == 27 * 8 + 8 + 8 + 8, "Args has no padding");

#define GEMM_CALL(EpiT, SchedT, g, S, E) pg8::gemm_phase<EpiT, SchedT, true, true>(C.lds + RING_OFF, g, S, E)

__global__ void __launch_bounds__(NWAVES * 64, 2) trunk_fwd(Args args) {
    extern __shared__ __attribute__((aligned(16))) unsigned char lds_raw[];
    Ctx C;
    C.lds = (LAS unsigned char*)lds_raw;
    C.tid = threadIdx.x; C.lane = C.tid & 63; C.wave = __builtin_amdgcn_readfirstlane(C.tid >> 6);
    C.G = gridDim.x; C.bid = blockIdx.x; C.gw = C.bid * NWAVES + C.wave; C.NGW = C.G * NWAVES;
#pragma unroll
    for (int i = 0; i < 27; ++i) C.in[i] = args.in[i];
    C.out = args.out; C.ws = args.ws;
    volatile LAS unsigned* MISC = (volatile LAS unsigned*)(C.lds + MISC_OFF);
    for (int u = C.tid; u < (LDS_BYTES - LDSCTL_OFF) / 4; u += NWAVES * 64) ((LAS unsigned*)(C.lds + LDSCTL_OFF))[u] = 0u;
    __syncthreads();
    XcdBarrier bar; bar.bar = (unsigned*)(C.ws + WS_CTL) + CW_BAR; bar.x = 0; bar.st = nullptr;
    if (MK_SINGLE) bar = xcd_barrier_post((unsigned*)(C.ws + WS_CTL) + CW_BAR, MISC + 8);
    const int lo = args.ph_lo, hi = args.ph_hi;
#define IN(k) (lo <= (k) && (k) < hi)
#define SEAM(k) do { if (MK_SINGLE && IN((k) + 1)) xcd_barrier(bar); } while (0)

    bf16* HB = WSP(bf16, WS_HB); float* SS = WSP(float, WS_SS); bf16* Pb = WSP(bf16, WS_BIG + BIG_P); bf16* MIX = WSP(bf16, WS_BIG + BIG_MIX);
    float* SCR1 = WSP(float, WS_BIG + BIG_SCR1); float* SCR2 = WSP(float, WS_BIG + BIG_SCR2); bf16* HID = WSP(bf16, WS_BIG); float* Y = WSP(float, WS_Y); bf16* XS = WSP(bf16, WS_Y);
    const int* PANEL = WSP(int, WS_ROUTE + RT_PANEL); const int* NPp = WSP(int, WS_ROUTE + RT_NP); const float* SLOTRS = WSP(float, WS_ROUTE + RT_SLOTRS);

#define PH_INPROJ(k, layer, NN) if (IN(k)) { pg8::Gemm g{HB, WSP(bf16, WS_WIN + WIN_OFF[layer]), M, NN, D}; pg8::StaticOrder S; S.init(M, NN, C.G, C.bid); \
        pg8::EpiScaleBf16 E{Pb, NN, SS}; GEMM_CALL(pg8::EpiScaleBf16, pg8::StaticOrder, g, S, E); }
#define PH_OUTPROJ(k, layer) if (IN(k)) { pg8::Gemm g{MIX, WSP(bf16, WS_WOUT + (size_t)(layer) * 2 * MiB), M, D, D}; pg8::StaticOrder S; S.init(M, D, C.G, C.bid); \
        pg8::EpiResid E{C.out, HB, SS}; GEMM_CALL(pg8::EpiResid, pg8::StaticOrder, g, S, E); SEAM(k); }
#define PH_FFN_DENSE(k, j) if (IN(k)) { pg8::Gemm g{HB, WSP(bf16, WS_WFD + (j) * FD_STRIDE), M, 2 * FF, D}; pg8::StaticOrder S; S.init(M, 2 * FF, C.G, C.bid); \
        pg8::EpiSwiglu<false> E{HID, SS}; GEMM_CALL(pg8::EpiSwiglu<false>, pg8::StaticOrder, g, S, E); SEAM(k); } \
    if (IN((k) + 1)) { pg8::Gemm g{HID, WSP(bf16, WS_WFD + (j) * FD_STRIDE + FD_WD), M, D, FF}; pg8::StaticOrder S; S.init(M, D, C.G, C.bid); \
        pg8::EpiResid E{C.out, HB, SS}; GEMM_CALL(pg8::EpiResid, pg8::StaticOrder, g, S, E); SEAM((k) + 1); }
#define PH_FFN_MOE(k, j, layer) if (IN(k)) { moe_route1(C, j, layer); SEAM(k); } \
    if (IN((k) + 1)) { moe_route2(C); SEAM((k) + 1); } \
    if (IN((k) + 2)) { pg8::Gemm g{XS, WSP(bf16, WS_WMOE + (j) * MOE_STRIDE), MAXSLOT, NE * 2 * FF, D}; pg8::MoeOrder S; S.init(NPp, PANEL, 28, C.G, C.bid); \
        pg8::EpiSwiglu<true> E{HID, SLOTRS}; GEMM_CALL(pg8::EpiSwiglu<true>, pg8::MoeOrder, g, S, E); SEAM((k) + 2); } \
    if (IN((k) + 3)) { pg8::Gemm g{HID, WSP(bf16, WS_WMOE + (j) * MOE_STRIDE + MOE_WD), MAXSLOT, NE * D, FF}; pg8::MoeOrder S; S.init(NPp, PANEL, 4, C.G, C.bid); \
        pg8::EpiYF32 E{Y}; GEMM_CALL(pg8::EpiYF32, pg8::MoeOrder, g, S, E); SEAM((k) + 3); } \
    if (IN((k) + 4)) { moe_combine(C); SEAM((k) + 4); }
#define PH_MEMATTN(layer, NN, first_cu) do { const int ncu = C.G - (first_cu); if (C.bid >= (first_cu)) for (int u = C.bid - (first_cu); u < 256; u += ncu) \
        attn_naive_unit<false>(C, u, Pb, NN, NN - 256, C.in[5] + (layer) * 64, C.in[6] + (layer) * 64, nullptr, layer, 0, 0, MIX); } while (0)

    if (IN(0)) { p_prologue(C); SEAM(0); }
    if (IN(1)) { { pg8::Gemm g{WSP(bf16, WS_MEMN), WSP(bf16, WS_WMEM), MROWS, 2048, D}; pg8::StaticOrder S; S.init(MROWS, 2048, C.G, C.bid);
          pg8::EpiPlainBf16 E{WSP(bf16, WS_MKV), 2048}; GEMM_CALL(pg8::EpiPlainBf16, pg8::StaticOrder, g, S, E); } }
    PH_INPROJ(1, 0, N_SWA)
    if (IN(1)) SEAM(1);
    if (IN(2)) { for (int u = C.bid; u < 512; u += C.G) attn_naive_unit<true>(C, u, Pb, N_SWA, 0, C.in[10], C.in[11], C.in[12], 0, 768, 1024, MIX);
                 PH_MEMATTN(0, N_SWA, 0); SEAM(2); }
    PH_OUTPROJ(3, 0)
    PH_FFN_DENSE(4, 0)
    PH_INPROJ(6, 1, N_RET)
    if (IN(6)) SEAM(6);
    if (IN(7)) { if (C.bid < 12) ret_naive_unit(C, C.bid, Pb, SCR1); PH_MEMATTN(1, N_RET, 12); SEAM(7); }
    if (IN(8)) { ret_post(C, Pb, SCR1, MIX); SEAM(8); }
    PH_OUTPROJ(9, 1)
    PH_FFN_MOE(10, 0, 1)
    PH_INPROJ(15, 2, N_MLS)
    if (IN(15)) { mls_gates(C); SEAM(15); }
    if (IN(16)) { mls_conv(C, Pb, SCR2); SEAM(16); }
    if (IN(17)) { if (C.bid < 16) mls_naive_unit(C, C.bid, Pb, SCR2, SCR1); PH_MEMATTN(2, N_MLS, 16); SEAM(17); }
    if (IN(18)) { mls_post(C, Pb, SCR1, MIX); SEAM(18); }
    PH_OUTPROJ(19, 2)
    PH_FFN_DENSE(20, 1)
    PH_INPROJ(22, 3, N_SWA)
    if (IN(22)) SEAM(22);
    if (IN(23)) { for (int u = C.bid; u < 512; u += C.G) attn_naive_unit<true>(C, u, Pb, N_SWA, 0, C.in[10] + 64, C.in[11] + 64, C.in[12] + 12, 3, 768, 1024, MIX);
                  PH_MEMATTN(3, N_SWA, 0); SEAM(23); }
    PH_OUTPROJ(24, 3)
    PH_FFN_MOE(25, 1, 3)
#undef IN
}

extern "C" void kernel_launch(void* const* d_in, const int* in_sizes, int n_in, void* d_out, int out_size, void* d_ws, size_t ws_size, hipStream_t stream) {
    static int grid = 0;
    if (grid == 0) {
        if (n_in != 27 || in_sizes[0] != M * D || out_size != M * D || ws_size < WS_END) { fprintf(stderr, "kernel_launch: unexpected shapes (n_in %d, in0 %d, out %d, ws %zu < %zu)\n", n_in, n_in > 0 ? in_sizes[0] : -1, out_size, ws_size, (size_t)WS_END); grid = -1; return; }
        int dev = 0, cus = 0, per_cu = 0;
        if (hipGetDevice(&dev) != hipSuccess || hipDeviceGetAttribute(&cus, hipDeviceAttributeMultiprocessorCount, dev) != hipSuccess) { grid = -1; return; }
        if (hipFuncSetAttribute((const void*)trunk_fwd, hipFuncAttributeMaxDynamicSharedMemorySize, LDS_BYTES) != hipSuccess) { fprintf(stderr, "kernel_launch: hipFuncSetAttribute failed\n"); grid = -1; return; }
        if (hipOccupancyMaxActiveBlocksPerMultiprocessor(&per_cu, (const void*)trunk_fwd, NWAVES * 64, LDS_BYTES) != hipSuccess || per_cu < 1) fprintf(stderr, "kernel_launch: occupancy query says %d\n", per_cu);
        (void)hipGetLastError();
        grid = cus;
    }
    if (grid < 0) return;
    if (hipMemsetAsync((char*)d_ws + WS_CTL, 0, CTL_ZERO_BYTES, stream) != hipSuccess) return;
    Args a{};
    for (int i = 0; i < 27; ++i) a.in[i] = (const float*)d_in[i];
    a.out = (float*)d_out; a.ws = (unsigned char*)d_ws;
    if (MK_SINGLE) { a.ph_lo = 0; a.ph_hi = NPHASE; hipLaunchKernelGGL(trunk_fwd, dim3(grid), dim3(NWAVES * 64), LDS_BYTES, stream, a); }
    else for (int p = 0; p < NPHASE; ++p) { a.ph_lo = p; a.ph_hi = p + 1; hipLaunchKernelGGL(trunk_fwd, dim3(grid), dim3(NWAVES * 64), LDS_BYTES, stream, a); }
}
```

```cpp
#include <hip/hip_runtime.h>
#include <cstdio>
#include <cstdint>
namespace pg8 {
#define PG8_LAS __attribute__((address_space(3)))
typedef unsigned short bf16_t;
typedef short bf16x8 __attribute__((ext_vector_type(8)));
typedef float f32x4 __attribute__((ext_vector_type(4)));
typedef unsigned u32x4 __attribute__((ext_vector_type(4)));
constexpr int BM = 256, BK = 64, HALF = 128, HTB = HALF * BK * 2  , STAGE_BYTES = 8 * HTB, NXCD = 8, WGM = 8;

__host__ __device__ __forceinline__ int lds_byte(int r, int c) { const int st = (r >> 4) * 2 + (c >> 5), rr = r & 15, cc = c & 31, ob = rr * 64 + cc * 2; return st * 1024 + (ob ^ (((ob >> 9) & 1) << 5)); }
__host__ __device__ __forceinline__ void stage_rc(int b, int& R, int& C) { const int st = b / 1024, sb = b % 1024, swz = sb ^ (((sb >> 9) & 1) << 5); R = (st >> 1) * 16 + swz / 64; C = (st & 1) * 32 + (swz % 64) / 2; }
__host__ __device__ __forceinline__ int perm32(int rho) { const int n = rho >> 4, i = rho & 15; return 8 * (i >> 2) + 4 * n + (i & 3); }

struct Unit { int pm, pn; };
struct Gemm { const bf16_t* A; const bf16_t* Bt; int M, N, K; const int* rowmap; int ld; };

struct StaticOrder {
    int nM, nN, nwg, G, c;
    __host__ __device__ void init(int M, int N, int G_, int c_) { nM = M / BM; nN = N / BM; nwg = nM * nN; G = G_; c = c_; }
    __host__ __device__ bool next(int i, Unit& u) const {
        const long L = (long)i * G + c; if (L >= nwg) return false;
        int wgid = (int)L; { const int q = nwg / NXCD, r = nwg % NXCD, xcd = wgid % NXCD, off = wgid / NXCD; wgid = (xcd < r ? xcd * (q + 1) : r * (q + 1) + (xcd - r) * q) + off; }
        const int nig = WGM * nN, gid = wgid / nig, fm = gid * WGM, gsz = (nM - fm) < WGM ? (nM - fm) : WGM;
        u.pm = fm + ((wgid % nig) % gsz); u.pn = (wgid % nig) / gsz; return true;
    }
    __device__ __forceinline__ void a_ready(const Unit&) const {}
    __device__ __forceinline__ void done(const Unit&) const {}
};

__device__ __forceinline__ unsigned cvt_pk_bf16(float lo, float hi) { unsigned r; asm volatile("v_cvt_pk_bf16_f32 %0, %1, %2" : "=v"(r) : "v"(lo), "v"(hi)); return r; }
__device__ __forceinline__ float row_rstd16(const float* SS, int row) {
    const f32x4 a = *(const f32x4*)(SS + (size_t)row * 4);
    return 1.0f / sqrtf(((a[0] + a[1]) + (a[2] + a[3])) * (1.0f / 1024.0f) + 1e-6f);
}
typedef float f32x2 __attribute__((ext_vector_type(2)));

struct EpiPlainBf16 {
    static constexpr bool PERM = true, AFTER_DRAIN = false;
    bf16_t* O; int ldc;
    __device__ __forceinline__ void operator()(const f32x4 (&acc)[2][2][4][2], const Unit& u, int wr, int wc, int fr, int fq) const {
        const int row0 = u.pm * BM + wr * 64 + fr, col0 = u.pn * BM + wc * 32 + 8 * fq;
#pragma unroll
        for (int ai = 0; ai < 2; ++ai)
#pragma unroll
            for (int m = 0; m < 4; ++m) { bf16_t* rowp = O + (size_t)(row0 + ai * HALF + m * 16) * ldc + col0;
#pragma unroll
                for (int bj = 0; bj < 2; ++bj) { const f32x4 v0 = acc[ai][bj][m][0], v1 = acc[ai][bj][m][1];
                    u32x4 w; w.x = cvt_pk_bf16(v0[0], v0[1]); w.y = cvt_pk_bf16(v0[2], v0[3]); w.z = cvt_pk_bf16(v1[0], v1[1]); w.w = cvt_pk_bf16(v1[2], v1[3]);
                    *(u32x4*)(rowp + bj * HALF) = w; } }
    }
};
struct EpiScaleBf16 {
    static constexpr bool PERM = true, AFTER_DRAIN = false;
    bf16_t* O; int ldc; const float* SS; const PG8_LAS float* rsl;
    __device__ __forceinline__ void operator()(const f32x4 (&acc)[2][2][4][2], const Unit& u, int wr, int wc, int fr, int fq) const {
        const int row0 = u.pm * BM + wr * 64 + fr, col0 = u.pn * BM + wc * 32 + 8 * fq;
#pragma unroll
        for (int ai = 0; ai < 2; ++ai)
#pragma unroll
            for (int m = 0; m < 4; ++m) { const int row = row0 + ai * HALF + m * 16; const float sc = rsl ? rsl[row & 255] : row_rstd16(SS, row); bf16_t* rowp = O + (size_t)row * ldc + col0;
#pragma unroll
                for (int bj = 0; bj < 2; ++bj) { const f32x4 v0 = acc[ai][bj][m][0] * sc, v1 = acc[ai][bj][m][1] * sc;
                    u32x4 w; w.x = cvt_pk_bf16(v0[0], v0[1]); w.y = cvt_pk_bf16(v0[2], v0[3]); w.z = cvt_pk_bf16(v1[0], v1[1]); w.w = cvt_pk_bf16(v1[2], v1[3]);
                    *(u32x4*)(rowp + bj * HALF) = w; } }
    }
};
struct EpiResid {
    static constexpr bool PERM = true, AFTER_DRAIN = false;
    bf16_t* HB; float* SS; PG8_LAS float* xs;
    __device__ __forceinline__ void operator()(const f32x4 (&acc)[2][2][4][2], const Unit& u, int wr, int wc, int fr, int fq) const {
        const int row0 = u.pm * BM + wr * 64 + fr, col0 = u.pn * BM + wc * 32 + 8 * fq;
        u32x4 hv[2][4][2];
#pragma unroll
        for (int ai = 0; ai < 2; ++ai)
#pragma unroll
            for (int m = 0; m < 4; ++m) { const bf16_t* bp = HB + (size_t)(row0 + ai * HALF + m * 16) * 1024 + col0;
                hv[ai][m][0] = *(const u32x4*)bp; hv[ai][m][1] = *(const u32x4*)(bp + HALF); }
#pragma unroll
        for (int ai = 0; ai < 2; ++ai)
#pragma unroll
            for (int m = 0; m < 4; ++m) { const int row = row0 + ai * HALF + m * 16; bf16_t* bp = HB + (size_t)row * 1024 + col0; float ss = 0.f;
#pragma unroll
                for (int bj = 0; bj < 2; ++bj) { const u32x4 hw = hv[ai][m][bj];
                    f32x4 h0 = (f32x4){__uint_as_float(hw.x << 16), __uint_as_float(hw.x & 0xffff0000u), __uint_as_float(hw.y << 16), __uint_as_float(hw.y & 0xffff0000u)};
                    f32x4 h1 = (f32x4){__uint_as_float(hw.z << 16), __uint_as_float(hw.z & 0xffff0000u), __uint_as_float(hw.w << 16), __uint_as_float(hw.w & 0xffff0000u)};
                    h0 = h0 + acc[ai][bj][m][0]; h1 = h1 + acc[ai][bj][m][1];
                    ss += ((h0[0] * h0[0] + h0[1] * h0[1]) + (h0[2] * h0[2] + h0[3] * h0[3])) + ((h1[0] * h1[0] + h1[1] * h1[1]) + (h1[2] * h1[2] + h1[3] * h1[3]));
                    u32x4 w; w.x = cvt_pk_bf16(h0[0], h0[1]); w.y = cvt_pk_bf16(h0[2], h0[3]); w.z = cvt_pk_bf16(h1[0], h1[1]); w.w = cvt_pk_bf16(h1[2], h1[3]);
                    *(u32x4*)(bp + bj * HALF) = w; }
                ss += __shfl_xor(ss, 16); ss += __shfl_xor(ss, 32);
                if (fq == 0) xs[(ai * HALF + wr * 64 + m * 16 + fr) * 4 + wc] = ss; }
        asm volatile("s_waitcnt lgkmcnt(0)" ::: "memory"); __builtin_amdgcn_s_barrier(); asm volatile("" ::: "memory");
        if (threadIdx.x < 256) { const f32x4 v = *(const PG8_LAS f32x4*)(xs + 4 * threadIdx.x); SS[(size_t)(u.pm * BM + threadIdx.x) * 4 + u.pn] = (v[0] + v[1]) + (v[2] + v[3]); }
    }
};
template <bool MOE> struct EpiSwiglu {
    static constexpr bool PERM = true, AFTER_DRAIN = false;
    bf16_t* O; const float* RS; const PG8_LAS float* rsl;
    static __device__ __forceinline__ f32x2 swi2(f32x2 g, f32x2 u, float nsc, float sc2) {
        const f32x2 t = g * nsc; f32x2 d; d.x = __builtin_amdgcn_exp2f(t.x); d.y = __builtin_amdgcn_exp2f(t.y); d = d + 1.0f;
        f32x2 r; r.x = __builtin_amdgcn_rcpf(d.x); r.y = __builtin_amdgcn_rcpf(d.y);
        return ((g * u) * sc2) * r;
    }
    __device__ __forceinline__ void operator()(const f32x4 (&acc)[2][2][4][2], const Unit& u, int wr, int wc, int fr, int fq) const {
        const int pnl = MOE ? (u.pn % 28) : u.pn;
        const int row0 = u.pm * BM + wr * 64 + fr, col0 = pnl * HALF + wc * 32 + 8 * fq;
        float scv[2][4];
#pragma unroll
        for (int ai = 0; ai < 2; ++ai)
#pragma unroll
            for (int m = 0; m < 4; ++m) { const int row = row0 + ai * HALF + m * 16; scv[ai][m] = MOE ? RS[row] : (rsl ? rsl[row & 255] : row_rstd16(RS, row)); }
#pragma unroll
        for (int ai = 0; ai < 2; ++ai)
#pragma unroll
            for (int m = 0; m < 4; ++m) { const int row = row0 + ai * HALF + m * 16; const float sc = scv[ai][m], nsc = -1.4426950408889634f * sc, sc2 = sc * sc;
                const f32x4 g0 = acc[ai][0][m][0], g1 = acc[ai][0][m][1], u0 = acc[ai][1][m][0], u1 = acc[ai][1][m][1];
                const f32x2 a = swi2((f32x2){g0[0], g0[1]}, (f32x2){u0[0], u0[1]}, nsc, sc2), b = swi2((f32x2){g0[2], g0[3]}, (f32x2){u0[2], u0[3]}, nsc, sc2);
                const f32x2 c = swi2((f32x2){g1[0], g1[1]}, (f32x2){u1[0], u1[1]}, nsc, sc2), d = swi2((f32x2){g1[2], g1[3]}, (f32x2){u1[2], u1[3]}, nsc, sc2);
                u32x4 w; w.x = cvt_pk_bf16(a.x, a.y); w.y = cvt_pk_bf16(b.x, b.y); w.z = cvt_pk_bf16(c.x, c.y); w.w = cvt_pk_bf16(d.x, d.y);
                *(u32x4*)(O + (size_t)row * 3584 + col0) = w; }
    }
};
struct EpiYBf16 {
    static constexpr bool PERM = true, AFTER_DRAIN = false;
    bf16_t* Y;
    __device__ __forceinline__ void operator()(const f32x4 (&acc)[2][2][4][2], const Unit& u, int wr, int wc, int fr, int fq) const {
        const int pnl = u.pn & 3;
        const int row0 = u.pm * BM + wr * 64 + fr, col0 = pnl * BM + wc * 32 + 8 * fq;
#pragma unroll
        for (int ai = 0; ai < 2; ++ai)
#pragma unroll
            for (int m = 0; m < 4; ++m) { bf16_t* yp = Y + (size_t)(row0 + ai * HALF + m * 16) * 1024 + col0;
#pragma unroll
                for (int bj = 0; bj < 2; ++bj) { const f32x4 v0 = acc[ai][bj][m][0], v1 = acc[ai][bj][m][1];
                    u32x4 w; w.x = cvt_pk_bf16(v0[0], v0[1]); w.y = cvt_pk_bf16(v0[2], v0[3]); w.z = cvt_pk_bf16(v1[0], v1[1]); w.w = cvt_pk_bf16(v1[2], v1[3]);
                    *(u32x4*)(yp + bj * HALF) = w; } }
    }
};
struct EpiSlab {
    static constexpr bool PERM = true, AFTER_DRAIN = false;
    float* S; int* tailidx; int tail, ks;
    __device__ __forceinline__ void operator()(const f32x4 (&acc)[2][2][4][2], const Unit& u, int wr, int wc, int fr, int fq) const {
        float* sp = S + (size_t)(tail * 7 + ks) * 65536; const int row0 = wr * 64 + fr, col0 = wc * 32 + 8 * fq;
        if (ks == 0 && threadIdx.x == 0) tailidx[u.pm * 4 + (u.pn & 3)] = tail;
#pragma unroll
        for (int ai = 0; ai < 2; ++ai)
#pragma unroll
            for (int m = 0; m < 4; ++m) { float* yp = sp + (size_t)(row0 + ai * HALF + m * 16) * 256 + col0;
#pragma unroll
                for (int bj = 0; bj < 2; ++bj) { *(f32x4*)(yp + bj * HALF) = acc[ai][bj][m][0]; *(f32x4*)(yp + bj * HALF + 4) = acc[ai][bj][m][1]; } }
    }
};
struct MoeOrder {
    StaticOrder so; const int* panel_e; int ntn, max_rounds, first_round;
    __device__ void init(const int* np_ptr, const int* panel_e_, int ntn_, int G, int c) { const int np = __builtin_amdgcn_readfirstlane(*np_ptr); so.init(np * BM, ntn_ * BM, G, c); panel_e = panel_e_; ntn = ntn_; max_rounds = 1 << 20; first_round = 0; }
    __device__ bool next(int i, Unit& u) const { i += first_round; if (i >= max_rounds || !so.next(i, u)) return false; const int e = __builtin_amdgcn_readfirstlane(panel_e[u.pm]); u.pn += e * ntn; return true; }
    __device__ __forceinline__ void a_ready(const Unit&) const {}
    __device__ __forceinline__ void done(const Unit&) const {}
};
template <class Epi, class Sched, bool ALIGN_EPI = false, bool SP2 = false, bool GATHER = false>
__device__ __forceinline__ void gemm_phase(PG8_LAS unsigned char* lds, const Gemm g, const Sched& S, const Epi& E) {
    const int tid = threadIdx.x, wid = __builtin_amdgcn_readfirstlane(tid >> 6), lane = tid & 63, wr = wid >> 2, wc = wid & 3, fr = lane & 15, fq = lane >> 4;
    const int K = g.K, nt = K / BK, LD = g.ld ? g.ld : g.K;
    unsigned voffA[2], voffB[2]; int gR[2]; unsigned gC[2];
#pragma unroll
    for (int i = 0; i < 2; ++i) { int R, C; stage_rc(tid * 16 + i * 8192, R, C); const int Rb = Epi::PERM ? ((R & ~31) + perm32(R & 31)) : R;
        voffA[i] = (unsigned)(R * LD + C) * 2u; voffB[i] = (unsigned)(Rb * LD + C) * 2u; gR[i] = R; gC[i] = (unsigned)C * 2u; }
    const size_t kstep = (size_t)(BK * 2);
    const size_t hstep = (size_t)HALF * LD * 2;
    const size_t tstep = 2 * hstep;
    const unsigned ldsw = (unsigned)wid * 1024u;
    const int aoff = lds_byte(wr * 64 + fr, fq * 8), boff = lds_byte(wc * 32 + fr, fq * 8);
#define PG8_SA(b, h) (((b) * 2 + (h)) * HTB)
#define PG8_SB(b, h) ((4 + (b) * 2 + (h)) * HTB)
#define PG8_STAGE(bufoff, gbase, voff) do { _Pragma("unroll") for (int _i = 0; _i < 2; ++_i) \
        __builtin_amdgcn_global_load_lds((const unsigned*)((const char*)(gbase) + (voff)[_i]), (PG8_LAS unsigned*)(lds + (bufoff) + ldsw + _i * 8192), 16, 0, 0); } while (0)
#define PG8_GOFF(dst, pm_) do { _Pragma("unroll") for (int _h = 0; _h < 2; ++_h) _Pragma("unroll") for (int _i = 0; _i < 2; ++_i) \
        dst[_h][_i] = (unsigned)g.rowmap[(pm_) * BM + _h * HALF + gR[_i]] * (unsigned)(LD * 2) + gC[_i]; } while (0)
#define PG8_STAGE_A(bufoff, ptr, half, nx) do { if constexpr (GATHER) { const unsigned _o0 = (nx) ? gvN[half][0] : gvC[half][0], _o1 = (nx) ? gvN[half][1] : gvC[half][1]; \
        __builtin_amdgcn_global_load_lds((const unsigned*)((const char*)(ptr) + _o0), (PG8_LAS unsigned*)(lds + (bufoff) + ldsw), 16, 0, 0); \
        __builtin_amdgcn_global_load_lds((const unsigned*)((const char*)(ptr) + _o1), (PG8_LAS unsigned*)(lds + (bufoff) + ldsw + 8192), 16, 0, 0); } \
        else { PG8_STAGE(bufoff, (ptr) + (half) * hstep, voffA); } } while (0)
#define PG8_LDA(dst, b, h) do { _Pragma("unroll") for (int m = 0; m < 4; ++m) _Pragma("unroll") for (int k = 0; k < 2; ++k) dst[m][k] = *(const PG8_LAS bf16x8*)(lds + PG8_SA(b, h) + aoff + m * 2048 + k * 1024); } while (0)
#define PG8_LDB(dst, b, h) do { _Pragma("unroll") for (int n = 0; n < 2; ++n) _Pragma("unroll") for (int k = 0; k < 2; ++k) dst[n][k] = *(const PG8_LAS bf16x8*)(lds + PG8_SB(b, h) + boff + n * 2048 + k * 1024); } while (0)
#define PG8_MMA(ai, bj, At, Bt) do { __builtin_amdgcn_s_setprio(1); _Pragma("unroll") for (int m = 0; m < 4; ++m) _Pragma("unroll") for (int n = 0; n < 2; ++n) _Pragma("unroll") for (int k = 0; k < 2; ++k) \
        acc[ai][bj][m][n] = __builtin_amdgcn_mfma_f32_16x16x32_bf16(Bt[n][k], At[m][k], acc[ai][bj][m][n], 0, 0, 0); __builtin_amdgcn_s_setprio(0); } while (0)
#define PG8_WAIT_V(n) asm volatile("s_waitcnt vmcnt(" #n ")" ::: "memory")
#define PG8_WAIT_L(n) asm volatile("s_waitcnt lgkmcnt(" #n ")" ::: "memory")
#define PG8_BAR __builtin_amdgcn_s_barrier()
#define PG8_SCHED __builtin_amdgcn_sched_barrier(0)
    Unit cur, nxt; int ui = 0;
    if (!S.next(0, cur)) return;
    f32x4 acc[2][2][4][2];
#pragma unroll
    for (int a = 0; a < 2; ++a)
#pragma unroll
        for (int b = 0; b < 2; ++b)
#pragma unroll
            for (int m = 0; m < 4; ++m)
#pragma unroll
                for (int n = 0; n < 2; ++n) acc[a][b][m][n] = (f32x4){0.f, 0.f, 0.f, 0.f};
    bf16x8 At[4][2], B0[2][2], B1[2][2];
    unsigned gvC[2][2], gvN[2][2]; if constexpr (GATHER) { PG8_GOFF(gvC, cur.pm); PG8_GOFF(gvN, cur.pm); }
    const char* cA = GATHER ? (const char*)g.A : (const char*)g.A + (size_t)cur.pm * tstep; const char* cB = (const char*)g.Bt + (size_t)cur.pn * tstep;
    S.a_ready(cur);
    if constexpr (SP2) {
        PG8_STAGE(PG8_SB(0, 0), cB, voffB); PG8_STAGE(PG8_SB(0, 1), cB + hstep, voffB); PG8_STAGE_A(PG8_SA(0, 0), cA, 0, false); PG8_STAGE_A(PG8_SA(0, 1), cA, 1, false);
        if (wr == 1) PG8_BAR;
        PG8_WAIT_V(2); PG8_BAR;
        PG8_STAGE(PG8_SB(1, 0), cB + kstep, voffB); PG8_STAGE_A(PG8_SA(1, 0), cA + kstep, 0, false); PG8_STAGE(PG8_SB(1, 1), cB + hstep + kstep, voffB);
        PG8_WAIT_V(6); PG8_BAR;
    } else {
        PG8_STAGE(PG8_SB(0, 0), cB, voffB); PG8_STAGE_A(PG8_SA(0, 0), cA, 0, false); PG8_STAGE(PG8_SB(0, 1), cB + hstep, voffB); PG8_STAGE_A(PG8_SA(0, 1), cA, 1, false);
        if (wr == 1) PG8_BAR;
        PG8_WAIT_V(4); PG8_BAR;
        PG8_STAGE(PG8_SB(1, 0), cB + kstep, voffB); PG8_STAGE_A(PG8_SA(1, 0), cA + kstep, 0, false); PG8_STAGE(PG8_SB(1, 1), cB + hstep + kstep, voffB);
        PG8_WAIT_V(6); PG8_BAR;
    }
    for (;;) {
        const bool has_next = S.next(ui + 1, nxt);
        if constexpr (GATHER) { if (has_next) { PG8_GOFF(gvN, nxt.pm); } else { _Pragma("unroll") for (int _h = 0; _h < 2; ++_h) { gvN[_h][0] = gvC[_h][0]; gvN[_h][1] = gvC[_h][1]; } } }
        const char* nA = GATHER ? (const char*)g.A : (has_next ? (const char*)g.A + (size_t)nxt.pm * tstep : cA); const char* nB = has_next ? (const char*)g.Bt + (size_t)nxt.pn * tstep : cB;
        for (int t = 0; t < nt; t += 2) {
            const bool last = (t == nt - 2);
            const char* a1 = cA + (size_t)(t + 1) * kstep;
            const char* a2 = last ? nA : cA + (size_t)(t + 2) * kstep; const char* b2 = last ? nB : cB + (size_t)(t + 2) * kstep;
            const char* a3 = a2 + kstep; const char* b3 = b2 + kstep;
            if (last && has_next) S.a_ready(nxt);
            if constexpr (SP2) {
            PG8_LDB(B0, 0, 0); PG8_LDB(B1, 0, 1); PG8_SCHED; PG8_LDA(At, 0, 0); PG8_STAGE_A(PG8_SA(1, 1), a1, 1, false);
            PG8_WAIT_V(8); PG8_WAIT_L(0); PG8_BAR; PG8_MMA(0, 0, At, B0); PG8_MMA(0, 1, At, B1); PG8_BAR; PG8_SCHED;
            PG8_LDA(At, 0, 1); PG8_STAGE(PG8_SB(0, 0), b2, voffB); PG8_STAGE(PG8_SB(0, 1), b2 + hstep, voffB); PG8_STAGE_A(PG8_SA(0, 0), a2, 0, last);
            PG8_WAIT_V(8); PG8_WAIT_L(0); PG8_BAR; PG8_MMA(1, 0, At, B0); PG8_MMA(1, 1, At, B1); PG8_BAR; PG8_SCHED;
            PG8_LDB(B0, 1, 0); PG8_LDB(B1, 1, 1); PG8_SCHED; PG8_LDA(At, 1, 0); PG8_STAGE_A(PG8_SA(0, 1), a2, 1, last);
            PG8_WAIT_V(8); PG8_WAIT_L(0); PG8_BAR; PG8_MMA(0, 0, At, B0); PG8_MMA(0, 1, At, B1); PG8_BAR; PG8_SCHED;
            PG8_LDA(At, 1, 1); PG8_STAGE(PG8_SB(1, 0), b3, voffB); PG8_STAGE(PG8_SB(1, 1), b3 + hstep, voffB); PG8_STAGE_A(PG8_SA(1, 0), a3, 0, last);
            PG8_WAIT_V(8); PG8_WAIT_L(0); PG8_BAR; PG8_MMA(1, 0, At, B0); PG8_MMA(1, 1, At, B1); PG8_BAR; PG8_SCHED;
            } else {
            PG8_LDB(B0, 0, 0); PG8_SCHED; PG8_LDA(At, 0, 0); PG8_STAGE_A(PG8_SA(1, 1), a1, 1, false);
            PG8_WAIT_L(8); PG8_BAR; PG8_WAIT_L(0); PG8_MMA(0, 0, At, B0); PG8_BAR; PG8_SCHED;
            PG8_LDB(B1, 0, 1); PG8_STAGE(PG8_SB(0, 0), b2, voffB);
            PG8_BAR; PG8_WAIT_L(0); PG8_MMA(0, 1, At, B1); PG8_BAR;
            PG8_LDA(At, 0, 1); PG8_STAGE_A(PG8_SA(0, 0), a2, 0, last);
            PG8_BAR; PG8_WAIT_L(0); PG8_MMA(1, 0, At, B0); PG8_BAR; PG8_SCHED;
            PG8_STAGE(PG8_SB(0, 1), b2 + hstep, voffB);
            PG8_WAIT_V(6); PG8_BAR; PG8_MMA(1, 1, At, B1); PG8_BAR;
            PG8_LDB(B0, 1, 0); PG8_SCHED; PG8_LDA(At, 1, 0); PG8_STAGE_A(PG8_SA(0, 1), a2, 1, last);
            PG8_WAIT_L(8); PG8_BAR; PG8_WAIT_L(0); PG8_MMA(0, 0, At, B0); PG8_BAR; PG8_SCHED;
            PG8_LDB(B1, 1, 1); PG8_STAGE(PG8_SB(1, 0), b3, voffB);
            PG8_BAR; PG8_WAIT_L(0); PG8_MMA(0, 1, At, B1); PG8_BAR;
            PG8_LDA(At, 1, 1); PG8_STAGE_A(PG8_SA(1, 0), a3, 0, last);
            PG8_BAR; PG8_WAIT_L(0); PG8_MMA(1, 0, At, B0); PG8_BAR; PG8_SCHED;
            PG8_STAGE(PG8_SB(1, 1), b3 + hstep, voffB);
            PG8_WAIT_V(6); PG8_BAR; PG8_MMA(1, 1, At, B1); PG8_BAR;
            }
        }
        if constexpr (ALIGN_EPI) { if (wr == 0) PG8_BAR; }
        if constexpr (!Epi::AFTER_DRAIN) { E(acc, cur, wr, wc, fr, fq); S.done(cur); }
        if (!has_next) break;
#pragma unroll
        for (int a = 0; a < 2; ++a)
#pragma unroll
            for (int b = 0; b < 2; ++b)
#pragma unroll
                for (int m = 0; m < 4; ++m)
#pragma unroll
                    for (int n = 0; n < 2; ++n) acc[a][b][m][n] = (f32x4){0.f, 0.f, 0.f, 0.f};
        cur = nxt; cA = nA; cB = nB; ++ui;
        if constexpr (GATHER) { _Pragma("unroll") for (int _h = 0; _h < 2; ++_h) { gvC[_h][0] = gvN[_h][0]; gvC[_h][1] = gvN[_h][1]; } }
        if constexpr (ALIGN_EPI) { if (wr == 1) PG8_BAR; }
    }
    PG8_WAIT_V(0);
    if constexpr (!ALIGN_EPI) { if (wr == 0) PG8_BAR; }
    PG8_BAR;
    if constexpr (Epi::AFTER_DRAIN) { E.fused(acc, cur, wr, wc, fr, fq, lds, wid, lane); S.done(cur); }
#undef PG8_SA
#undef PG8_SB
#undef PG8_STAGE
#undef PG8_GOFF
#undef PG8_STAGE_A
#undef PG8_LDA
#undef PG8_LDB
#undef PG8_MMA
#undef PG8_WAIT_V
#undef PG8_WAIT_L
#undef PG8_BAR
#undef PG8_SCHED
}
}
constexpr int NWAVES = 8;
constexpr int BATCH = 2, SEQ = 8192, D = 1024, M = BATCH * SEQ, FF = 3584, NE = 8, MEMT = 256, MROWS = BATCH * MEMT;
constexpr int N_SWA = 1536, N_RET = 2560, N_MLS = 2560, MLS_SRC = 2568;
constexpr int MAXSLOT = 2 * M + NE * 256;
constexpr int NPHASE = 32;
#ifndef DBL_MASK
#define DBL_MASK 0ull
#endif
#ifndef DBL_REPS
#define DBL_REPS 1
#endif
#ifndef MK_SINGLE
#define MK_SINGLE 1
#endif
constexpr size_t MiB = 1u << 20, KiB = 1024;
constexpr size_t WS_CTL = 0, CTL_ZERO_BYTES = 32 * KiB;
constexpr size_t WS_SS = 1 * MiB, WS_MEMN = 2 * MiB, WS_MKV = 3 * MiB, WS_ROUTE = 5 * MiB;
constexpr size_t RT_SEL = 0, RT_RSTD = 256 * KiB, RT_CNT = 320 * KiB, RT_PANEL = 328 * KiB, RT_NP = 329 * KiB, RT_TOKSLOT = 384 * KiB, RT_ROWTOK = 512 * KiB, RT_SLOTRS = 704 * KiB, RT_TAILIDX = 896 * KiB, RT_GATES = 1 * MiB, RT_AUXG = 2304 * KiB;
constexpr size_t WS_WIN = 8 * MiB, WS_WOUT = 24 * MiB, WS_WMEM = 32 * MiB, WS_WFD = 36 * MiB, WS_WMOE = 78 * MiB;
constexpr size_t WIN_OFF[4] = {0, 3 * MiB, 8 * MiB, 13 * MiB};
constexpr size_t FD_STRIDE = 21 * MiB, FD_WD = 14 * MiB, MOE_STRIDE = 168 * MiB, MOE_WD = 112 * MiB;
constexpr size_t WS_HB = 414 * MiB, WS_BIG = 446 * MiB, WS_Y = 684 * MiB, WS_SLAB = 820 * MiB, WS_END = 876 * MiB;
constexpr size_t BIG_P = 0, BIG_MIX = 80 * MiB, BIG_SCR1 = 112 * MiB, BIG_SCR2 = 160 * MiB;
constexpr int CW_BAR = 4096;
constexpr int RING_OFF = 0, RING_BYTES = 163328;
constexpr int LDSCTL_OFF = RING_BYTES, MISC_OFF = LDSCTL_OFF + 320;
constexpr int LDS_BYTES = 163840;


#define GAS __attribute__((address_space(1)))
#define LAS __attribute__((address_space(3)))
typedef unsigned short bf16;
typedef unsigned v4u __attribute__((ext_vector_type(4)));
typedef float f32x4 __attribute__((ext_vector_type(4)));
typedef short bf16x8 __attribute__((ext_vector_type(8)));
typedef GAS unsigned gu32;
typedef GAS unsigned long long gu64;
#define RLX_AGENT __ATOMIC_RELAXED, __HIP_MEMORY_SCOPE_AGENT
#define LDS_WAIT() asm volatile("s_waitcnt lgkmcnt(0)" ::: "memory")
#define VM_WAIT() asm volatile("s_waitcnt vmcnt(0)" ::: "memory")
__device__ __forceinline__ unsigned long long rt() { return __builtin_amdgcn_s_memrealtime(); }
__device__ __forceinline__ unsigned f2bf(float f) { unsigned u = __builtin_bit_cast(unsigned, f); return (u + 0x7fffu + ((u >> 16) & 1u)) >> 16; }
__device__ __forceinline__ unsigned pk2(float lo, float hi) { return f2bf(lo) | (f2bf(hi) << 16); }

#define XB_TMO      128
#define XB_XCNT(j)  (256  + 64 * (j))
#define XB_XSUB(j)  (1280 + 64 * (j))
#define XB_XGEN(j)  (2304 + 64 * (j))
#define XB_TOP      3328
#define XB_TOPGEN   3392
#define XCD_BAR_WORDS 3456
#define XB_SPIN_CAP (1u << 18)

__device__ __forceinline__ unsigned xb_ld(unsigned* p)              { return __hip_atomic_load(p, __ATOMIC_RELAXED, __HIP_MEMORY_SCOPE_AGENT); }
__device__ __forceinline__ unsigned xb_add(unsigned* p, unsigned v) { return __hip_atomic_fetch_add(p, v, __ATOMIC_RELAXED, __HIP_MEMORY_SCOPE_AGENT); }
__device__ __forceinline__ unsigned xb_xcc_id() { return (unsigned)__builtin_amdgcn_s_getreg((3 << 11) | 20) & 0xFu; }
#define XB_SPIN(cond, bar) do { unsigned _sp = 0; while (cond) { __builtin_amdgcn_s_sleep(1); \
    if ((++_sp & 255u) == 0u) { if (xb_ld(&(bar)[XB_TMO])) break; if (_sp > XB_SPIN_CAP) { atomicAdd(&(bar)[XB_TMO], 1u); break; } } } } while (0)

struct XcdBarrier {
    unsigned* bar; unsigned x;
    volatile LAS unsigned* st;
};

__device__ __forceinline__ XcdBarrier xcd_barrier_post(unsigned* bar, volatile LAS unsigned* st) {
    XcdBarrier b; b.bar = bar; b.x = xb_xcc_id(); b.st = st;
    if (threadIdx.x == 0) (void)xb_add(&bar[XB_XCNT(b.x)], 1u);
    return b;
}
__device__ __forceinline__ void xcd_barrier_complete(unsigned* bar, unsigned x, unsigned& nloc, unsigned& nx) {
    const unsigned G = gridDim.x * gridDim.y * gridDim.z;
    unsigned sum, cnt, mine, sp = 0u;
    for (;;) {
        sum = 0u; cnt = 0u; mine = 0u;
#pragma unroll
        for (unsigned j = 0; j < 16; ++j) { const unsigned c = xb_ld(&bar[XB_XCNT(j)]); sum += c; cnt += (c > 0u) ? 1u : 0u; mine = (j == x) ? c : mine; }
        if (sum == G) break;
        __builtin_amdgcn_s_sleep(1);
        if ((++sp & 255u) == 0u) { if (xb_ld(&bar[XB_TMO])) break; if (sp > XB_SPIN_CAP) { atomicAdd(&bar[XB_TMO], 1u); break; } }
    }
    nloc = mine > 0u ? mine : 1u; nx = cnt > 0u ? cnt : 1u;
}

__device__ __forceinline__ void xcd_barrier(const XcdBarrier& b) {
    asm volatile("s_waitcnt vmcnt(0)" ::: "memory");
    __syncthreads();
    if (threadIdx.x == 0) {
        unsigned* bar = b.bar;
        __builtin_amdgcn_s_waitcnt(0);
        unsigned nloc = b.st[0], nx = b.st[1];
        if (nloc == 0u) { xcd_barrier_complete(bar, b.x, nloc, nx); b.st[0] = nloc; b.st[1] = nx; }
        const unsigned old = xb_add(&bar[XB_XSUB(b.x)], 1u);
        const unsigned gen = old / nloc;
        if (old + 1u == (gen + 1u) * nloc) {
            __builtin_amdgcn_fence(__ATOMIC_RELEASE, "agent");
            asm volatile("s_waitcnt vmcnt(0)" ::: "memory");
            const unsigned og = xb_add(&bar[XB_TOP], 1u);
            const unsigned tg = og / nx;
            if (og + 1u == (tg + 1u) * nx) xb_add(&bar[XB_TOPGEN], 1u);
            else XB_SPIN(xb_ld(&bar[XB_TOPGEN]) == tg, bar);
            __builtin_amdgcn_fence(__ATOMIC_ACQUIRE, "agent");
            xb_add(&bar[XB_XGEN(b.x)], 1u);
            asm volatile("s_waitcnt vmcnt(0)" ::: "memory");
        } else {
            XB_SPIN(xb_ld(&bar[XB_XGEN(b.x)]) == gen, bar);
            __builtin_amdgcn_fence(__ATOMIC_ACQUIRE, "agent");
            asm volatile("s_waitcnt vmcnt(0)" ::: "memory");
        }
    }
    __syncthreads();
}


typedef unsigned v2u __attribute__((ext_vector_type(2)));
__device__ __forceinline__ float bflo(unsigned w) { return __uint_as_float(w << 16); }
__device__ __forceinline__ float bfhi(unsigned w) { return __uint_as_float(w & 0xffff0000u); }
__device__ __forceinline__ float wave_sum(float v) {
#pragma unroll
    for (int o = 1; o < 64; o <<= 1) v += __shfl_xor(v, o);
    return v;
}
__device__ __forceinline__ float silu1(float x) { return x / (1.0f + __expf(-x)); }
__device__ __forceinline__ float sigmoid1(float x) { return 1.0f / (1.0f + __expf(-x)); }

struct Ctx {
    LAS unsigned char* lds;
    int tid, lane, wave, gw, NGW, G, bid;
    const float* in[27];
    float* out;
    unsigned char* ws;
};
#define WSP(T, off) ((T*)(C.ws + (off)))

__device__ __forceinline__ unsigned cvt2(float lo, float hi) { unsigned r; asm volatile("v_cvt_pk_bf16_f32 %0, %1, %2" : "=v"(r) : "v"(lo), "v"(hi)); return r; }
struct TpDesc { const float* W; bf16* WT; const float* gain; int ldw, K, csrc0, drow0, mode, kb, nb; };
__device__ __forceinline__ void tp_decode(Ctx& C, int tile, TpDesc& d) {
    constexpr int T_FFN = 54 * 224, T_IN = 512, T_OUT = 256;
    d.gain = nullptr; d.csrc0 = 0; d.drow0 = 0; d.mode = 0;
    if (tile < T_FFN) {
        const int job = tile / 224, r = tile % 224; int which;
        if (job < 6) { const int j = job / 3; which = job % 3; unsigned char* base = C.ws + WS_WFD + j * FD_STRIDE;
            if (which < 2) { d.W = (which == 0 ? C.in[20] : C.in[21]) + (size_t)j * D * FF; d.WT = (bf16*)base; d.gain = C.in[8] + (2 * j) * D; }
            else { d.W = C.in[22] + (size_t)j * FF * D; d.WT = (bf16*)(base + FD_WD); }
        } else { const int q = job - 6, j = q / 24, e = (q % 24) / 3; which = q % 3; unsigned char* base = C.ws + WS_WMOE + j * MOE_STRIDE;
            if (which < 2) { d.W = (which == 0 ? C.in[24] : C.in[25]) + (size_t)(j * NE + e) * D * FF; d.WT = (bf16*)base + (size_t)e * 7168 * D; d.gain = C.in[8] + (2 * j + 1) * D; }
            else { d.W = C.in[26] + (size_t)(j * NE + e) * FF * D; d.WT = (bf16*)(base + MOE_WD) + (size_t)e * D * FF; }
        }
        if (which < 2) { d.ldw = FF; d.K = D; d.drow0 = which ? 128 : 0; d.mode = 1; d.kb = r / 14; d.nb = r % 14; }
        else { d.ldw = D; d.K = FF; d.kb = r / 4; d.nb = r % 4; }
    } else if (tile < T_FFN + T_IN) {
        int r = tile - T_FFN; d.K = D;
        if (r < 96) { d.W = C.in[9]; d.ldw = N_SWA; d.WT = WSP(bf16, WS_WIN + WIN_OFF[0]); d.gain = C.in[2] + 0 * D; d.kb = r / 6; d.nb = r % 6; }
        else if ((r -= 96) < 160) { d.W = C.in[13]; d.ldw = N_RET; d.WT = WSP(bf16, WS_WIN + WIN_OFF[1]); d.gain = C.in[2] + 1 * D; d.kb = r / 10; d.nb = r % 10; }
        else if ((r -= 160) < 144) { d.W = C.in[14]; d.ldw = MLS_SRC; d.WT = WSP(bf16, WS_WIN + WIN_OFF[2]); d.gain = C.in[2] + 2 * D; d.kb = r / 9; d.nb = r % 9; }
        else if ((r -= 144) < 16) { d.W = C.in[14]; d.ldw = MLS_SRC; d.csrc0 = 2312; d.drow0 = 2304; d.WT = WSP(bf16, WS_WIN + WIN_OFF[2]); d.gain = C.in[2] + 2 * D; d.kb = r; d.nb = 0; }
        else { r -= 16; d.W = C.in[9] + (size_t)D * N_SWA; d.ldw = N_SWA; d.WT = WSP(bf16, WS_WIN + WIN_OFF[3]); d.gain = C.in[2] + 3 * D; d.kb = r / 6; d.nb = r % 6; }
    } else if (tile < T_FFN + T_IN + T_OUT) {
        const int r = tile - T_FFN - T_IN, l = r >> 6, q = r & 63;
        d.W = C.in[7] + (size_t)l * D * D; d.ldw = D; d.K = D; d.WT = WSP(bf16, WS_WOUT + (size_t)l * 2 * MiB); d.kb = q >> 2; d.nb = q & 3;
    } else {
        const int r = tile - T_FFN - T_IN - T_OUT, l = r >> 5, q = r & 31;
        d.W = C.in[4] + (size_t)l * D * 512; d.ldw = 512; d.K = D; d.WT = WSP(bf16, WS_WMEM); d.drow0 = 512 * l; d.gain = C.in[3] + l * D; d.kb = q >> 1; d.nb = q & 1;
    }
}
__device__ __forceinline__ void tp_load(Ctx& C, const TpDesc& d, f32x4 (&v)[8], f32x4 (&gn)[2]) {
    const int k0 = d.kb * 64 + 8 * C.wave, n = d.nb * 256 + 4 * C.lane;
    if (d.gain) { gn[0] = *(const GAS f32x4*)(d.gain + k0); gn[1] = *(const GAS f32x4*)(d.gain + k0 + 4); }
#pragma unroll
    for (int kk = 0; kk < 8; ++kk) v[kk] = __builtin_nontemporal_load((const GAS f32x4*)(d.W + (size_t)(k0 + kk) * d.ldw + d.csrc0 + n));
}
constexpr int TP_ALL = 54 * 224 + 512 + 256 + 128;
constexpr int TP_WIN_N = 768, TP_MOVED_LO = 30 * 224, TP_MOVED_N = 3 * TP_WIN_N;
__device__ __forceinline__ void tp_run(Ctx& C, int first, int stride, int count, int skip_lo, int skip_len) {
    constexpr int TP_LD = 144, TP_BUF = 256 * TP_LD;
    TpDesc da, db; f32x4 va[8], vb[8], ga[2], gb[2]; int buf = 0;
    int tile = first;
    __syncthreads();
    if (tile < count) { tp_decode(C, tile >= skip_lo ? tile + skip_len : tile, da); tp_load(C, da, va, ga); }
    if (tile + stride < count) { const int t1 = tile + stride; tp_decode(C, t1 >= skip_lo ? t1 + skip_len : t1, db); tp_load(C, db, vb, gb); }
#define TP_STEP(d, v, gn) { LAS unsigned char* Lb = C.lds + RING_OFF + buf * TP_BUF; \
        if (d.gain) { _Pragma("unroll") for (int kk = 0; kk < 8; ++kk) v[kk] = v[kk] * gn[kk >> 2][kk & 3]; } \
        _Pragma("unroll") for (int c = 0; c < 4; ++c) { v4u o; o.x = cvt2(v[0][c], v[1][c]); o.y = cvt2(v[2][c], v[3][c]); o.z = cvt2(v[4][c], v[5][c]); o.w = cvt2(v[6][c], v[7][c]); \
            *(LAS v4u*)(Lb + (4 * C.lane + c) * TP_LD + 16 * C.wave) = o; } \
        const TpDesc dc = d; const int nx = tile + 2 * stride; \
        if (nx < count) { tp_decode(C, nx >= skip_lo ? nx + skip_len : nx, d); tp_load(C, d, v, gn); } \
        __syncthreads(); \
        _Pragma("unroll") for (int q = 0; q < 4; ++q) { const int id = C.tid + 512 * q, row = id >> 3, pc = id & 7; const int n = dc.nb * 256 + row; \
            const int drow = dc.mode ? dc.drow0 + (n >> 7) * 256 + (n & 127) : dc.drow0 + n; \
            *(GAS v4u*)(dc.WT + (size_t)drow * dc.K + dc.kb * 64 + 8 * pc) = *(const LAS v4u*)(Lb + row * TP_LD + 16 * pc); } \
        tile += stride; buf ^= 1; }
    while (tile < count) { TP_STEP(da, va, ga) if (tile >= count) break; TP_STEP(db, vb, gb) }
#undef TP_STEP
    __syncthreads();
}
__device__ __forceinline__ void p_prologue(Ctx& C) {
    if (C.G == 256) tp_run(C, C.bid, C.G, TP_ALL - TP_MOVED_N, TP_MOVED_LO, TP_MOVED_N); else tp_run(C, C.bid, C.G, TP_ALL, 1 << 30, 0);
    for (int m0 = C.gw; m0 < M; m0 += 4 * C.NGW) {
        f32x4 xv[4][4];
#pragma unroll
        for (int u = 0; u < 4; ++u) { const int m = m0 + u * C.NGW; if (m < M) { const GAS f32x4* xr = (const GAS f32x4*)(C.in[0] + (size_t)m * D) + C.lane;
#pragma unroll
            for (int j = 0; j < 4; ++j) xv[u][j] = __builtin_nontemporal_load(xr + 64 * j); } }
#pragma unroll
        for (int u = 0; u < 4; ++u) { const int m = m0 + u * C.NGW; if (m < M) {
            GAS unsigned long long* o8 = (GAS unsigned long long*)(WSP(bf16, WS_HB) + (size_t)m * D) + C.lane; float s = 0.f;
#pragma unroll
            for (int j = 0; j < 4; ++j) { const f32x4 v = xv[u][j]; s += (v.x * v.x + v.y * v.y) + (v.z * v.z + v.w * v.w);
                o8[64 * j] = (unsigned long long)pk2(v.x, v.y) | ((unsigned long long)pk2(v.z, v.w) << 32); }
            s = wave_sum(s);
            if (C.lane < 4) WSP(float, WS_SS)[(size_t)m * 4 + C.lane] = C.lane == 0 ? s : 0.f; } }
    }
    for (int m = C.gw; m < MROWS; m += C.NGW) {
        const GAS f32x4* xr = (const GAS f32x4*)(C.in[1] + (size_t)m * D) + C.lane; f32x4 v[4]; float s = 0.f;
#pragma unroll
        for (int j = 0; j < 4; ++j) { v[j] = xr[64 * j]; s += (v[j].x * v[j].x + v[j].y * v[j].y) + (v[j].z * v[j].z + v[j].w * v[j].w); }
        const float rs = 1.0f / sqrtf(wave_sum(s) * (1.0f / D) + 1e-6f);
        GAS unsigned long long* o8 = (GAS unsigned long long*)(WSP(bf16, WS_MEMN) + (size_t)m * D) + C.lane;
#pragma unroll
        for (int j = 0; j < 4; ++j) o8[64 * j] = (unsigned long long)pk2(v[j].x * rs, v[j].y * rs) | ((unsigned long long)pk2(v[j].z * rs, v[j].w * rs) << 32);
    }
}

__device__ __forceinline__ void ld8(const bf16* p, float (&f)[8]) { const v4u w = *(const GAS v4u*)p; f[0] = bflo(w.x); f[1] = bfhi(w.x); f[2] = bflo(w.y); f[3] = bfhi(w.y); f[4] = bflo(w.z); f[5] = bfhi(w.z); f[6] = bflo(w.w); f[7] = bfhi(w.w); }
__device__ __forceinline__ void load_w8(const float* gain, const float* W, int ldw, int c0, int lane, float (&RW)[16][8]) {
#pragma unroll
    for (int j = 0; j < 2; ++j)
#pragma unroll
        for (int i = 0; i < 8; ++i) { const int k = 8 * lane + 512 * j + i; const float gk = gain[k]; const float* wp = W + (size_t)k * ldw + c0;
#pragma unroll
            for (int e = 0; e < 8; ++e) RW[j * 8 + i][e] = gk * wp[e]; }
}
__device__ __forceinline__ void dots8(const bf16* hrow, const float (&RW)[16][8], int lane, float (&out)[8], float& rstd) {
    float acc[8]; float ss = 0.f;
#pragma unroll
    for (int e = 0; e < 8; ++e) acc[e] = 0.f;
#pragma unroll
    for (int j = 0; j < 2; ++j) { float hv[8]; ld8(hrow + 8 * lane + 512 * j, hv);
#pragma unroll
        for (int i = 0; i < 8; ++i) { ss += hv[i] * hv[i];
#pragma unroll
            for (int e = 0; e < 8; ++e) acc[e] += hv[i] * RW[j * 8 + i][e]; } }
    rstd = 1.0f / sqrtf(wave_sum(ss) * (1.0f / D) + 1e-6f);
#pragma unroll
    for (int e = 0; e < 8; ++e) out[e] = wave_sum(acc[e]) * rstd;
}
__device__ __forceinline__ void dots8_x4(Ctx& C, int m0, const float (&RW)[16][8], float& val, float& rs) {
    const int lane = C.lane; v4u raw[4][2];
#pragma unroll
    for (int t = 0; t < 4; ++t) { const bf16* hrow = WSP(bf16, WS_HB) + (size_t)(m0 + t) * D; raw[t][0] = *(const GAS v4u*)(hrow + 8 * lane); raw[t][1] = *(const GAS v4u*)(hrow + 8 * lane + 512); }
    float acc[32], ss[4];
#pragma unroll
    for (int t = 0; t < 4; ++t) { ss[t] = 0.f;
#pragma unroll
        for (int e = 0; e < 8; ++e) acc[t * 8 + e] = 0.f;
#pragma unroll
        for (int jj = 0; jj < 2; ++jj) { const v4u w = raw[t][jj]; const float hv[8] = {bflo(w.x), bfhi(w.x), bflo(w.y), bfhi(w.y), bflo(w.z), bfhi(w.z), bflo(w.w), bfhi(w.w)};
#pragma unroll
            for (int i = 0; i < 8; ++i) { ss[t] += hv[i] * hv[i];
#pragma unroll
                for (int e = 0; e < 8; ++e) acc[t * 8 + e] += hv[i] * RW[jj * 8 + i][e]; } } }
#pragma unroll
    for (int s = 0; s < 5; ++s) { const int d = 1 << s, hn = 16 >> s; const bool up = (lane & d) != 0;
#pragma unroll
        for (int q = 0; q < hn; ++q) { const float send = up ? acc[q] : acc[q + hn], keep = up ? acc[q + hn] : acc[q]; acc[q] = keep + __shfl_xor(send, d); } }
    const float lsum = acc[0] + __shfl_xor(acc[0], 32);
    { const bool up0 = (lane & 1) != 0; const float s0 = (up0 ? ss[2] : ss[0]) + __shfl_xor(up0 ? ss[0] : ss[2], 1), s1 = (up0 ? ss[3] : ss[1]) + __shfl_xor(up0 ? ss[1] : ss[3], 1);
      const bool up1 = (lane & 2) != 0; ss[0] = (up1 ? s1 : s0) + __shfl_xor(up1 ? s0 : s1, 2); }
    float sst = ss[0];
#pragma unroll
    for (int d = 4; d < 64; d <<= 1) sst += __shfl_xor(sst, d);
    rs = 1.0f / sqrtf(sst * (1.0f / D) + 1e-6f); val = lsum * rs;
}
__device__ __forceinline__ void mls_gates(Ctx& C) {
    const bool half = (C.G == 256); if (half && C.bid < 128) return;
    const int gw = half ? (C.bid - 128) * NWAVES + C.wave : C.gw, ngw = half ? 128 * NWAVES : C.NGW;
    float* GT = WSP(float, WS_ROUTE + RT_GATES); float RW[16][8];
    load_w8(C.in[2] + 2 * D, C.in[14], MLS_SRC, 2304, C.lane, RW);
    const int tk = ((C.lane & 1) << 1) | ((C.lane >> 1) & 1), ex = (((C.lane >> 2) & 1) << 2) | (((C.lane >> 3) & 1) << 1) | ((C.lane >> 4) & 1);
    for (int m0 = 4 * gw; m0 < M; m0 += 4 * ngw) { float val, rs; dots8_x4(C, m0, RW, val, rs);
        if (C.lane < 32) GT[(size_t)(m0 + tk) * 8 + ex] = val; }
}
__device__ __forceinline__ void mls_conv(Ctx& C, const bf16* P, bf16* QKC) {
    const float* cw = C.in[15]; const float* cb = C.in[16];
    const int nthr = C.G * NWAVES * 64, gt = C.bid * NWAVES * 64 + C.tid;
    for (int e = gt; e < (M / 16) * 96; e += nthr) { const int seg = e / 96, c0 = (e % 96) * 8, m0 = seg * 16; const bool first = (m0 & (SEQ - 1)) == 0;
        v4u raw[19];
#pragma unroll
        for (int r = 0; r < 19; ++r) { if (r >= 3 || !first) raw[r] = *(const GAS v4u*)(P + (size_t)(m0 - 3 + r) * N_MLS + c0); else raw[r] = (v4u){0u, 0u, 0u, 0u}; }
        float wv[4][8], bv[8];
#pragma unroll
        for (int j = 0; j < 4; ++j) { const f32x4 a = *(const GAS f32x4*)(cw + j * 768 + c0), b2 = *(const GAS f32x4*)(cw + j * 768 + c0 + 4);
            wv[j][0] = a.x; wv[j][1] = a.y; wv[j][2] = a.z; wv[j][3] = a.w; wv[j][4] = b2.x; wv[j][5] = b2.y; wv[j][6] = b2.z; wv[j][7] = b2.w; }
        { const f32x4 a = *(const GAS f32x4*)(cb + c0), b2 = *(const GAS f32x4*)(cb + c0 + 4); bv[0] = a.x; bv[1] = a.y; bv[2] = a.z; bv[3] = a.w; bv[4] = b2.x; bv[5] = b2.y; bv[6] = b2.z; bv[7] = b2.w; }
        const float sc = c0 >= 384 ? 0.10206207261596577f : 1.0f;
#pragma unroll
        for (int r = 0; r < 16; ++r) { float acc[8];
#pragma unroll
            for (int i = 0; i < 8; ++i) acc[i] = bv[i];
#pragma unroll
            for (int j = 0; j < 4; ++j) { const v4u w = raw[r + j]; const float x[8] = {bflo(w.x), bfhi(w.x), bflo(w.y), bfhi(w.y), bflo(w.z), bfhi(w.z), bflo(w.w), bfhi(w.w)};
#pragma unroll
                for (int i = 0; i < 8; ++i) acc[i] += wv[j][i] * x[i]; }
#pragma unroll
            for (int i = 0; i < 8; ++i) acc[i] = silu1(acc[i]) * sc;
            v4u o; o.x = pk2(acc[0], acc[1]); o.y = pk2(acc[2], acc[3]); o.z = pk2(acc[4], acc[5]); o.w = pk2(acc[6], acc[7]);
            *(GAS v4u*)(QKC + (size_t)(m0 + r) * 768 + c0) = o; }
    }
}
__device__ __forceinline__ bool r1_better(float va, int ea, float vb, int eb) { return va > vb || (va == vb && ea < eb); }
__device__ __forceinline__ void moe_route1(Ctx& C, int j, int layer) {
    f32x4* SEL = WSP(f32x4, WS_ROUTE + RT_SEL); float* RSTD = WSP(float, WS_ROUTE + RT_RSTD); int* CNT = WSP(int, WS_ROUTE + RT_CNT);
    LAS int* lc = (LAS int*)(C.lds + RING_OFF); float RW[16][8]; const int lane = C.lane;
    load_w8(C.in[8] + layer * D, C.in[23] + (size_t)j * D * NE, NE, 0, lane, RW);
    for (int chunk = C.bid; chunk < M / 64; chunk += C.G) {
        __syncthreads();
        if (C.tid < 8) lc[C.tid] = 0;
        __syncthreads();
#pragma unroll 1
        for (int grp = 0; grp < 2; ++grp) {
            const int m0 = chunk * 64 + C.wave * 8 + grp * 4;
            float lval, rs; dots8_x4(C, m0, RW, lval, rs);
            const int tk = ((lane & 1) << 1) | ((lane >> 1) & 1), ex = (((lane >> 2) & 1) << 2) | (((lane >> 3) & 1) << 1) | ((lane >> 4) & 1);
            float v1 = lval, v2 = -3.0e38f; int e1 = ex, e2 = 8;
#pragma unroll
            for (int d = 4; d <= 16; d <<= 1) { const float pv1 = __shfl_xor(v1, d), pv2 = __shfl_xor(v2, d); const int pe1 = __shfl_xor(e1, d), pe2 = __shfl_xor(e2, d);
                float n1, n2; int f1, f2;
                if (r1_better(v1, e1, pv1, pe1)) { n1 = v1; f1 = e1; if (r1_better(v2, e2, pv1, pe1)) { n2 = v2; f2 = e2; } else { n2 = pv1; f2 = pe1; } }
                else { n1 = pv1; f1 = pe1; if (r1_better(v1, e1, pv2, pe2)) { n2 = v1; f2 = e1; } else { n2 = pv2; f2 = pe2; } }
                v1 = n1; e1 = f1; v2 = n2; e2 = f2; }
            if (lane < 4) { const int mm = m0 + tk; const float w1 = 1.0f / (1.0f + __expf(v2 - v1)), w2 = 1.0f - w1;
                f32x4 s; s.x = __int_as_float(e1); s.y = __int_as_float(e2); s.z = w1; s.w = w2; SEL[mm] = s; RSTD[mm] = rs; atomicAdd((int*)&lc[e1], 1); atomicAdd((int*)&lc[e2], 1); }
        }
        __syncthreads();
        if (C.tid < 8) CNT[chunk * 8 + C.tid] = lc[C.tid];
    }
}
__device__ __forceinline__ void moe_route2(Ctx& C) {
    const f32x4* SEL = WSP(f32x4, WS_ROUTE + RT_SEL); const float* RSTD = WSP(float, WS_ROUTE + RT_RSTD); const int* CNT = WSP(int, WS_ROUTE + RT_CNT);
    int* PANEL = WSP(int, WS_ROUTE + RT_PANEL); int* NP = WSP(int, WS_ROUTE + RT_NP); int* TOKSLOT = WSP(int, WS_ROUTE + RT_TOKSLOT); float* SLOTRS = WSP(float, WS_ROUTE + RT_SLOTRS); int* ROWTOK = WSP(int, WS_ROUTE + RT_ROWTOK);
    if (C.wave != 0) return;
    for (int chunk = C.bid; chunk < M / 64; chunk += C.G) {
        const int e = C.lane & 7, sub = C.lane >> 3; int tot = 0, pre = 0;
        const int mtok = chunk * 64 + C.lane; const f32x4 stok = SEL[mtok]; const float rstok = RSTD[mtok];
        int cv[32];
#pragma unroll
        for (int q = 0; q < 32; ++q) cv[q] = CNT[(sub + 8 * q) * 8 + e];
#pragma unroll
        for (int q = 0; q < 32; ++q) { tot += cv[q]; pre += (sub + 8 * q < chunk) ? cv[q] : 0; }
        tot += __shfl_xor(tot, 8); tot += __shfl_xor(tot, 16); tot += __shfl_xor(tot, 32);
        pre += __shfl_xor(pre, 8); pre += __shfl_xor(pre, 16); pre += __shfl_xor(pre, 32);
        const int np = (tot + 255) >> 8; int pstart = 0;
#pragma unroll
        for (int k = 0; k < 8; ++k) { const int v = __shfl(np, k); pstart += (k < e) ? v : 0; }
        const int mybase = pstart * 256 + pre;
        if (chunk == 0) { int* TAILIDX = WSP(int, WS_ROUTE + RT_TAILIDX); for (int q = C.lane; q < 576; q += 64) TAILIDX[q] = -1;
            if (C.lane < 8) { for (int p = 0; p < np; ++p) PANEL[pstart + p] = e; if (e == 7) NP[0] = pstart + np; }
            for (int sl = pstart * 256 + tot + sub; sl < (pstart + np) * 256; sl += 8) { ROWTOK[sl] = 0; SLOTRS[sl] = 0.f; } }
        const int m = mtok; const f32x4 s = stok; const int e1 = __float_as_int(s.x), e2 = __float_as_int(s.y);
        const unsigned long long lt = (1ull << C.lane) - 1ull; int s1 = 0, s2 = 0;
#pragma unroll
        for (int ee = 0; ee < 8; ++ee) { const unsigned long long both = __ballot(e1 == ee) | __ballot(e2 == ee); const int r = __popcll(both & lt); const int be = __shfl(mybase, ee);
            if (e1 == ee) s1 = be + r; if (e2 == ee) s2 = be + r; }
        TOKSLOT[2 * m] = s1; TOKSLOT[2 * m + 1] = s2; const float rs = rstok; SLOTRS[s1] = rs; SLOTRS[s2] = rs; ROWTOK[s1] = m; ROWTOK[s2] = m;
    }
}
struct CombRow { unsigned long long hw[4]; v2u y1[4], y2[4]; };
__device__ __forceinline__ f32x4 slab_sum(const float* SLAB, int tl, int slot, int lane) {
    const float* sp = SLAB + (size_t)tl * 7 * 65536 + (size_t)(slot & 255) * 256 + 4 * lane; f32x4 a = *(const GAS f32x4*)sp;
#pragma unroll
    for (int k = 1; k < 7; ++k) a = a + *(const GAS f32x4*)(sp + (size_t)k * 65536);
    return a;
}
template <bool FINAL>
__device__ __forceinline__ void moe_combine(Ctx& C) {
    const f32x4* SEL = WSP(f32x4, WS_ROUTE + RT_SEL); const int* TOKSLOT = WSP(int, WS_ROUTE + RT_TOKSLOT); const bf16* Y = WSP(bf16, WS_Y);
    const float* SLAB = WSP(float, WS_SLAB); const int* TAILIDX = WSP(int, WS_ROUTE + RT_TAILIDX); const int lane = C.lane;
    typedef int i32x4 __attribute__((ext_vector_type(4)));
    for (int base = C.gw; base < M; base += 8 * C.NGW) {
        const int mrow = base + (lane & 7) * C.NGW; const bool okl = mrow < M; const int mr = okl ? mrow : base;
        const f32x4 sel = SEL[mr]; const int s1l = TOKSLOT[2 * mr], s2l = TOKSLOT[2 * mr + 1];
        const i32x4 t1l = *(const GAS i32x4*)(TAILIDX + (s1l >> 8) * 4), t2l = *(const GAS i32x4*)(TAILIDX + (s2l >> 8) * 4);
#pragma unroll
        for (int k0 = 0; k0 < 8; k0 += 2) {
            CombRow R[2]; int mm[2], s1[2], s2[2], tl1[2][4], tl2[2][4]; float w1[2], w2[2]; bool ok[2];
#pragma unroll
            for (int u = 0; u < 2; ++u) { const int k = k0 + u; mm[u] = base + k * C.NGW; ok[u] = mm[u] < M;
                s1[u] = __shfl(s1l, k); s2[u] = __shfl(s2l, k); w1[u] = __shfl(sel.z, k); w2[u] = __shfl(sel.w, k);
#pragma unroll
                for (int jj = 0; jj < 4; ++jj) { tl1[u][jj] = __shfl(t1l[jj], k); tl2[u][jj] = __shfl(t2l[jj], k); }
                if (ok[u]) { const GAS unsigned long long* o8 = (const GAS unsigned long long*)(WSP(bf16, WS_HB) + (size_t)mm[u] * D) + lane;
#pragma unroll
                    for (int jj = 0; jj < 4; ++jj) { R[u].hw[jj] = o8[64 * jj];
                        R[u].y1[jj] = tl1[u][jj] < 0 ? *(const GAS v2u*)(Y + (size_t)s1[u] * D + 256 * jj + 4 * lane) : (v2u){0u, 0u};
                        R[u].y2[jj] = tl2[u][jj] < 0 ? *(const GAS v2u*)(Y + (size_t)s2[u] * D + 256 * jj + 4 * lane) : (v2u){0u, 0u}; } } }
#pragma unroll
            for (int u = 0; u < 2; ++u) if (ok[u]) {
                GAS unsigned long long* o8 = (GAS unsigned long long*)(WSP(bf16, WS_HB) + (size_t)mm[u] * D) + lane; float ss = 0.f;
#pragma unroll
                for (int jj = 0; jj < 4; ++jj) { const unsigned lo = (unsigned)R[u].hw[jj], hi = (unsigned)(R[u].hw[jj] >> 32);
                    f32x4 v = (f32x4){bflo(lo), bfhi(lo), bflo(hi), bfhi(hi)};
                    f32x4 a = (f32x4){bflo(R[u].y1[jj].x), bfhi(R[u].y1[jj].x), bflo(R[u].y1[jj].y), bfhi(R[u].y1[jj].y)}; if (tl1[u][jj] >= 0) a = slab_sum(SLAB, tl1[u][jj], s1[u], lane);
                    f32x4 b2 = (f32x4){bflo(R[u].y2[jj].x), bfhi(R[u].y2[jj].x), bflo(R[u].y2[jj].y), bfhi(R[u].y2[jj].y)}; if (tl2[u][jj] >= 0) b2 = slab_sum(SLAB, tl2[u][jj], s2[u], lane);
                    v = v + (a * w1[u] + b2 * w2[u]);
                    if (FINAL) { ((GAS f32x4*)(C.out + (size_t)mm[u] * D) + lane)[64 * jj] = v; }
                    else { ss += (v.x * v.x + v.y * v.y) + (v.z * v.z + v.w * v.w); o8[64 * jj] = (unsigned long long)pk2(v.x, v.y) | ((unsigned long long)pk2(v.z, v.w) << 32); } }
                if (!FINAL) { ss = wave_sum(ss); if (lane < 4) WSP(float, WS_SS)[(size_t)mm[u] * 4 + lane] = lane == 0 ? ss : 0.f; } }
        }
    }
}

template <class Sched> __device__ __forceinline__ const LAS float* rstd_table(Ctx& C, const Sched& S, const float* SS) {
    LAS float* tab = (LAS float*)(C.lds + 131072 + 4096);
    pg8::Unit u0, u; bool one = S.next(0, u0);
    for (int i = 1; one && S.next(i, u); ++i) one = (u.pm == u0.pm);
    __syncthreads();
    if (one && C.tid < 256) tab[C.tid] = pg8::row_rstd16(SS, u0.pm * 256 + C.tid);
    __syncthreads();
    return one ? tab : nullptr;
}
typedef short v4i16_t __attribute__((ext_vector_type(4)));
typedef const LAS unsigned char* ldsc;
__device__ __forceinline__ bf16x8 frag_rows(ldsc base, int ld, int row0, int kbyte0, int i, int g) { return *(const LAS bf16x8*)(base + (row0 + i) * ld + kbyte0 + 16 * g); }
__device__ __forceinline__ bf16x8 frag_tr(ldsc base, int ld, int k0, int nbyte0, int i, int g, bool perm) {
    const int q = i >> 2, p = i & 3;
    ldsc p1 = base + (k0 + (perm ? 4 * g : 8 * g) + q) * ld + nbyte0 + 8 * p; ldsc p2 = p1 + (perm ? 16 : 4) * ld;
    const v4i16_t a = __builtin_amdgcn_ds_read_tr16_b64_v4i16((LAS v4i16_t*)p1), b = __builtin_amdgcn_ds_read_tr16_b64_v4i16((LAS v4i16_t*)p2);
    return (bf16x8){a[0], a[1], a[2], a[3], b[0], b[1], b[2], b[3]};
}
__device__ __forceinline__ unsigned cvtpk(float lo, float hi) { unsigned r; asm volatile("v_cvt_pk_bf16_f32 %0, %1, %2" : "=v"(r) : "v"(lo), "v"(hi)); return r; }
__device__ __forceinline__ bf16x8 pack_acc2(const f32x4& t0, const f32x4& t1) {
    v4u w; w.x = cvtpk(t0[0], t0[1]); w.y = cvtpk(t0[2], t0[3]); w.z = cvtpk(t1[0], t1[1]); w.w = cvtpk(t1[2], t1[3]); return __builtin_bit_cast(bf16x8, w);
}
#define MFMA16(a, b, c) __builtin_amdgcn_mfma_f32_16x16x32_bf16(a, b, c, 0, 0, 0)
__device__ __forceinline__ void st8_lds(LAS unsigned char* p, const float (&f)[8]) { v4u w; w.x = cvtpk(f[0], f[1]); w.y = cvtpk(f[2], f[3]); w.z = cvtpk(f[4], f[5]); w.w = cvtpk(f[6], f[7]); *(LAS v4u*)p = w; }

constexpr int AT_LD = 144, AT_K = 0, AT_V = 256 * AT_LD, AT_Q = 2 * 256 * AT_LD;
struct AttnKV { v4u k[4], v[4]; };
template <int QIT> struct AttnQ { v4u q[QIT][4]; };
__device__ __forceinline__ void attn_ld_kv(AttnKV& R, const bf16* Kb, long krow0, int ldk, int kcol, int vcol, bool ok, int t) {
    const int row = t >> 1, half = t & 1;
#pragma unroll
    for (int c = 0; c < 4; ++c) { if (ok) { R.k[c] = *(const GAS v4u*)(Kb + (size_t)(krow0 + row) * ldk + kcol + half * 32 + c * 8); R.v[c] = *(const GAS v4u*)(Kb + (size_t)(krow0 + row) * ldk + vcol + half * 32 + c * 8); }
        else { R.k[c] = (v4u){0u, 0u, 0u, 0u}; R.v[c] = (v4u){0u, 0u, 0u, 0u}; } }
}
template <int NQH, bool SWA>
__device__ __forceinline__ void attn_ld_q(AttnQ<(NQH * 256 + 511) / 512>& R, const bf16* P, int ldp, long tok0, int qcol, int hh, int t) {
    constexpr int QIT = (NQH * 256 + 511) / 512;
#pragma unroll
    for (int it = 0; it < QIT; ++it) { const int hr = t + 512 * it; if (hr < NQH * 256) { const int qrow = hr >> 1, qhalf = hr & 1, qh = qrow >> 7, r = qrow & 127; const int hq = SWA ? hh * 3 + qh : hh;
#pragma unroll
        for (int c = 0; c < 4; ++c) R.q[it][c] = *(const GAS v4u*)(P + (size_t)(tok0 + r) * ldp + qcol + hq * 64 + qhalf * 32 + c * 8); } }
}
__device__ __forceinline__ void attn_st_kv(const AttnKV& R, LAS unsigned char* L, const float (&kg)[32], int t) {
    const int row = t >> 1, half = t & 1; float ss = 0.f; float kf[4][8];
#pragma unroll
    for (int c = 0; c < 4; ++c) { const v4u w4 = R.k[c]; kf[c][0] = bflo(w4.x); kf[c][1] = bfhi(w4.x); kf[c][2] = bflo(w4.y); kf[c][3] = bfhi(w4.y); kf[c][4] = bflo(w4.z); kf[c][5] = bfhi(w4.z); kf[c][6] = bflo(w4.w); kf[c][7] = bfhi(w4.w);
#pragma unroll
        for (int j = 0; j < 8; ++j) ss += kf[c][j] * kf[c][j]; }
    ss += __shfl_xor(ss, 1);
    const float rs = 1.0f / sqrtf(ss * (1.0f / 64.0f) + 1e-6f);
#pragma unroll
    for (int c = 0; c < 4; ++c) {
#pragma unroll
        for (int j = 0; j < 8; ++j) kf[c][j] = kf[c][j] * rs * kg[c * 8 + j];
        st8_lds(L + AT_K + row * AT_LD + half * 64 + c * 16, kf[c]); *(LAS v4u*)(L + AT_V + row * AT_LD + half * 64 + c * 16) = R.v[c]; }
}
template <int NQH>
__device__ __forceinline__ void attn_st_q(const AttnQ<(NQH * 256 + 511) / 512>& R, LAS unsigned char* L, const float (&qg)[32], int t) {
    constexpr int QIT = (NQH * 256 + 511) / 512;
#pragma unroll
    for (int it = 0; it < QIT; ++it) { const int hr = t + 512 * it; if (hr < NQH * 256) { const int qrow = hr >> 1, qhalf = hr & 1;
        float ss = 0.f; float qf[4][8];
#pragma unroll
        for (int c = 0; c < 4; ++c) { const v4u w4 = R.q[it][c]; qf[c][0] = bflo(w4.x); qf[c][1] = bfhi(w4.x); qf[c][2] = bflo(w4.y); qf[c][3] = bfhi(w4.y); qf[c][4] = bflo(w4.z); qf[c][5] = bfhi(w4.z); qf[c][6] = bflo(w4.w); qf[c][7] = bfhi(w4.w);
#pragma unroll
            for (int j = 0; j < 8; ++j) ss += qf[c][j] * qf[c][j]; }
        ss += __shfl_xor(ss, 1);
        const float rs = 0.18033688011112042f / sqrtf(ss * (1.0f / 64.0f) + 1e-6f);
#pragma unroll
        for (int c = 0; c < 4; ++c) {
#pragma unroll
            for (int j = 0; j < 8; ++j) qf[c][j] = qf[c][j] * rs * qg[c * 8 + j];
            st8_lds(L + AT_Q + qrow * AT_LD + qhalf * 64 + c * 16, qf[c]); } } }
}
template <bool SWA>
__device__ __forceinline__ void attn_compute(Ctx& C, int hh, long tok0, bool prev_valid, const float* sink, bf16* MIX) {
    LAS unsigned char* L = C.lds + RING_OFF;
    const int lane = C.lane, w = C.wave, i = lane & 15, g = lane >> 4;
    constexpr int NQH = SWA ? 3 : 1, NT = SWA ? 10 : 16;
    const int t0 = SWA ? w : 0;
#pragma unroll 1
    for (int qh = 0; qh < NQH; ++qh) {
        const int hq = SWA ? hh * 3 + qh : hh;
        const bf16x8 q0 = frag_rows(L + AT_Q, AT_LD, qh * 128 + 16 * w, 0, i, g), q1 = frag_rows(L + AT_Q, AT_LD, qh * 128 + 16 * w, 64, i, g);
        f32x4 s[NT];
        constexpr int TB = SWA ? 5 : 4, NB = NT / TB;
        bf16x8 kf[2][TB][2];
#define AT_LDK(b) { _Pragma("unroll") for (int k = 0; k < TB; ++k) { const int tt = (b) * TB + k, kt = (t0 + tt) > 15 ? 15 : (t0 + tt); \
            kf[(b) & 1][k][0] = frag_rows(L + AT_K, AT_LD, 16 * kt, 0, i, g); kf[(b) & 1][k][1] = frag_rows(L + AT_K, AT_LD, 16 * kt, 64, i, g); } asm volatile("" ::: "memory"); }
        AT_LDK(0)
#pragma unroll
        for (int b = 0; b < NB; ++b) {
            if (b + 1 < NB) AT_LDK(b + 1)
#pragma unroll
            for (int k = 0; k < TB; ++k) s[b * TB + k] = MFMA16(kf[b & 1][k][0], q0, ((f32x4){0.f, 0.f, 0.f, 0.f}));
#pragma unroll
            for (int k = 0; k < TB; ++k) s[b * TB + k] = MFMA16(kf[b & 1][k][1], q1, s[b * TB + k]); }
#undef AT_LDK
        bf16x8 vf[3][4];
#define AT_LDV(pr) { const int k0_ = 16 * (t0 + 2 * (pr)); _Pragma("unroll") for (int dv = 0; dv < 4; ++dv) vf[(pr) % 3][dv] = frag_tr(L + AT_V, AT_LD, k0_, 32 * dv, i, g, true); asm volatile("" ::: "memory"); }
        AT_LDV(0) AT_LDV(1)
        const float slope = SWA ? exp2f(-8.0f * (float)(hq + 1) / 12.0f) * 1.4426950408889634f : 0.f;
        const float sk = SWA ? sink[hq] * 1.4426950408889634f : 0.f;
        float mx = SWA ? sk : -1e30f;
        if (SWA) {
            const int base = i - 4 * g + 128; const float sb = slope * (float)base;
#pragma unroll
            for (int tt = 0; tt < NT; ++tt)
#pragma unroll
                for (int r = 0; r < 4; ++r) { const bool valid = (unsigned)(base - (16 * tt + r)) < 128u;
                    s[tt][r] = valid ? fmaf(slope, (float)(16 * tt + r), s[tt][r]) - sb : -1e30f; }
            if (!prev_valid) {
#pragma unroll
                for (int tt = 0; tt < NT; ++tt)
#pragma unroll
                    for (int r = 0; r < 4; ++r) { if (16 * (t0 + tt) + 4 * g + r < 128) s[tt][r] = -1e30f; } }
        }
#pragma unroll
        for (int tt = 0; tt < NT; ++tt) mx = fmaxf(mx, fmaxf(fmaxf(s[tt][0], s[tt][1]), fmaxf(s[tt][2], s[tt][3])));
        mx = fmaxf(mx, __shfl_xor(mx, 16)); mx = fmaxf(mx, __shfl_xor(mx, 32));
        float l = 0.f;
#pragma unroll
        for (int tt = 0; tt < NT; ++tt)
#pragma unroll
            for (int r = 0; r < 4; ++r) { const float p = __builtin_amdgcn_exp2f(s[tt][r] - mx); s[tt][r] = p; l += p; }
        l += __shfl_xor(l, 16); l += __shfl_xor(l, 32);
        if (SWA) l += __builtin_amdgcn_exp2f(sk - mx);
        const float inv = 1.0f / l;
        f32x4 o[4];
#pragma unroll
        for (int dv = 0; dv < 4; ++dv) o[dv] = (f32x4){0.f, 0.f, 0.f, 0.f};
#pragma unroll
        for (int pr = 0; pr < NT / 2; ++pr) {
            if (pr + 2 < NT / 2) AT_LDV(pr + 2)
            const bf16x8 pb = pack_acc2(s[2 * pr], s[2 * pr + 1]);
#pragma unroll
            for (int dv = 0; dv < 4; ++dv) o[dv] = MFMA16(vf[pr % 3][dv], pb, o[dv]);
        }
#undef AT_LDV
        bf16* op = MIX + (size_t)(tok0 + 16 * w + i) * D + (SWA ? hq * 64 : 768 + hq * 64) + 4 * g;
#pragma unroll
        for (int dv = 0; dv < 4; ++dv) { v2u wv; wv.x = cvtpk(o[dv][0] * inv, o[dv][1] * inv); wv.y = cvtpk(o[dv][2] * inv, o[dv][3] * inv); *(GAS v2u*)(op + 16 * dv) = wv; }
    }
}

__device__ __forceinline__ void attn_swa_unit(Ctx& C, int unit, const bf16* P, int ldp, const float* qgain, const float* kgain, const float* sink, int kcol0, int vcol0, bf16* MIX) {
    LAS unsigned char* L = C.lds + RING_OFF; const int t = C.tid;
    const int hh = unit & 3, blk = (unit >> 2) & 63, b = unit >> 8; const long krow0 = (long)b * SEQ + (long)blk * 128 - 128, tok0 = (long)b * SEQ + (long)blk * 128; const bool prev_valid = blk > 0;
    AttnKV rkv; AttnQ<2> rq; float kg[32], qg[32];
#pragma unroll
    for (int q = 0; q < 32; ++q) { kg[q] = kgain[(t & 1) * 32 + q]; qg[q] = qgain[(t & 1) * 32 + q]; }
    attn_ld_kv(rkv, P, krow0, ldp, kcol0 + hh * 64, vcol0 + hh * 64, prev_valid || (t >> 1) >= 128, t);
    attn_ld_q<3, true>(rq, P, ldp, tok0, 0, hh, t);
    __syncthreads();
    attn_st_kv(rkv, L, kg, t); attn_st_q<3>(rq, L, qg, t);
    __syncthreads();
    attn_compute<true>(C, hh, tok0, prev_valid, sink, MIX);
}
__device__ __forceinline__ void attn_mem_pair(Ctx& C, int pair, const bf16* P, int ldp, const float* qgain, const float* kgain, int layer, bf16* MIX) {
    LAS unsigned char* L = C.lds + RING_OFF; const int t = C.tid;
    const int hh = pair & 3, bp = (pair >> 2) & 31, b = pair >> 7; const long tok0 = (long)b * SEQ + (long)bp * 256; const int qcol = ldp - 256;
    AttnKV rkv; AttnQ<1> rq; float kg[32], qg[32];
#pragma unroll
    for (int q = 0; q < 32; ++q) { kg[q] = kgain[(t & 1) * 32 + q]; qg[q] = qgain[(t & 1) * 32 + q]; }
    attn_ld_kv(rkv, WSP(bf16, WS_MKV), (long)b * MEMT, 2048, layer * 512 + hh * 64, layer * 512 + 256 + hh * 64, true, t);
    attn_ld_q<1, false>(rq, P, ldp, tok0, qcol, hh, t);
    __syncthreads();
    attn_st_kv(rkv, L, kg, t); attn_st_q<1>(rq, L, qg, t);
    __syncthreads();
    attn_ld_q<1, false>(rq, P, ldp, tok0 + 128, qcol, hh, t);
    attn_compute<false>(C, hh, tok0, true, nullptr, MIX);
    __syncthreads();
    attn_st_q<1>(rq, L, qg, t);
    __syncthreads();
    attn_compute<false>(C, hh, tok0 + 128, true, nullptr, MIX);
}

template <int MODE> struct CMT;
template <> struct CMT<0> { static constexpr int DK = 64, DV = 128, NH = 6, LDP = N_RET; };
template <> struct CMT<1> { static constexpr int DK = 96, DV = 192, NH = 4, LDP = N_MLS; };
template <int MODE> struct CML {
    static constexpr int DK = CMT<MODE>::DK, DV = CMT<MODE>::DV, LDQK = DK * 2 + 16, LDV = DV * 2 + 16;
    static constexpr int Q = 0, K = 128 * LDQK, V = 2 * 128 * LDQK, S = V + 128 * LDV, AUX = S + DK * LDV;
    static_assert(AUX + 832 * 4 <= RING_BYTES, "chunk mixer LDS");
};
constexpr size_t RT_NLOC = 1536 * KiB, RT_NIN = 1792 * KiB, RT_CHG = 2048 * KiB, RT_CHA = 2052 * KiB, RT_MIN = 2056 * KiB;
constexpr size_t SCR2_STATE = 24 * MiB;

template <int NROWS, int NCOLS> struct StageRegs { static constexpr int CPR = NCOLS / 8, TOTAL = NROWS * CPR, ITER = (TOTAL + 511) / 512; v4u r[ITER]; };
template <int NROWS, int NCOLS>
__device__ __forceinline__ void stage_ld(StageRegs<NROWS, NCOLS>& R, const bf16* src, size_t lds_src, int t) {
    typedef StageRegs<NROWS, NCOLS> SR;
#pragma unroll
    for (int it = 0; it < SR::ITER; ++it) { const int e = t + 512 * it; if (e < SR::TOTAL) { const int row = e / SR::CPR, c = e % SR::CPR; R.r[it] = *(const GAS v4u*)(src + (size_t)row * lds_src + c * 8); } }
}
template <int NROWS, int NCOLS, bool SCALE>
__device__ __forceinline__ void stage_st(const StageRegs<NROWS, NCOLS>& R, LAS unsigned char* dst, int ldd, const LAS float* rsc, float cs, int t) {
    typedef StageRegs<NROWS, NCOLS> SR;
#pragma unroll
    for (int it = 0; it < SR::ITER; ++it) { const int e = t + 512 * it; if (e < SR::TOTAL) { const int row = e / SR::CPR, c = e % SR::CPR;
        if (!SCALE) { *(LAS v4u*)(dst + row * ldd + c * 16) = R.r[it]; }
        else { const v4u w = R.r[it]; float f[8] = {bflo(w.x), bfhi(w.x), bflo(w.y), bfhi(w.y), bflo(w.z), bfhi(w.z), bflo(w.w), bfhi(w.w)}; const float sc = cs * (rsc ? rsc[row] : 1.0f);
#pragma unroll
            for (int j = 0; j < 8; ++j) f[j] *= sc;
            st8_lds(dst + row * ldd + c * 16, f); } } }
}
__device__ __forceinline__ void mls_chunk_scans(Ctx& C, float* aux, size_t row0, int h, float& btot, float& cmax) {
    const float* GT = WSP(float, WS_ROUTE + RT_GATES); const float ib = C.in[17][h], fb = C.in[18][h]; const int l = C.lane;
    float li0 = GT[(row0 + 2 * l) * 8 + h] + ib, li1 = GT[(row0 + 2 * l + 1) * 8 + h] + ib;
    float x0 = GT[(row0 + 2 * l) * 8 + 4 + h] + fb, x1 = GT[(row0 + 2 * l + 1) * 8 + 4 + h] + fb;
    x0 = fminf(x0, 0.f) - log1pf(__expf(-fabsf(x0))); x1 = fminf(x1, 0.f) - log1pf(__expf(-fabsf(x1)));
    const float s = x0 + x1; float inc = s;
#pragma unroll
    for (int d = 1; d < 64; d <<= 1) { const float v = __shfl_up(inc, d); if (l >= d) inc += v; }
    const float b0 = inc - s + x0, b1 = inc; const float c0 = li0 - b0, c1 = li1 - b1;
    float pm = fmaxf(c0, c1);
#pragma unroll
    for (int d = 1; d < 64; d <<= 1) { const float v = __shfl_up(pm, d); if (l >= d) pm = fmaxf(pm, v); }
    const float pmprev = __shfl_up(pm, 1); const float m0 = (l == 0) ? c0 : fmaxf(pmprev, c0);
    aux[2 * l] = b0; aux[2 * l + 1] = b1; aux[128 + 2 * l] = c0; aux[128 + 2 * l + 1] = c1; aux[256 + 2 * l] = m0; aux[256 + 2 * l + 1] = pm;
    const float cm = __shfl(pm, 63); aux[384 + 2 * l] = __expf(c0 - cm); aux[384 + 2 * l + 1] = __expf(c1 - cm);
    btot = __shfl(b1, 63); cmax = cm;
}
__device__ __forceinline__ void mls_aux(Ctx& C) {
    float* AUXG = WSP(float, WS_ROUTE + RT_AUXG);
    for (int unit = C.gw; unit < 512; unit += C.NGW) { const int bh = unit >> 6, c = unit & 63, b = bh >> 2, h = bh & 3; const size_t row0 = (size_t)b * SEQ + (size_t)c * 128;
        float* aux = AUXG + (size_t)unit * 512; float b127, cm; mls_chunk_scans(C, aux, row0, h, b127, cm);
        if (C.lane == 63) { WSP(float, WS_ROUTE + RT_CHG)[unit] = b127; WSP(float, WS_ROUTE + RT_CHA)[unit] = b127 + cm; } }
}
template <int MODE>
__device__ __forceinline__ void chunk_state_unit(Ctx& C, int unit, const bf16* P, const bf16* QKC, float* U) {
    typedef CML<MODE> Lm; constexpr int DK = Lm::DK, DV = Lm::DV, NH = CMT<MODE>::NH, LDP = CMT<MODE>::LDP, ND = DK / 16, NV = DV / 16, TPW = ND * NV / 8;
    LAS unsigned char* L = C.lds + RING_OFF; LAS float* aux = (LAS float*)(L + Lm::AUX);
    const int bh = unit >> 6, c = unit & 63, b = bh / NH, h = bh % NH, t = C.tid, i = C.lane & 15, g = C.lane >> 4, w = C.wave;
    const size_t row0 = (size_t)b * SEQ + (size_t)c * 128;
    StageRegs<128, DK> rK; StageRegs<128, DV> rV;
    stage_ld<128, DK>(rK, MODE == 0 ? P + row0 * LDP + 384 + h * 64 : QKC + row0 * 768 + 384 + h * 96, MODE == 0 ? LDP : 768, t);
    stage_ld<128, DV>(rV, P + row0 * LDP + 768 + h * DV, LDP, t);
    float wsc = 0.f; if (MODE == 1 && t < 128) wsc = WSP(float, WS_ROUTE + RT_AUXG)[(size_t)unit * 512 + 384 + t];
    __syncthreads();
    if (MODE == 0) { if (t < 128) { const float l2g = log2f(1.0f - exp2f(-5.0f - (float)h)); aux[384 + t] = 0.125f * exp2f((float)(127 - t) * l2g); } }
    else { if (t < 128) aux[384 + t] = wsc; }
    __syncthreads();
    stage_st<128, DK, true>(rK, L + Lm::K, Lm::LDQK, aux + 384, 1.0f, t);
    stage_st<128, DV, false>(rV, L + Lm::V, Lm::LDV, nullptr, 1.0f, t);
    __syncthreads();
#pragma unroll 1
    for (int n = 0; n < TPW; ++n) { const int id = w * TPW + n, dt = id / NV, vt = id % NV;
        f32x4 acc = (f32x4){0.f, 0.f, 0.f, 0.f};
#pragma unroll
        for (int ks = 0; ks < 4; ++ks) acc = MFMA16(frag_tr(L + Lm::K, Lm::LDQK, 32 * ks, 32 * dt, i, g, false), frag_tr(L + Lm::V, Lm::LDV, 32 * ks, 32 * vt, i, g, false), acc);
        float* up = U + (size_t)unit * DK * DV + (size_t)(16 * dt + 4 * g) * DV + 16 * vt + i;
#pragma unroll
        for (int r = 0; r < 4; ++r) up[r * DV] = acc[r]; }
    if (MODE == 1 && t < 4 * DK) { const int dcol = t >> 2, part = t & 3; float s0 = 0.f, s1 = 0.f;
#pragma unroll 8
        for (int j = 0; j < 32; j += 2) { s0 += bflo((unsigned)*(const LAS unsigned short*)(L + Lm::K + (part * 32 + j) * Lm::LDQK + 2 * dcol)); s1 += bflo((unsigned)*(const LAS unsigned short*)(L + Lm::K + (part * 32 + j + 1) * Lm::LDQK + 2 * dcol)); }
        float s = s0 + s1; s += __shfl_xor(s, 1); s += __shfl_xor(s, 2);
        if (part == 0) WSP(float, WS_ROUTE + RT_NLOC)[(size_t)unit * 96 + dcol] = s; }
}
__device__ __forceinline__ void ret_scan(Ctx& C, const float* U, bf16* SIN) {
    const int gt = C.bid * 512 + C.tid, nthr = C.G * 512;
    for (int e = gt; e < 12 * 8192; e += nthr) { const int bh = e >> 13, idx = e & 8191, h = bh % 6;
        const float gL = exp2f(128.0f * log2f(1.0f - exp2f(-5.0f - (float)h))); float S = 0.f;
        const float* up = U + (size_t)bh * 64 * 8192 + idx; bf16* sp = SIN + (size_t)bh * 64 * 8192 + idx;
        float u[64];
#pragma unroll
        for (int c = 0; c < 64; ++c) u[c] = up[(size_t)c * 8192];
#pragma unroll
        for (int c = 0; c < 64; ++c) { sp[(size_t)c * 8192] = (bf16)f2bf(S); S = gL * S + u[c]; } }
}
__device__ __forceinline__ void mls_scan(Ctx& C, const float* U, bf16* CIN) {
    constexpr int NC = 96 * 192, SEG = NC / 1024;
    typedef float f32x2 __attribute__((ext_vector_type(2)));
    const float* CHG = WSP(float, WS_ROUTE + RT_CHG); const float* CHA = WSP(float, WS_ROUTE + RT_CHA); float* MIN_ = WSP(float, WS_ROUTE + RT_MIN);
    const float* NLOC = WSP(float, WS_ROUTE + RT_NLOC); float* NIN = WSP(float, WS_ROUTE + RT_NIN);
    LAS float* sc = (LAS float*)(C.lds + RING_OFF);
    for (int task = C.bid; task < 8 * (SEG + 1); task += C.G) { const int bh = task / (SEG + 1), seg = task % (SEG + 1);
        __syncthreads();
        if (C.wave == 0) { const float gg = CHG[bh * 64 + C.lane], aa = CHA[bh * 64 + C.lane]; float m = 0.f, dmine = 0.f, wmine = 0.f, mmine = 0.f;
            for (int c = 0; c < 64; ++c) { const float g1 = __shfl(gg, c), a1 = __shfl(aa, c); const float mn = fmaxf(g1 + m, a1); const float dd = __expf(g1 + m - mn), ww = __expf(a1 - mn);
                if (C.lane == c) { dmine = dd; wmine = ww; mmine = m; } m = mn; }
            sc[C.lane] = dmine; sc[64 + C.lane] = wmine; if (seg == SEG) MIN_[bh * 64 + C.lane] = mmine; }
        __syncthreads();
        if (seg < SEG) { const int idx = seg * 1024 + 2 * C.tid; const float* src = U + (size_t)bh * 64 * NC + idx; bf16* dst = CIN + (size_t)bh * 64 * NC + idx;
            f32x2 u[64];
#pragma unroll
            for (int c = 0; c < 64; ++c) u[c] = *(const GAS f32x2*)(src + (size_t)c * NC);
            float v0 = 0.f, v1 = 0.f;
#pragma unroll
            for (int c = 0; c < 64; ++c) { *(GAS unsigned*)(dst + (size_t)c * NC) = pk2(v0, v1); const float dd = sc[c], ww = sc[64 + c]; v0 = dd * v0 + ww * u[c].x; v1 = dd * v1 + ww * u[c].y; } }
        else if (C.tid < 96) { const float* src = NLOC + (size_t)bh * 64 * 96 + C.tid; float u[64];
#pragma unroll
            for (int c = 0; c < 64; ++c) u[c] = src[(size_t)c * 96];
            float val = 0.f;
#pragma unroll
            for (int c = 0; c < 64; ++c) { NIN[(size_t)(bh * 64 + c) * 96 + C.tid] = val; val = sc[c] * val + sc[64 + c] * u[c]; } }
    }
}
template <int MODE>
__device__ __forceinline__ void chunk_out_unit(Ctx& C, int unit, const bf16* P, const bf16* QKC, const bf16* SIN, bf16* MIX) {
    typedef CML<MODE> Lm; constexpr int DK = Lm::DK, DV = Lm::DV, NH = CMT<MODE>::NH, LDP = CMT<MODE>::LDP, NV = DV / 16, NKS = DK / 32;
    LAS unsigned char* L = C.lds + RING_OFF; LAS float* aux = (LAS float*)(L + Lm::AUX);
    const int bh = unit >> 6, c = unit & 63, b = bh / NH, h = bh % NH, t = C.tid, i = C.lane & 15, g = C.lane >> 4, w = C.wave;
    const size_t row0 = (size_t)b * SEQ + (size_t)c * 128;
    StageRegs<128, DK> rQ, rK; StageRegs<128, DV> rV; StageRegs<DK, DV> rS;
    stage_ld<128, DK>(rQ, MODE == 0 ? P + row0 * LDP + h * 64 : QKC + row0 * 768 + h * 96, MODE == 0 ? LDP : 768, t);
    stage_ld<128, DK>(rK, MODE == 0 ? P + row0 * LDP + 384 + h * 64 : QKC + row0 * 768 + 384 + h * 96, MODE == 0 ? LDP : 768, t);
    stage_ld<128, DV>(rV, P + row0 * LDP + 768 + h * DV, LDP, t);
    stage_ld<DK, DV>(rS, SIN + (size_t)unit * DK * DV, DV, t);
    float auxv = 0.f; if (MODE == 1) { if (t < 384) auxv = WSP(float, WS_ROUTE + RT_AUXG)[(size_t)unit * 512 + t]; else if (t < 384 + 96) auxv = WSP(float, WS_ROUTE + RT_NIN)[(size_t)unit * 96 + t - 384]; }
    f32x4 gnv = (f32x4){0.f, 0.f, 0.f, 0.f}; if (MODE == 1 && t < 48) gnv = *(const GAS f32x4*)(C.in[19] + h * DV + 4 * t);
    __syncthreads();
    if (MODE == 1) { if (t < 384) aux[t] = auxv; else if (t < 384 + 96) aux[512 + t - 384] = auxv; if (t < 48) *(LAS f32x4*)(aux + 640 + 4 * t) = gnv; }
    stage_st<128, DK, false>(rQ, L + Lm::Q, Lm::LDQK, nullptr, 1.0f, t);
    if (MODE == 0) stage_st<128, DK, true>(rK, L + Lm::K, Lm::LDQK, nullptr, 0.125f, t); else stage_st<128, DK, false>(rK, L + Lm::K, Lm::LDQK, nullptr, 1.0f, t);
    stage_st<128, DV, false>(rV, L + Lm::V, Lm::LDV, nullptr, 1.0f, t);
    stage_st<DK, DV, false>(rS, L + Lm::S, Lm::LDV, nullptr, 1.0f, t);
    __syncthreads();
    const int qt = w < 4 ? w : 11 - w;
    const int iq = 16 * qt + i;
    v2u gwv[NV];
    { const bf16* gp0 = P + (row0 + iq) * LDP + 1536 + h * DV + 4 * g;
#pragma unroll
      for (int vt = 0; vt < NV; ++vt) gwv[vt] = *(const GAS v2u*)(gp0 + 16 * vt); }
    float m_in_early = 0.f; if (MODE == 1) m_in_early = WSP(float, WS_ROUTE + RT_MIN)[unit];
    bf16x8 qf[NKS];
#pragma unroll
    for (int s = 0; s < NKS; ++s) qf[s] = frag_rows(L + Lm::Q, Lm::LDQK, 16 * qt, 64 * s, i, g);
    f32x4 o[NV];
#pragma unroll
    for (int vt = 0; vt < NV; ++vt) { o[vt] = (f32x4){0.f, 0.f, 0.f, 0.f};
#pragma unroll
        for (int s = 0; s < NKS; ++s) o[vt] = MFMA16(frag_tr(L + Lm::S, Lm::LDV, 32 * s, 32 * vt, i, g, false), qf[s], o[vt]); }
    float colscale, ri = 0.f, emi = 1.f, den = 0.f;
    const float l2g = MODE == 0 ? log2f(1.0f - exp2f(-5.0f - (float)h)) : 0.f;
    if (MODE == 0) colscale = exp2f((float)(iq + 1) * l2g);
    else { const float m_in = m_in_early; const float bi = aux[iq], mxc = fmaxf(m_in, aux[256 + iq]);
        ri = -mxc; colscale = __expf(m_in - mxc); emi = __expf(-(bi + mxc));
        float nq = 0.f;
#pragma unroll
        for (int s = 0; s < NKS; ++s) { const v4u qw = __builtin_bit_cast(v4u, qf[s]); const f32x4 n0 = *(const LAS f32x4*)(aux + 512 + 32 * s + 8 * g), n1 = *(const LAS f32x4*)(aux + 512 + 32 * s + 8 * g + 4);
            nq += bflo(qw.x) * n0[0] + bfhi(qw.x) * n0[1] + bflo(qw.y) * n0[2] + bfhi(qw.y) * n0[3] + bflo(qw.z) * n1[0] + bfhi(qw.z) * n1[1] + bflo(qw.w) * n1[2] + bfhi(qw.w) * n1[3]; }
        nq += __shfl_xor(nq, 16); nq += __shfl_xor(nq, 32);
        den = colscale * nq; }
#pragma unroll
    for (int vt = 0; vt < NV; ++vt) o[vt] = o[vt] * colscale;
    float dsum = 0.f;
#pragma unroll
    for (int pr = 0; pr < 4; ++pr) {
        if (2 * pr <= qt) {
            f32x4 st[2];
#pragma unroll
            for (int u = 0; u < 2; ++u) { const int tt = 2 * pr + u; st[u] = (f32x4){0.f, 0.f, 0.f, 0.f};
#pragma unroll
                for (int s = 0; s < NKS; ++s) st[u] = MFMA16(frag_rows(L + Lm::K, Lm::LDQK, 16 * tt, 64 * s, i, g), qf[s], st[u]);
                f32x4 cj; if (MODE == 1) cj = *(const LAS f32x4*)(aux + 128 + 16 * tt + 4 * g);
#pragma unroll
                for (int r = 0; r < 4; ++r) { const int j = 16 * tt + 4 * g + r; const bool valid = j <= iq;
                    const float wgt = MODE == 0 ? exp2f((float)(iq - j) * l2g) : __expf(fminf(ri + cj[r], 0.f));
                    st[u][r] = valid ? st[u][r] * wgt : 0.f; dsum += st[u][r]; } }
            const bf16x8 pb = pack_acc2(st[0], st[1]);
#pragma unroll
            for (int vt = 0; vt < NV; ++vt) o[vt] = MFMA16(frag_tr(L + Lm::V, Lm::LDV, 32 * pr, 32 * vt, i, g, true), pb, o[vt]);
        }
    }
    const size_t tok = row0 + iq; float ss = 0.f;
    if (MODE == 1) { dsum += __shfl_xor(dsum, 16); dsum += __shfl_xor(dsum, 32); den += dsum; const float inv = 1.0f / fmaxf(fabsf(den), emi);
#pragma unroll
        for (int vt = 0; vt < NV; ++vt) o[vt] = o[vt] * inv; }
#pragma unroll
    for (int vt = 0; vt < NV; ++vt) ss += (o[vt][0] * o[vt][0] + o[vt][1] * o[vt][1]) + (o[vt][2] * o[vt][2] + o[vt][3] * o[vt][3]);
    ss += __shfl_xor(ss, 16); ss += __shfl_xor(ss, 32);
    const float rs = 1.0f / sqrtf(ss * (1.0f / DV) + 1e-6f);
    bf16* op = MIX + tok * D + h * DV + 4 * g;
#pragma unroll
    for (int vt = 0; vt < NV; ++vt) { const v2u gw = gwv[vt]; float gv[4] = {bflo(gw.x), bfhi(gw.x), bflo(gw.y), bfhi(gw.y)}; float r4[4];
        if (MODE == 0) {
#pragma unroll
            for (int r = 0; r < 4; ++r) r4[r] = silu1(gv[r]) * o[vt][r] * rs; }
        else { const f32x4 gn = *(const LAS f32x4*)(aux + 640 + 16 * vt + 4 * g);
#pragma unroll
            for (int r = 0; r < 4; ++r) r4[r] = sigmoid1(gv[r]) * o[vt][r] * rs * gn[r]; }
        v2u wv; wv.x = cvtpk(r4[0], r4[1]); wv.y = cvtpk(r4[2], r4[3]); *(GAS v2u*)(op + 16 * vt) = wv; }
}

struct Args { const float* in[27]; float* out; unsigned char* ws; int ph_lo, ph_hi; };
static_assert(sizeof(Args) == 27 * 8 + 8 + 8 + 8, "Args has no padding");

#define GEMM_CALL(EpiT, SchedT, g, S, E) pg8::gemm_phase<EpiT, SchedT, true, true>(C.lds + RING_OFF, g, S, E)

__global__ void __launch_bounds__(NWAVES * 64, 2) trunk_fwd(Args args) {
    extern __shared__ __attribute__((aligned(16))) unsigned char lds_raw[];
    Ctx C;
    C.lds = (LAS unsigned char*)lds_raw;
    C.tid = threadIdx.x; C.lane = C.tid & 63; C.wave = __builtin_amdgcn_readfirstlane(C.tid >> 6);
    C.G = gridDim.x; C.bid = blockIdx.x; C.gw = C.bid * NWAVES + C.wave; C.NGW = C.G * NWAVES;
#pragma unroll
    for (int i = 0; i < 27; ++i) C.in[i] = args.in[i];
    C.out = args.out; C.ws = args.ws;
    volatile LAS unsigned* MISC = (volatile LAS unsigned*)(C.lds + MISC_OFF);
    for (int u = C.tid; u < (LDS_BYTES - LDSCTL_OFF) / 4; u += NWAVES * 64) ((LAS unsigned*)(C.lds + LDSCTL_OFF))[u] = 0u;
    __syncthreads();
    XcdBarrier bar; bar.bar = (unsigned*)(C.ws + WS_CTL) + CW_BAR; bar.x = 0; bar.st = nullptr;
    if (MK_SINGLE) bar = xcd_barrier_post((unsigned*)(C.ws + WS_CTL) + CW_BAR, MISC + 8);
    const int lo = args.ph_lo, hi = args.ph_hi;
#define IN(k) (lo <= (k) && (k) < hi)
#define DBL(k) (((DBL_MASK >> (k)) & 1ull) != 0ull)
#define SEAM(k) do { if (MK_SINGLE && IN((k) + 1)) xcd_barrier(bar); } while (0)
#define PH(k, ...) if (IN(k)) { __VA_ARGS__ if (DBL(k)) { for (int rep_ = 0; rep_ < DBL_REPS; ++rep_) { if (MK_SINGLE) xcd_barrier(bar); __VA_ARGS__ } } }

    bf16* HB = WSP(bf16, WS_HB); float* SS = WSP(float, WS_SS); bf16* Pb = WSP(bf16, WS_BIG + BIG_P); bf16* MIX = WSP(bf16, WS_BIG + BIG_MIX);
    float* SCR1 = WSP(float, WS_BIG + BIG_SCR1); bf16* QKC = WSP(bf16, WS_BIG + BIG_SCR2); bf16* SIN = WSP(bf16, WS_BIG + BIG_SCR2 + SCR2_STATE); bf16* HID = WSP(bf16, WS_BIG);
    const int* PANEL = WSP(int, WS_ROUTE + RT_PANEL); const int* NPp = WSP(int, WS_ROUTE + RT_NP); const float* SLOTRS = WSP(float, WS_ROUTE + RT_SLOTRS);

#define G_INPROJ(layer, NN) { pg8::Gemm g{HB, WSP(bf16, WS_WIN + WIN_OFF[layer]), M, NN, D}; pg8::StaticOrder S; S.init(M, NN, C.G, C.bid); \
        pg8::EpiScaleBf16 E{Pb, NN, SS, rstd_table(C, S, SS)}; GEMM_CALL(pg8::EpiScaleBf16, pg8::StaticOrder, g, S, E); }
#define G_OUTPROJ(layer) { pg8::Gemm g{MIX, WSP(bf16, WS_WOUT + (size_t)(layer) * 2 * MiB), M, D, D}; pg8::StaticOrder S; S.init(M, D, C.G, C.bid); \
        pg8::EpiResid E{HB, SS, (PG8_LAS float*)(C.lds + 131072)}; GEMM_CALL(pg8::EpiResid, pg8::StaticOrder, g, S, E); }
#define G_GATEUP_DENSE(j) { pg8::Gemm g{HB, WSP(bf16, WS_WFD + (j) * FD_STRIDE), M, 2 * FF, D}; pg8::StaticOrder S; S.init(M, 2 * FF, C.G, C.bid); \
        pg8::EpiSwiglu<false> E{HID, SS, rstd_table(C, S, SS)}; GEMM_CALL(pg8::EpiSwiglu<false>, pg8::StaticOrder, g, S, E); }
#define G_DOWN_DENSE(j) { pg8::Gemm g{HID, WSP(bf16, WS_WFD + (j) * FD_STRIDE + FD_WD), M, D, FF}; pg8::StaticOrder S; S.init(M, D, C.G, C.bid); \
        pg8::EpiResid E{HB, SS, (PG8_LAS float*)(C.lds + 131072)}; GEMM_CALL(pg8::EpiResid, pg8::StaticOrder, g, S, E); }
#define G_GATEUP_MOE(j) { pg8::Gemm g{HB, WSP(bf16, WS_WMOE + (j) * MOE_STRIDE), MAXSLOT, NE * 2 * FF, D, WSP(int, WS_ROUTE + RT_ROWTOK)}; pg8::MoeOrder S; S.init(NPp, PANEL, 28, C.G, C.bid); \
        pg8::EpiSwiglu<true> E{HID, SLOTRS, nullptr}; pg8::gemm_phase<pg8::EpiSwiglu<true>, pg8::MoeOrder, true, true, true>(C.lds + RING_OFF, g, S, E); }
#define G_DOWN_MOE(j) { pg8::Gemm g{HID, WSP(bf16, WS_WMOE + (j) * MOE_STRIDE + MOE_WD), MAXSLOT, NE * D, FF}; pg8::MoeOrder S; S.init(NPp, PANEL, 4, C.G, C.bid); \
        if (C.G == 256) S.max_rounds = 2; pg8::EpiYBf16 E{WSP(bf16, WS_Y)}; GEMM_CALL(pg8::EpiYBf16, pg8::MoeOrder, g, S, E); } \
    if (C.G == 256) { const int tail = C.bid / 7, ks = C.bid % 7; \
        pg8::Gemm g{HID + ks * 512, WSP(bf16, WS_WMOE + (j) * MOE_STRIDE + MOE_WD) + ks * 512, MAXSLOT, NE * D, 512, nullptr, FF}; \
        pg8::MoeOrder S; S.init(NPp, PANEL, 4, C.G, tail); S.first_round = 2; S.max_rounds = (C.bid < 224) ? 3 : 0; \
        pg8::EpiSlab E{WSP(float, WS_SLAB), WSP(int, WS_ROUTE + RT_TAILIDX), tail, ks}; GEMM_CALL(pg8::EpiSlab, pg8::MoeOrder, g, S, E); }
#define G_MEMKV() { pg8::Gemm g{WSP(bf16, WS_MEMN), WSP(bf16, WS_WMEM), MROWS, 2048, D}; pg8::StaticOrder S; S.init(MROWS, 2048, C.G, (C.bid + 16) % C.G); \
        pg8::EpiPlainBf16 E{WSP(bf16, WS_MKV), 2048}; GEMM_CALL(pg8::EpiPlainBf16, pg8::StaticOrder, g, S, E); }
#define MEMATTN(layer, NN) for (int u = C.bid; u < 256; u += C.G) attn_mem_pair(C, u, Pb, NN, C.in[5] + (layer) * 64, C.in[6] + (layer) * 64, layer, MIX);
#define FFN_DENSE(k, j) PH(k, G_GATEUP_DENSE(j) SEAM(k);) PH((k) + 1, G_DOWN_DENSE(j) SEAM((k) + 1);)
#define FFN_MOE(k, j, layer) PH(k, moe_route1(C, j, layer); SEAM(k);) PH((k) + 1, moe_route2(C); SEAM((k) + 1);) PH((k) + 2, G_GATEUP_MOE(j) SEAM((k) + 2);) \
        PH((k) + 3, G_DOWN_MOE(j) SEAM((k) + 3);) PH((k) + 4, moe_combine<(layer) == 3>(C); SEAM((k) + 4);)

    PH(0, p_prologue(C); SEAM(0);)
    PH(1, G_MEMKV() G_INPROJ(0, N_SWA) SEAM(1);)
    PH(2, for (int u = C.bid; u < 512; u += C.G) attn_swa_unit(C, u, Pb, N_SWA, C.in[10], C.in[11], C.in[12], 768, 1024, MIX);
          MEMATTN(0, N_SWA) SEAM(2);)
    PH(3, G_OUTPROJ(0) SEAM(3);)
    FFN_DENSE(4, 0)
#define IDLE_TP(win) if (C.G == 256 && C.bid >= 128) tp_run(C, TP_MOVED_LO + (win) * TP_WIN_N + C.bid - 128, 128, TP_MOVED_LO + ((win) + 1) * TP_WIN_N, 1 << 30, 0);
    PH(6, G_INPROJ(1, N_RET) IDLE_TP(0) SEAM(6);)
    PH(7, for (int u = C.bid; u < 768; u += C.G) chunk_state_unit<0>(C, u, Pb, nullptr, SCR1); MEMATTN(1, N_RET) SEAM(7);)
    PH(8, ret_scan(C, SCR1, SIN); SEAM(8);)
    PH(9, for (int u = C.bid; u < 768; u += C.G) chunk_out_unit<0>(C, u, Pb, nullptr, SIN, MIX); SEAM(9);)
    PH(10, G_OUTPROJ(1) SEAM(10);)
    FFN_MOE(11, 0, 1)
    PH(16, G_INPROJ(2, N_MLS) mls_gates(C); IDLE_TP(1) SEAM(16);)
    PH(17, mls_aux(C); mls_conv(C, Pb, QKC); SEAM(17);)
    PH(18, for (int u = C.bid; u < 512; u += C.G) chunk_state_unit<1>(C, u, Pb, QKC, SCR1); MEMATTN(2, N_MLS) SEAM(18);)
    PH(19, mls_scan(C, SCR1, SIN); SEAM(19);)
    PH(20, for (int u = C.bid; u < 512; u += C.G) chunk_out_unit<1>(C, u, Pb, QKC, SIN, MIX); SEAM(20);)
    PH(21, G_OUTPROJ(2) SEAM(21);)
    FFN_DENSE(22, 1)
    PH(24, G_INPROJ(3, N_SWA) IDLE_TP(2) SEAM(24);)
    PH(25, for (int u = C.bid; u < 512; u += C.G) attn_swa_unit(C, u, Pb, N_SWA, C.in[10] + 64, C.in[11] + 64, C.in[12] + 12, 768, 1024, MIX);
           MEMATTN(3, N_SWA) SEAM(25);)
    PH(26, G_OUTPROJ(3) SEAM(26);)
    FFN_MOE(27, 1, 3)
#undef IN
}

extern "C" void kernel_launch(void* const* d_in, const int* in_sizes, int n_in, void* d_out, int out_size, void* d_ws, size_t ws_size, hipStream_t stream) {
    static int grid = 0;
    if (grid == 0) {
        if (n_in != 27 || in_sizes[0] != M * D || out_size != M * D || ws_size < WS_END) { fprintf(stderr, "kernel_launch: unexpected shapes (n_in %d, in0 %d, out %d, ws %zu < %zu)\n", n_in, n_in > 0 ? in_sizes[0] : -1, out_size, ws_size, (size_t)WS_END); grid = -1; return; }
        int dev = 0, cus = 0, per_cu = 0;
        if (hipGetDevice(&dev) != hipSuccess || hipDeviceGetAttribute(&cus, hipDeviceAttributeMultiprocessorCount, dev) != hipSuccess) { grid = -1; return; }
        if (hipFuncSetAttribute((const void*)trunk_fwd, hipFuncAttributeMaxDynamicSharedMemorySize, LDS_BYTES) != hipSuccess) { fprintf(stderr, "kernel_launch: hipFuncSetAttribute failed\n"); grid = -1; return; }
        if (hipOccupancyMaxActiveBlocksPerMultiprocessor(&per_cu, (const void*)trunk_fwd, NWAVES * 64, LDS_BYTES) != hipSuccess || per_cu < 1) fprintf(stderr, "kernel_launch: occupancy query says %d\n", per_cu);
        (void)hipGetLastError();
        grid = cus;
    }
    if (grid < 0) return;
    if (hipMemsetAsync((char*)d_ws + WS_CTL, 0, CTL_ZERO_BYTES, stream) != hipSuccess) return;
    Args a{};
    for (int i = 0; i < 27; ++i) a.in[i] = (const float*)d_in[i];
    a.out = (float*)d_out; a.ws = (unsigned char*)d_ws;
    if (MK_SINGLE) { a.ph_lo = 0; a.ph_hi = NPHASE; hipLaunchKernelGGL(trunk_fwd, dim3(grid), dim3(NWAVES * 64), LDS_BYTES, stream, a); }
    else for (int p = 0; p < NPHASE; ++p) { a.ph_lo = p; a.ph_hi = p + 1; hipLaunchKernelGGL(trunk_fwd, dim3(grid), dim3(NWAVES * 64), LDS_BYTES, stream, a); }
}
```

```cpp
#include <hip/hip_runtime.h>
#include <cstdio>
#include <cstdint>
namespace pg8 {
#define PG8_LAS __attribute__((address_space(3)))
typedef unsigned short bf16_t;
typedef short bf16x8 __attribute__((ext_vector_type(8)));
typedef float f32x4 __attribute__((ext_vector_type(4)));
typedef unsigned u32x4 __attribute__((ext_vector_type(4)));
constexpr int BM = 256, BK = 64, HALF = 128, HTB = HALF * BK * 2  , STAGE_BYTES = 8 * HTB, NXCD = 8, WGM = 8;

__host__ __device__ __forceinline__ int lds_byte(int r, int c) { const int st = (r >> 4) * 2 + (c >> 5), rr = r & 15, cc = c & 31, ob = rr * 64 + cc * 2; return st * 1024 + (ob ^ (((ob >> 9) & 1) << 5)); }
__host__ __device__ __forceinline__ void stage_rc(int b, int& R, int& C) { const int st = b / 1024, sb = b % 1024, swz = sb ^ (((sb >> 9) & 1) << 5); R = (st >> 1) * 16 + swz / 64; C = (st & 1) * 32 + (swz % 64) / 2; }
__host__ __device__ __forceinline__ int perm32(int rho) { const int n = rho >> 4, i = rho & 15; return 8 * (i >> 2) + 4 * n + (i & 3); }

struct Unit { int pm, pn; };
struct Gemm { const bf16_t* A; const bf16_t* Bt; int M, N, K; const int* rowmap; int ld; };

struct StaticOrder {
    int nM, nN, nwg, G, c;
    __host__ __device__ void init(int M, int N, int G_, int c_) { nM = M / BM; nN = N / BM; nwg = nM * nN; G = G_; c = c_; }
    __host__ __device__ bool next(int i, Unit& u) const {
        const long L = (long)i * G + c; if (L >= nwg) return false;
        int wgid = (int)L; { const int q = nwg / NXCD, r = nwg % NXCD, xcd = wgid % NXCD, off = wgid / NXCD; wgid = (xcd < r ? xcd * (q + 1) : r * (q + 1) + (xcd - r) * q) + off; }
        const int nig = WGM * nN, gid = wgid / nig, fm = gid * WGM, gsz = (nM - fm) < WGM ? (nM - fm) : WGM;
        u.pm = fm + ((wgid % nig) % gsz); u.pn = (wgid % nig) / gsz; return true;
    }
    __device__ __forceinline__ void a_ready(const Unit&) const {}
    __device__ __forceinline__ void done(const Unit&) const {}
};

__device__ __forceinline__ unsigned cvt_pk_bf16(float lo, float hi) { unsigned r; asm volatile("v_cvt_pk_bf16_f32 %0, %1, %2" : "=v"(r) : "v"(lo), "v"(hi)); return r; }
__device__ __forceinline__ float row_rstd16(const float* SS, int row) {
    const f32x4 a = *(const f32x4*)(SS + (size_t)row * 4);
    return 1.0f / sqrtf(((a[0] + a[1]) + (a[2] + a[3])) * (1.0f / 1024.0f) + 1e-6f);
}
typedef float f32x2 __attribute__((ext_vector_type(2)));

struct EpiPlainBf16 {
    static constexpr bool PERM = true, AFTER_DRAIN = false;
    bf16_t* O; int ldc;
    __device__ __forceinline__ void operator()(const f32x4 (&acc)[2][2][4][2], const Unit& u, int wr, int wc, int fr, int fq) const {
        const int row0 = u.pm * BM + wr * 64 + fr, col0 = u.pn * BM + wc * 32 + 8 * fq;
#pragma unroll
        for (int ai = 0; ai < 2; ++ai)
#pragma unroll
            for (int m = 0; m < 4; ++m) { bf16_t* rowp = O + (size_t)(row0 + ai * HALF + m * 16) * ldc + col0;
#pragma unroll
                for (int bj = 0; bj < 2; ++bj) { const f32x4 v0 = acc[ai][bj][m][0], v1 = acc[ai][bj][m][1];
                    u32x4 w; w.x = cvt_pk_bf16(v0[0], v0[1]); w.y = cvt_pk_bf16(v0[2], v0[3]); w.z = cvt_pk_bf16(v1[0], v1[1]); w.w = cvt_pk_bf16(v1[2], v1[3]);
                    *(u32x4*)(rowp + bj * HALF) = w; } }
    }
};
struct EpiScaleBf16 {
    static constexpr bool PERM = true, AFTER_DRAIN = false;
    bf16_t* O; int ldc; const float* SS; const PG8_LAS float* rsl;
    __device__ __forceinline__ void operator()(const f32x4 (&acc)[2][2][4][2], const Unit& u, int wr, int wc, int fr, int fq) const {
        const int row0 = u.pm * BM + wr * 64 + fr, col0 = u.pn * BM + wc * 32 + 8 * fq;
#pragma unroll
        for (int ai = 0; ai < 2; ++ai)
#pragma unroll
            for (int m = 0; m < 4; ++m) { const int row = row0 + ai * HALF + m * 16; const float sc = rsl ? rsl[row & 255] : row_rstd16(SS, row); bf16_t* rowp = O + (size_t)row * ldc + col0;
#pragma unroll
                for (int bj = 0; bj < 2; ++bj) { const f32x4 v0 = acc[ai][bj][m][0] * sc, v1 = acc[ai][bj][m][1] * sc;
                    u32x4 w; w.x = cvt_pk_bf16(v0[0], v0[1]); w.y = cvt_pk_bf16(v0[2], v0[3]); w.z = cvt_pk_bf16(v1[0], v1[1]); w.w = cvt_pk_bf16(v1[2], v1[3]);
                    *(u32x4*)(rowp + bj * HALF) = w; } }
    }
};
struct EpiResid {
    static constexpr bool PERM = true, AFTER_DRAIN = false;
    bf16_t* HB; float* SS; PG8_LAS float* xs;
    __device__ __forceinline__ void operator()(const f32x4 (&acc)[2][2][4][2], const Unit& u, int wr, int wc, int fr, int fq) const {
        const int row0 = u.pm * BM + wr * 64 + fr, col0 = u.pn * BM + wc * 32 + 8 * fq;
        u32x4 hv[2][4][2];
#pragma unroll
        for (int ai = 0; ai < 2; ++ai)
#pragma unroll
            for (int m = 0; m < 4; ++m) { const bf16_t* bp = HB + (size_t)(row0 + ai * HALF + m * 16) * 1024 + col0;
                hv[ai][m][0] = *(const u32x4*)bp; hv[ai][m][1] = *(const u32x4*)(bp + HALF); }
#pragma unroll
        for (int ai = 0; ai < 2; ++ai)
#pragma unroll
            for (int m = 0; m < 4; ++m) { const int row = row0 + ai * HALF + m * 16; bf16_t* bp = HB + (size_t)row * 1024 + col0; float ss = 0.f;
#pragma unroll
                for (int bj = 0; bj < 2; ++bj) { const u32x4 hw = hv[ai][m][bj];
                    f32x4 h0 = (f32x4){__uint_as_float(hw.x << 16), __uint_as_float(hw.x & 0xffff0000u), __uint_as_float(hw.y << 16), __uint_as_float(hw.y & 0xffff0000u)};
                    f32x4 h1 = (f32x4){__uint_as_float(hw.z << 16), __uint_as_float(hw.z & 0xffff0000u), __uint_as_float(hw.w << 16), __uint_as_float(hw.w & 0xffff0000u)};
                    h0 = h0 + acc[ai][bj][m][0]; h1 = h1 + acc[ai][bj][m][1];
                    ss += ((h0[0] * h0[0] + h0[1] * h0[1]) + (h0[2] * h0[2] + h0[3] * h0[3])) + ((h1[0] * h1[0] + h1[1] * h1[1]) + (h1[2] * h1[2] + h1[3] * h1[3]));
                    u32x4 w; w.x = cvt_pk_bf16(h0[0], h0[1]); w.y = cvt_pk_bf16(h0[2], h0[3]); w.z = cvt_pk_bf16(h1[0], h1[1]); w.w = cvt_pk_bf16(h1[2], h1[3]);
                    *(u32x4*)(bp + bj * HALF) = w; }
                ss += __shfl_xor(ss, 16); ss += __shfl_xor(ss, 32);
                if (fq == 0) xs[(ai * HALF + wr * 64 + m * 16 + fr) * 4 + wc] = ss; }
        asm volatile("s_waitcnt lgkmcnt(0)" ::: "memory"); __builtin_amdgcn_s_barrier(); asm volatile("" ::: "memory");
        if (threadIdx.x < 256) { const f32x4 v = *(const PG8_LAS f32x4*)(xs + 4 * threadIdx.x); SS[(size_t)(u.pm * BM + threadIdx.x) * 4 + u.pn] = (v[0] + v[1]) + (v[2] + v[3]); }
    }
};
template <bool MOE> struct EpiSwiglu {
    static constexpr bool PERM = true, AFTER_DRAIN = false;
    bf16_t* O; const float* RS; const PG8_LAS float* rsl;
    static __device__ __forceinline__ f32x2 swi2(f32x2 g, f32x2 u, float nsc, float sc2) {
        const f32x2 t = g * nsc; f32x2 d; d.x = __builtin_amdgcn_exp2f(t.x); d.y = __builtin_amdgcn_exp2f(t.y); d = d + 1.0f;
        f32x2 r; r.x = __builtin_amdgcn_rcpf(d.x); r.y = __builtin_amdgcn_rcpf(d.y);
        return ((g * u) * sc2) * r;
    }
    __device__ __forceinline__ void operator()(const f32x4 (&acc)[2][2][4][2], const Unit& u, int wr, int wc, int fr, int fq) const {
        const int pnl = MOE ? (u.pn % 28) : u.pn;
        const int row0 = u.pm * BM + wr * 64 + fr, col0 = pnl * HALF + wc * 32 + 8 * fq;
        float scv[2][4];
#pragma unroll
        for (int ai = 0; ai < 2; ++ai)
#pragma unroll
            for (int m = 0; m < 4; ++m) { const int row = row0 + ai * HALF + m * 16; scv[ai][m] = MOE ? RS[row] : (rsl ? rsl[row & 255] : row_rstd16(RS, row)); }
#pragma unroll
        for (int ai = 0; ai < 2; ++ai)
#pragma unroll
            for (int m = 0; m < 4; ++m) { const int row = row0 + ai * HALF + m * 16; const float sc = scv[ai][m], nsc = -1.4426950408889634f * sc, sc2 = sc * sc;
                const f32x4 g0 = acc[ai][0][m][0], g1 = acc[ai][0][m][1], u0 = acc[ai][1][m][0], u1 = acc[ai][1][m][1];
                const f32x2 a = swi2((f32x2){g0[0], g0[1]}, (f32x2){u0[0], u0[1]}, nsc, sc2), b = swi2((f32x2){g0[2], g0[3]}, (f32x2){u0[2], u0[3]}, nsc, sc2);
                const f32x2 c = swi2((f32x2){g1[0], g1[1]}, (f32x2){u1[0], u1[1]}, nsc, sc2), d = swi2((f32x2){g1[2], g1[3]}, (f32x2){u1[2], u1[3]}, nsc, sc2);
                u32x4 w; w.x = cvt_pk_bf16(a.x, a.y); w.y = cvt_pk_bf16(b.x, b.y); w.z = cvt_pk_bf16(c.x, c.y); w.w = cvt_pk_bf16(d.x, d.y);
                *(u32x4*)(O + (size_t)row * 3584 + col0) = w; }
    }
};
struct EpiYBf16 {
    static constexpr bool PERM = true, AFTER_DRAIN = false;
    bf16_t* Y;
    __device__ __forceinline__ void operator()(const f32x4 (&acc)[2][2][4][2], const Unit& u, int wr, int wc, int fr, int fq) const {
        const int pnl = u.pn & 3;
        const int row0 = u.pm * BM + wr * 64 + fr, col0 = pnl * BM + wc * 32 + 8 * fq;
#pragma unroll
        for (int ai = 0; ai < 2; ++ai)
#pragma unroll
            for (int m = 0; m < 4; ++m) { bf16_t* yp = Y + (size_t)(row0 + ai * HALF + m * 16) * 1024 + col0;
#pragma unroll
                for (int bj = 0; bj < 2; ++bj) { const f32x4 v0 = acc[ai][bj][m][0], v1 = acc[ai][bj][m][1];
                    u32x4 w; w.x = cvt_pk_bf16(v0[0], v0[1]); w.y = cvt_pk_bf16(v0[2], v0[3]); w.z = cvt_pk_bf16(v1[0], v1[1]); w.w = cvt_pk_bf16(v1[2], v1[3]);
                    *(u32x4*)(yp + bj * HALF) = w; } }
    }
};
struct EpiSlab {
    static constexpr bool PERM = true, AFTER_DRAIN = false;
    float* S; int* tailidx; int tail, ks;
    __device__ __forceinline__ void operator()(const f32x4 (&acc)[2][2][4][2], const Unit& u, int wr, int wc, int fr, int fq) const {
        float* sp = S + (size_t)(tail * 7 + ks) * 65536; const int row0 = wr * 64 + fr, col0 = wc * 32 + 8 * fq;
        if (ks == 0 && threadIdx.x == 0) tailidx[u.pm * 4 + (u.pn & 3)] = tail;
#pragma unroll
        for (int ai = 0; ai < 2; ++ai)
#pragma unroll
            for (int m = 0; m < 4; ++m) { float* yp = sp + (size_t)(row0 + ai * HALF + m * 16) * 256 + col0;
#pragma unroll
                for (int bj = 0; bj < 2; ++bj) { *(f32x4*)(yp + bj * HALF) = acc[ai][bj][m][0]; *(f32x4*)(yp + bj * HALF + 4) = acc[ai][bj][m][1]; } }
    }
};
struct MoeOrder {
    StaticOrder so; const int* panel_e; int ntn, max_rounds, first_round;
    __device__ void init(const int* np_ptr, const int* panel_e_, int ntn_, int G, int c) { const int np = __builtin_amdgcn_readfirstlane(*np_ptr); so.init(np * BM, ntn_ * BM, G, c); panel_e = panel_e_; ntn = ntn_; max_rounds = 1 << 20; first_round = 0; }
    __device__ bool next(int i, Unit& u) const { i += first_round; if (i >= max_rounds || !so.next(i, u)) return false; const int e = __builtin_amdgcn_readfirstlane(panel_e[u.pm]); u.pn += e * ntn; return true; }
    __device__ __forceinline__ void a_ready(const Unit&) const {}
    __device__ __forceinline__ void done(const Unit&) const {}
};
template <class Epi, class Sched, bool ALIGN_EPI = false, bool SP2 = false, bool GATHER = false>
__device__ __forceinline__ void gemm_phase(PG8_LAS unsigned char* lds, const Gemm g, const Sched& S, const Epi& E) {
    const int tid = threadIdx.x, wid = __builtin_amdgcn_readfirstlane(tid >> 6), lane = tid & 63, wr = wid >> 2, wc = wid & 3, fr = lane & 15, fq = lane >> 4;
    const int K = g.K, nt = K / BK, LD = g.ld ? g.ld : g.K;
    unsigned voffA[2], voffB[2]; int gR[2]; unsigned gC[2];
#pragma unroll
    for (int i = 0; i < 2; ++i) { int R, C; stage_rc(tid * 16 + i * 8192, R, C); const int Rb = Epi::PERM ? ((R & ~31) + perm32(R & 31)) : R;
        voffA[i] = (unsigned)(R * LD + C) * 2u; voffB[i] = (unsigned)(Rb * LD + C) * 2u; gR[i] = R; gC[i] = (unsigned)C * 2u; }
    const size_t kstep = (size_t)(BK * 2);
    const size_t hstep = (size_t)HALF * LD * 2;
    const size_t tstep = 2 * hstep;
    const unsigned ldsw = (unsigned)wid * 1024u;
    const int aoff = lds_byte(wr * 64 + fr, fq * 8), boff = lds_byte(wc * 32 + fr, fq * 8);
#define PG8_SA(b, h) (((b) * 2 + (h)) * HTB)
#define PG8_SB(b, h) ((4 + (b) * 2 + (h)) * HTB)
#define PG8_STAGE(bufoff, gbase, voff) do { _Pragma("unroll") for (int _i = 0; _i < 2; ++_i) \
        __builtin_amdgcn_global_load_lds((const unsigned*)((const char*)(gbase) + (voff)[_i]), (PG8_LAS unsigned*)(lds + (bufoff) + ldsw + _i * 8192), 16, 0, 0); } while (0)
#define PG8_GOFF(dst, pm_) do { _Pragma("unroll") for (int _h = 0; _h < 2; ++_h) _Pragma("unroll") for (int _i = 0; _i < 2; ++_i) \
        dst[_h][_i] = (unsigned)g.rowmap[(pm_) * BM + _h * HALF + gR[_i]] * (unsigned)(LD * 2) + gC[_i]; } while (0)
#define PG8_STAGE_A(bufoff, ptr, half, nx) do { if constexpr (GATHER) { const unsigned _o0 = (nx) ? gvN[half][0] : gvC[half][0], _o1 = (nx) ? gvN[half][1] : gvC[half][1]; \
        __builtin_amdgcn_global_load_lds((const unsigned*)((const char*)(ptr) + _o0), (PG8_LAS unsigned*)(lds + (bufoff) + ldsw), 16, 0, 0); \
        __builtin_amdgcn_global_load_lds((const unsigned*)((const char*)(ptr) + _o1), (PG8_LAS unsigned*)(lds + (bufoff) + ldsw + 8192), 16, 0, 0); } \
        else { PG8_STAGE(bufoff, (ptr) + (half) * hstep, voffA); } } while (0)
#define PG8_LDA(dst, b, h) do { _Pragma("unroll") for (int m = 0; m < 4; ++m) _Pragma("unroll") for (int k = 0; k < 2; ++k) dst[m][k] = *(const PG8_LAS bf16x8*)(lds + PG8_SA(b, h) + aoff + m * 2048 + k * 1024); } while (0)
#define PG8_LDB(dst, b, h) do { _Pragma("unroll") for (int n = 0; n < 2; ++n) _Pragma("unroll") for (int k = 0; k < 2; ++k) dst[n][k] = *(const PG8_LAS bf16x8*)(lds + PG8_SB(b, h) + boff + n * 2048 + k * 1024); } while (0)
#define PG8_MMA(ai, bj, At, Bt) do { __builtin_amdgcn_s_setprio(1); _Pragma("unroll") for (int m = 0; m < 4; ++m) _Pragma("unroll") for (int n = 0; n < 2; ++n) _Pragma("unroll") for (int k = 0; k < 2; ++k) \
        acc[ai][bj][m][n] = __builtin_amdgcn_mfma_f32_16x16x32_bf16(Bt[n][k], At[m][k], acc[ai][bj][m][n], 0, 0, 0); __builtin_amdgcn_s_setprio(0); } while (0)
#define PG8_WAIT_V(n) asm volatile("s_waitcnt vmcnt(" #n ")" ::: "memory")
#define PG8_WAIT_L(n) asm volatile("s_waitcnt lgkmcnt(" #n ")" ::: "memory")
#define PG8_BAR __builtin_amdgcn_s_barrier()
#define PG8_SCHED __builtin_amdgcn_sched_barrier(0)
    Unit cur, nxt; int ui = 0;
    if (!S.next(0, cur)) return;
    f32x4 acc[2][2][4][2];
#pragma unroll
    for (int a = 0; a < 2; ++a)
#pragma unroll
        for (int b = 0; b < 2; ++b)
#pragma unroll
            for (int m = 0; m < 4; ++m)
#pragma unroll
                for (int n = 0; n < 2; ++n) acc[a][b][m][n] = (f32x4){0.f, 0.f, 0.f, 0.f};
    bf16x8 At[4][2], B0[2][2], B1[2][2];
    unsigned gvC[2][2], gvN[2][2]; if constexpr (GATHER) { PG8_GOFF(gvC, cur.pm); PG8_GOFF(gvN, cur.pm); }
    const char* cA = GATHER ? (const char*)g.A : (const char*)g.A + (size_t)cur.pm * tstep; const char* cB = (const char*)g.Bt + (size_t)cur.pn * tstep;
    S.a_ready(cur);
    if constexpr (SP2) {
        PG8_STAGE(PG8_SB(0, 0), cB, voffB); PG8_STAGE(PG8_SB(0, 1), cB + hstep, voffB); PG8_STAGE_A(PG8_SA(0, 0), cA, 0, false); PG8_STAGE_A(PG8_SA(0, 1), cA, 1, false);
        if (wr == 1) PG8_BAR;
        PG8_WAIT_V(2); PG8_BAR;
        PG8_STAGE(PG8_SB(1, 0), cB + kstep, voffB); PG8_STAGE_A(PG8_SA(1, 0), cA + kstep, 0, false); PG8_STAGE(PG8_SB(1, 1), cB + hstep + kstep, voffB);
        PG8_WAIT_V(6); PG8_BAR;
    } else {
        PG8_STAGE(PG8_SB(0, 0), cB, voffB); PG8_STAGE_A(PG8_SA(0, 0), cA, 0, false); PG8_STAGE(PG8_SB(0, 1), cB + hstep, voffB); PG8_STAGE_A(PG8_SA(0, 1), cA, 1, false);
        if (wr == 1) PG8_BAR;
        PG8_WAIT_V(4); PG8_BAR;
        PG8_STAGE(PG8_SB(1, 0), cB + kstep, voffB); PG8_STAGE_A(PG8_SA(1, 0), cA + kstep, 0, false); PG8_STAGE(PG8_SB(1, 1), cB + hstep + kstep, voffB);
        PG8_WAIT_V(6); PG8_BAR;
    }
    for (;;) {
        const bool has_next = S.next(ui + 1, nxt);
        if constexpr (GATHER) { if (has_next) { PG8_GOFF(gvN, nxt.pm); } else { _Pragma("unroll") for (int _h = 0; _h < 2; ++_h) { gvN[_h][0] = gvC[_h][0]; gvN[_h][1] = gvC[_h][1]; } } }
        const char* nA = GATHER ? (const char*)g.A : (has_next ? (const char*)g.A + (size_t)nxt.pm * tstep : cA); const char* nB = has_next ? (const char*)g.Bt + (size_t)nxt.pn * tstep : cB;
        for (int t = 0; t < nt; t += 2) {
            const bool last = (t == nt - 2);
            const char* a1 = cA + (size_t)(t + 1) * kstep;
            const char* a2 = last ? nA : cA + (size_t)(t + 2) * kstep; const char* b2 = last ? nB : cB + (size_t)(t + 2) * kstep;
            const char* a3 = a2 + kstep; const char* b3 = b2 + kstep;
            if (last && has_next) S.a_ready(nxt);
            if constexpr (SP2) {
            PG8_LDB(B0, 0, 0); PG8_LDB(B1, 0, 1); PG8_SCHED; PG8_LDA(At, 0, 0); PG8_STAGE_A(PG8_SA(1, 1), a1, 1, false);
            PG8_WAIT_V(8); PG8_WAIT_L(0); PG8_BAR; PG8_MMA(0, 0, At, B0); PG8_MMA(0, 1, At, B1); PG8_BAR; PG8_SCHED;
            PG8_LDA(At, 0, 1); PG8_STAGE(PG8_SB(0, 0), b2, voffB); PG8_STAGE(PG8_SB(0, 1), b2 + hstep, voffB); PG8_STAGE_A(PG8_SA(0, 0), a2, 0, last);
            PG8_WAIT_V(8); PG8_WAIT_L(0); PG8_BAR; PG8_MMA(1, 0, At, B0); PG8_MMA(1, 1, At, B1); PG8_BAR; PG8_SCHED;
            PG8_LDB(B0, 1, 0); PG8_LDB(B1, 1, 1); PG8_SCHED; PG8_LDA(At, 1, 0); PG8_STAGE_A(PG8_SA(0, 1), a2, 1, last);
            PG8_WAIT_V(8); PG8_WAIT_L(0); PG8_BAR; PG8_MMA(0, 0, At, B0); PG8_MMA(0, 1, At, B1); PG8_BAR; PG8_SCHED;
            PG8_LDA(At, 1, 1); PG8_STAGE(PG8_SB(1, 0), b3, voffB); PG8_STAGE(PG8_SB(1, 1), b3 + hstep, voffB); PG8_STAGE_A(PG8_SA(1, 0), a3, 0, last);
            PG8_WAIT_V(8); PG8_WAIT_L(0); PG8_BAR; PG8_MMA(1, 0, At, B0); PG8_MMA(1, 1, At, B1); PG8_BAR; PG8_SCHED;
            } else {
            PG8_LDB(B0, 0, 0); PG8_SCHED; PG8_LDA(At, 0, 0); PG8_STAGE_A(PG8_SA(1, 1), a1, 1, false);
            PG8_WAIT_L(8); PG8_BAR; PG8_WAIT_L(0); PG8_MMA(0, 0, At, B0); PG8_BAR; PG8_SCHED;
            PG8_LDB(B1, 0, 1); PG8_STAGE(PG8_SB(0, 0), b2, voffB);
            PG8_BAR; PG8_WAIT_L(0); PG8_MMA(0, 1, At, B1); PG8_BAR;
            PG8_LDA(At, 0, 1); PG8_STAGE_A(PG8_SA(0, 0), a2, 0, last);
            PG8_BAR; PG8_WAIT_L(0); PG8_MMA(1, 0, At, B0); PG8_BAR; PG8_SCHED;
            PG8_STAGE(PG8_SB(0, 1), b2 + hstep, voffB);
            PG8_WAIT_V(6); PG8_BAR; PG8_MMA(1, 1, At, B1); PG8_BAR;
            PG8_LDB(B0, 1, 0); PG8_SCHED; PG8_LDA(At, 1, 0); PG8_STAGE_A(PG8_SA(0, 1), a2, 1, last);
            PG8_WAIT_L(8); PG8_BAR; PG8_WAIT_L(0); PG8_MMA(0, 0, At, B0); PG8_BAR; PG8_SCHED;
            PG8_LDB(B1, 1, 1); PG8_STAGE(PG8_SB(1, 0), b3, voffB);
            PG8_BAR; PG8_WAIT_L(0); PG8_MMA(0, 1, At, B1); PG8_BAR;
            PG8_LDA(At, 1, 1); PG8_STAGE_A(PG8_SA(1, 0), a3, 0, last);
            PG8_BAR; PG8_WAIT_L(0); PG8_MMA(1, 0, At, B0); PG8_BAR; PG8_SCHED;
            PG8_STAGE(PG8_SB(1, 1), b3 + hstep, voffB);
            PG8_WAIT_V(6); PG8_BAR; PG8_MMA(1, 1, At, B1); PG8_BAR;
            }
        }
        if constexpr (ALIGN_EPI) { if (wr == 0) PG8_BAR; }
        if constexpr (!Epi::AFTER_DRAIN) { E(acc, cur, wr, wc, fr, fq); S.done(cur); }
        if (!has_next) break;
#pragma unroll
        for (int a = 0; a < 2; ++a)
#pragma unroll
            for (int b = 0; b < 2; ++b)
#pragma unroll
                for (int m = 0; m < 4; ++m)
#pragma unroll
                    for (int n = 0; n < 2; ++n) acc[a][b][m][n] = (f32x4){0.f, 0.f, 0.f, 0.f};
        cur = nxt; cA = nA; cB = nB; ++ui;
        if constexpr (GATHER) { _Pragma("unroll") for (int _h = 0; _h < 2; ++_h) { gvC[_h][0] = gvN[_h][0]; gvC[_h][1] = gvN[_h][1]; } }
        if constexpr (ALIGN_EPI) { if (wr == 1) PG8_BAR; }
    }
    PG8_WAIT_V(0);
    if constexpr (!ALIGN_EPI) { if (wr == 0) PG8_BAR; }
    PG8_BAR;
    if constexpr (Epi::AFTER_DRAIN) { E.fused(acc, cur, wr, wc, fr, fq, lds, wid, lane); S.done(cur); }
#undef PG8_SA
#undef PG8_SB
#undef PG8_STAGE
#undef PG8_GOFF
#undef PG8_STAGE_A
#undef PG8_LDA
#undef PG8_LDB
#undef PG8_MMA
#undef PG8_WAIT_V
#undef PG8_WAIT_L
#undef PG8_BAR
#undef PG8_SCHED
}
}
constexpr int NWAVES = 8;
constexpr int BATCH = 2, SEQ = 8192, D = 1024, M = BATCH * SEQ, FF = 3584, NE = 8, MEMT = 256, MROWS = BATCH * MEMT;
constexpr int N_SWA = 1536, N_RET = 2560, N_MLS = 2560, MLS_SRC = 2568;
constexpr int MAXSLOT = 2 * M + NE * 256;
constexpr int NPHASE = 32;
#ifndef DBL_MASK
#define DBL_MASK 0ull
#endif
#ifndef DBL_REPS
#define DBL_REPS 1
#endif
#ifndef MK_SINGLE
#define MK_SINGLE 1
#endif
constexpr size_t MiB = 1u << 20, KiB = 1024;
constexpr size_t WS_CTL = 0, CTL_ZERO_BYTES = 32 * KiB;
constexpr size_t WS_SS = 1 * MiB, WS_MEMN = 2 * MiB, WS_MKV = 3 * MiB, WS_ROUTE = 5 * MiB;
constexpr size_t RT_SEL = 0, RT_RSTD = 256 * KiB, RT_CNT = 320 * KiB, RT_PANEL = 328 * KiB, RT_NP = 329 * KiB, RT_TOKSLOT = 384 * KiB, RT_ROWTOK = 512 * KiB, RT_SLOTRS = 704 * KiB, RT_TAILIDX = 896 * KiB, RT_GATES = 1 * MiB, RT_AUXG = 2304 * KiB;
constexpr size_t WS_WIN = 8 * MiB, WS_WOUT = 24 * MiB, WS_WMEM = 32 * MiB, WS_WFD = 36 * MiB, WS_WMOE = 78 * MiB;
constexpr size_t WIN_OFF[4] = {0, 3 * MiB, 8 * MiB, 13 * MiB};
constexpr size_t FD_STRIDE = 21 * MiB, FD_WD = 14 * MiB, MOE_STRIDE = 168 * MiB, MOE_WD = 112 * MiB;
constexpr size_t WS_HB = 414 * MiB, WS_BIG = 446 * MiB, WS_Y = 684 * MiB, WS_SLAB = 820 * MiB, WS_END = 876 * MiB;
constexpr size_t BIG_P = 0, BIG_MIX = 80 * MiB, BIG_SCR1 = 112 * MiB, BIG_SCR2 = 160 * MiB;
constexpr int CW_BAR = 4096;
constexpr int RING_OFF = 0, RING_BYTES = 163328;
constexpr int LDSCTL_OFF = RING_BYTES, MISC_OFF = LDSCTL_OFF + 320;
constexpr int LDS_BYTES = 163840;


#define GAS __attribute__((address_space(1)))
#define LAS __attribute__((address_space(3)))
typedef unsigned short bf16;
typedef unsigned v4u __attribute__((ext_vector_type(4)));
typedef float f32x4 __attribute__((ext_vector_type(4)));
typedef short bf16x8 __attribute__((ext_vector_type(8)));
typedef GAS unsigned gu32;
typedef GAS unsigned long long gu64;
#define RLX_AGENT __ATOMIC_RELAXED, __HIP_MEMORY_SCOPE_AGENT
#define LDS_WAIT() asm volatile("s_waitcnt lgkmcnt(0)" ::: "memory")
#define VM_WAIT() asm volatile("s_waitcnt vmcnt(0)" ::: "memory")
__device__ __forceinline__ unsigned long long rt() { return __builtin_amdgcn_s_memrealtime(); }
__device__ __forceinline__ unsigned f2bf(float f) { unsigned u = __builtin_bit_cast(unsigned, f); return (u + 0x7fffu + ((u >> 16) & 1u)) >> 16; }
__device__ __forceinline__ unsigned pk2(float lo, float hi) { return f2bf(lo) | (f2bf(hi) << 16); }

#define XB_TMO      128
#define XB_XCNT(j)  (256  + 64 * (j))
#define XB_XSUB(j)  (1280 + 64 * (j))
#define XB_XGEN(j)  (2304 + 64 * (j))
#define XB_TOP      3328
#define XB_TOPGEN   3392
#define XCD_BAR_WORDS 3456
#define XB_SPIN_CAP (1u << 18)

__device__ __forceinline__ unsigned xb_ld(unsigned* p)              { return __hip_atomic_load(p, __ATOMIC_RELAXED, __HIP_MEMORY_SCOPE_AGENT); }
__device__ __forceinline__ unsigned xb_add(unsigned* p, unsigned v) { return __hip_atomic_fetch_add(p, v, __ATOMIC_RELAXED, __HIP_MEMORY_SCOPE_AGENT); }
__device__ __forceinline__ unsigned xb_xcc_id() { return (unsigned)__builtin_amdgcn_s_getreg((3 << 11) | 20) & 0xFu; }
#define XB_SPIN(cond, bar) do { unsigned _sp = 0; while (cond) { __builtin_amdgcn_s_sleep(1); \
    if ((++_sp & 255u) == 0u) { if (xb_ld(&(bar)[XB_TMO])) break; if (_sp > XB_SPIN_CAP) { atomicAdd(&(bar)[XB_TMO], 1u); break; } } } } while (0)

struct XcdBarrier {
    unsigned* bar; unsigned x;
    volatile LAS unsigned* st;
};

__device__ __forceinline__ XcdBarrier xcd_barrier_post(unsigned* bar, volatile LAS unsigned* st) {
    XcdBarrier b; b.bar = bar; b.x = xb_xcc_id(); b.st = st;
    if (threadIdx.x == 0) (void)xb_add(&bar[XB_XCNT(b.x)], 1u);
    return b;
}
__device__ __forceinline__ void xcd_barrier_complete(unsigned* bar, unsigned x, unsigned& nloc, unsigned& nx) {
    const unsigned G = gridDim.x * gridDim.y * gridDim.z;
    unsigned sum, cnt, mine, sp = 0u;
    for (;;) {
        sum = 0u; cnt = 0u; mine = 0u;
#pragma unroll
        for (unsigned j = 0; j < 16; ++j) { const unsigned c = xb_ld(&bar[XB_XCNT(j)]); sum += c; cnt += (c > 0u) ? 1u : 0u; mine = (j == x) ? c : mine; }
        if (sum == G) break;
        __builtin_amdgcn_s_sleep(1);
        if ((++sp & 255u) == 0u) { if (xb_ld(&bar[XB_TMO])) break; if (sp > XB_SPIN_CAP) { atomicAdd(&bar[XB_TMO], 1u); break; } }
    }
    nloc = mine > 0u ? mine : 1u; nx = cnt > 0u ? cnt : 1u;
}

__device__ __forceinline__ void xcd_barrier(const XcdBarrier& b) {
    asm volatile("s_waitcnt vmcnt(0)" ::: "memory");
    __syncthreads();
    if (threadIdx.x == 0) {
        unsigned* bar = b.bar;
        __builtin_amdgcn_s_waitcnt(0);
        unsigned nloc = b.st[0], nx = b.st[1];
        if (nloc == 0u) { xcd_barrier_complete(bar, b.x, nloc, nx); b.st[0] = nloc; b.st[1] = nx; }
        const unsigned old = xb_add(&bar[XB_XSUB(b.x)], 1u);
        const unsigned gen = old / nloc;
        if (old + 1u == (gen + 1u) * nloc) {
            __builtin_amdgcn_fence(__ATOMIC_RELEASE, "agent");
            asm volatile("s_waitcnt vmcnt(0)" ::: "memory");
            const unsigned og = xb_add(&bar[XB_TOP], 1u);
            const unsigned tg = og / nx;
            if (og + 1u == (tg + 1u) * nx) xb_add(&bar[XB_TOPGEN], 1u);
            else XB_SPIN(xb_ld(&bar[XB_TOPGEN]) == tg, bar);
            __builtin_amdgcn_fence(__ATOMIC_ACQUIRE, "agent");
            xb_add(&bar[XB_XGEN(b.x)], 1u);
            asm volatile("s_waitcnt vmcnt(0)" ::: "memory");
        } else {
            XB_SPIN(xb_ld(&bar[XB_XGEN(b.x)]) == gen, bar);
            __builtin_amdgcn_fence(__ATOMIC_ACQUIRE, "agent");
            asm volatile("s_waitcnt vmcnt(0)" ::: "memory");
        }
    }
    __syncthreads();
}


typedef unsigned v2u __attribute__((ext_vector_type(2)));
__device__ __forceinline__ float bflo(unsigned w) { return __uint_as_float(w << 16); }
__device__ __forceinline__ float bfhi(unsigned w) { return __uint_as_float(w & 0xffff0000u); }
__device__ __forceinline__ float wave_sum(float v) {
#pragma unroll
    for (int o = 1; o < 64; o <<= 1) v += __shfl_xor(v, o);
    return v;
}
__device__ __forceinline__ float silu1(float x) { return x / (1.0f + __expf(-x)); }
__device__ __forceinline__ float sigmoid1(float x) { return 1.0f / (1.0f + __expf(-x)); }

struct Ctx {
    LAS unsigned char* lds;
    int tid, lane, wave, gw, NGW, G, bid;
    const float* in[27];
    float* out;
    unsigned char* ws;
};
#define WSP(T, off) ((T*)(C.ws + (off)))

__device__ __forceinline__ unsigned cvt2(float lo, float hi) { unsigned r; asm volatile("v_cvt_pk_bf16_f32 %0, %1, %2" : "=v"(r) : "v"(lo), "v"(hi)); return r; }
struct TpDesc { const float* W; bf16* WT; const float* gain; int ldw, K, csrc0, drow0, mode, kb, nb; };
__device__ __forceinline__ void tp_decode(Ctx& C, int tile, TpDesc& d) {
    constexpr int T_FFN = 54 * 224, T_IN = 512, T_OUT = 256;
    d.gain = nullptr; d.csrc0 = 0; d.drow0 = 0; d.mode = 0;
    if (tile < T_FFN) {
        const int job = tile / 224, r = tile % 224; int which;
        if (job < 6) { const int j = job / 3; which = job % 3; unsigned char* base = C.ws + WS_WFD + j * FD_STRIDE;
            if (which < 2) { d.W = (which == 0 ? C.in[20] : C.in[21]) + (size_t)j * D * FF; d.WT = (bf16*)base; d.gain = C.in[8] + (2 * j) * D; }
            else { d.W = C.in[22] + (size_t)j * FF * D; d.WT = (bf16*)(base + FD_WD); }
        } else { const int q = job - 6, j = q / 24, e = (q % 24) / 3; which = q % 3; unsigned char* base = C.ws + WS_WMOE + j * MOE_STRIDE;
            if (which < 2) { d.W = (which == 0 ? C.in[24] : C.in[25]) + (size_t)(j * NE + e) * D * FF; d.WT = (bf16*)base + (size_t)e * 7168 * D; d.gain = C.in[8] + (2 * j + 1) * D; }
            else { d.W = C.in[26] + (size_t)(j * NE + e) * FF * D; d.WT = (bf16*)(base + MOE_WD) + (size_t)e * D * FF; }
        }
        if (which < 2) { d.ldw = FF; d.K = D; d.drow0 = which ? 128 : 0; d.mode = 1; d.kb = r / 14; d.nb = r % 14; }
        else { d.ldw = D; d.K = FF; d.kb = r / 4; d.nb = r % 4; }
    } else if (tile < T_FFN + T_IN) {
        int r = tile - T_FFN; d.K = D;
        if (r < 96) { d.W = C.in[9]; d.ldw = N_SWA; d.WT = WSP(bf16, WS_WIN + WIN_OFF[0]); d.gain = C.in[2] + 0 * D; d.kb = r / 6; d.nb = r % 6; }
        else if ((r -= 96) < 160) { d.W = C.in[13]; d.ldw = N_RET; d.WT = WSP(bf16, WS_WIN + WIN_OFF[1]); d.gain = C.in[2] + 1 * D; d.kb = r / 10; d.nb = r % 10; }
        else if ((r -= 160) < 144) { d.W = C.in[14]; d.ldw = MLS_SRC; d.WT = WSP(bf16, WS_WIN + WIN_OFF[2]); d.gain = C.in[2] + 2 * D; d.kb = r / 9; d.nb = r % 9; }
        else if ((r -= 144) < 16) { d.W = C.in[14]; d.ldw = MLS_SRC; d.csrc0 = 2312; d.drow0 = 2304; d.WT = WSP(bf16, WS_WIN + WIN_OFF[2]); d.gain = C.in[2] + 2 * D; d.kb = r; d.nb = 0; }
        else { r -= 16; d.W = C.in[9] + (size_t)D * N_SWA; d.ldw = N_SWA; d.WT = WSP(bf16, WS_WIN + WIN_OFF[3]); d.gain = C.in[2] + 3 * D; d.kb = r / 6; d.nb = r % 6; }
    } else if (tile < T_FFN + T_IN + T_OUT) {
        const int r = tile - T_FFN - T_IN, l = r >> 6, q = r & 63;
        d.W = C.in[7] + (size_t)l * D * D; d.ldw = D; d.K = D; d.WT = WSP(bf16, WS_WOUT + (size_t)l * 2 * MiB); d.kb = q >> 2; d.nb = q & 3;
    } else {
        const int r = tile - T_FFN - T_IN - T_OUT, l = r >> 5, q = r & 31;
        d.W = C.in[4] + (size_t)l * D * 512; d.ldw = 512; d.K = D; d.WT = WSP(bf16, WS_WMEM); d.drow0 = 512 * l; d.gain = C.in[3] + l * D; d.kb = q >> 1; d.nb = q & 1;
    }
}
__device__ __forceinline__ void tp_load(Ctx& C, const TpDesc& d, f32x4 (&v)[8], f32x4 (&gn)[2]) {
    const int k0 = d.kb * 64 + 8 * C.wave, n = d.nb * 256 + 4 * C.lane;
    if (d.gain) { gn[0] = *(const GAS f32x4*)(d.gain + k0); gn[1] = *(const GAS f32x4*)(d.gain + k0 + 4); }
#pragma unroll
    for (int kk = 0; kk < 8; ++kk) v[kk] = __builtin_nontemporal_load((const GAS f32x4*)(d.W + (size_t)(k0 + kk) * d.ldw + d.csrc0 + n));
}
constexpr int TP_ALL = 54 * 224 + 512 + 256 + 128;
constexpr int TP_WIN_N = 768, TP_MOVED_LO = 30 * 224, TP_MOVED_N = 3 * TP_WIN_N;
__device__ __forceinline__ void tp_run(Ctx& C, int first, int stride, int count, int skip_lo, int skip_len) {
    constexpr int TP_LD = 144, TP_BUF = 256 * TP_LD;
    TpDesc da, db; f32x4 va[8], vb[8], ga[2], gb[2]; int buf = 0;
    int tile = first;
    __syncthreads();
    if (tile < count) { tp_decode(C, tile >= skip_lo ? tile + skip_len : tile, da); tp_load(C, da, va, ga); }
    if (tile + stride < count) { const int t1 = tile + stride; tp_decode(C, t1 >= skip_lo ? t1 + skip_len : t1, db); tp_load(C, db, vb, gb); }
#define TP_STEP(d, v, gn) { LAS unsigned char* Lb = C.lds + RING_OFF + buf * TP_BUF; \
        if (d.gain) { _Pragma("unroll") for (int kk = 0; kk < 8; ++kk) v[kk] = v[kk] * gn[kk >> 2][kk & 3]; } \
        _Pragma("unroll") for (int c = 0; c < 4; ++c) { v4u o; o.x = cvt2(v[0][c], v[1][c]); o.y = cvt2(v[2][c], v[3][c]); o.z = cvt2(v[4][c], v[5][c]); o.w = cvt2(v[6][c], v[7][c]); \
            *(LAS v4u*)(Lb + (4 * C.lane + c) * TP_LD + 16 * C.wave) = o; } \
        const TpDesc dc = d; const int nx = tile + 2 * stride; \
        if (nx < count) { tp_decode(C, nx >= skip_lo ? nx + skip_len : nx, d); tp_load(C, d, v, gn); } \
        __syncthreads(); \
        _Pragma("unroll") for (int q = 0; q < 4; ++q) { const int id = C.tid + 512 * q, row = id >> 3, pc = id & 7; const int n = dc.nb * 256 + row; \
            const int drow = dc.mode ? dc.drow0 + (n >> 7) * 256 + (n & 127) : dc.drow0 + n; \
            *(GAS v4u*)(dc.WT + (size_t)drow * dc.K + dc.kb * 64 + 8 * pc) = *(const LAS v4u*)(Lb + row * TP_LD + 16 * pc); } \
        tile += stride; buf ^= 1; }
    while (tile < count) { TP_STEP(da, va, ga) if (tile >= count) break; TP_STEP(db, vb, gb) }
#undef TP_STEP
    __syncthreads();
}
__device__ __forceinline__ void p_prologue(Ctx& C) {
    if (C.G == 256) tp_run(C, C.bid, C.G, TP_ALL - TP_MOVED_N, TP_MOVED_LO, TP_MOVED_N); else tp_run(C, C.bid, C.G, TP_ALL, 1 << 30, 0);
    for (int m0 = C.gw; m0 < M; m0 += 4 * C.NGW) {
        f32x4 xv[4][4];
#pragma unroll
        for (int u = 0; u < 4; ++u) { const int m = m0 + u * C.NGW; if (m < M) { const GAS f32x4* xr = (const GAS f32x4*)(C.in[0] + (size_t)m * D) + C.lane;
#pragma unroll
            for (int j = 0; j < 4; ++j) xv[u][j] = __builtin_nontemporal_load(xr + 64 * j); } }
#pragma unroll
        for (int u = 0; u < 4; ++u) { const int m = m0 + u * C.NGW; if (m < M) {
            GAS unsigned long long* o8 = (GAS unsigned long long*)(WSP(bf16, WS_HB) + (size_t)m * D) + C.lane; float s = 0.f;
#pragma unroll
            for (int j = 0; j < 4; ++j) { const f32x4 v = xv[u][j]; s += (v.x * v.x + v.y * v.y) + (v.z * v.z + v.w * v.w);
                o8[64 * j] = (unsigned long long)pk2(v.x, v.y) | ((unsigned long long)pk2(v.z, v.w) << 32); }
            s = wave_sum(s);
            if (C.lane < 4) WSP(float, WS_SS)[(size_t)m * 4 + C.lane] = C.lane == 0 ? s : 0.f; } }
    }
    for (int m = C.gw; m < MROWS; m += C.NGW) {
        const GAS f32x4* xr = (const GAS f32x4*)(C.in[1] + (size_t)m * D) + C.lane; f32x4 v[4]; float s = 0.f;
#pragma unroll
        for (int j = 0; j < 4; ++j) { v[j] = xr[64 * j]; s += (v[j].x * v[j].x + v[j].y * v[j].y) + (v[j].z * v[j].z + v[j].w * v[j].w); }
        const float rs = 1.0f / sqrtf(wave_sum(s) * (1.0f / D) + 1e-6f);
        GAS unsigned long long* o8 = (GAS unsigned long long*)(WSP(bf16, WS_MEMN) + (size_t)m * D) + C.lane;
#pragma unroll
        for (int j = 0; j < 4; ++j) o8[64 * j] = (unsigned long long)pk2(v[j].x * rs, v[j].y * rs) | ((unsigned long long)pk2(v[j].z * rs, v[j].w * rs) << 32);
    }
}

__device__ __forceinline__ void ld8(const bf16* p, float (&f)[8]) { const v4u w = *(const GAS v4u*)p; f[0] = bflo(w.x); f[1] = bfhi(w.x); f[2] = bflo(w.y); f[3] = bfhi(w.y); f[4] = bflo(w.z); f[5] = bfhi(w.z); f[6] = bflo(w.w); f[7] = bfhi(w.w); }
__device__ __forceinline__ void load_w8(const float* gain, const float* W, int ldw, int c0, int lane, float (&RW)[16][8]) {
#pragma unroll
    for (int j = 0; j < 2; ++j)
#pragma unroll
        for (int i = 0; i < 8; ++i) { const int k = 8 * lane + 512 * j + i; const float gk = gain[k]; const float* wp = W + (size_t)k * ldw + c0;
#pragma unroll
            for (int e = 0; e < 8; ++e) RW[j * 8 + i][e] = gk * wp[e]; }
}
__device__ __forceinline__ void dots8(const bf16* hrow, const float (&RW)[16][8], int lane, float (&out)[8], float& rstd) {
    float acc[8]; float ss = 0.f;
#pragma unroll
    for (int e = 0; e < 8; ++e) acc[e] = 0.f;
#pragma unroll
    for (int j = 0; j < 2; ++j) { float hv[8]; ld8(hrow + 8 * lane + 512 * j, hv);
#pragma unroll
        for (int i = 0; i < 8; ++i) { ss += hv[i] * hv[i];
#pragma unroll
            for (int e = 0; e < 8; ++e) acc[e] += hv[i] * RW[j * 8 + i][e]; } }
    rstd = 1.0f / sqrtf(wave_sum(ss) * (1.0f / D) + 1e-6f);
#pragma unroll
    for (int e = 0; e < 8; ++e) out[e] = wave_sum(acc[e]) * rstd;
}
__device__ __forceinline__ void dots8_x4(Ctx& C, int m0, const float (&RW)[16][8], float& val, float& rs) {
    const int lane = C.lane; v4u raw[4][2];
#pragma unroll
    for (int t = 0; t < 4; ++t) { const bf16* hrow = WSP(bf16, WS_HB) + (size_t)(m0 + t) * D; raw[t][0] = *(const GAS v4u*)(hrow + 8 * lane); raw[t][1] = *(const GAS v4u*)(hrow + 8 * lane + 512); }
    float acc[32], ss[4];
#pragma unroll
    for (int t = 0; t < 4; ++t) { ss[t] = 0.f;
#pragma unroll
        for (int e = 0; e < 8; ++e) acc[t * 8 + e] = 0.f;
#pragma unroll
        for (int jj = 0; jj < 2; ++jj) { const v4u w = raw[t][jj]; const float hv[8] = {bflo(w.x), bfhi(w.x), bflo(w.y), bfhi(w.y), bflo(w.z), bfhi(w.z), bflo(w.w), bfhi(w.w)};
#pragma unroll
            for (int i = 0; i < 8; ++i) { ss[t] += hv[i] * hv[i];
#pragma unroll
                for (int e = 0; e < 8; ++e) acc[t * 8 + e] += hv[i] * RW[jj * 8 + i][e]; } } }
#pragma unroll
    for (int s = 0; s < 5; ++s) { const int d = 1 << s, hn = 16 >> s; const bool up = (lane & d) != 0;
#pragma unroll
        for (int q = 0; q < hn; ++q) { const float send = up ? acc[q] : acc[q + hn], keep = up ? acc[q + hn] : acc[q]; acc[q] = keep + __shfl_xor(send, d); } }
    const float lsum = acc[0] + __shfl_xor(acc[0], 32);
    { const bool up0 = (lane & 1) != 0; const float s0 = (up0 ? ss[2] : ss[0]) + __shfl_xor(up0 ? ss[0] : ss[2], 1), s1 = (up0 ? ss[3] : ss[1]) + __shfl_xor(up0 ? ss[1] : ss[3], 1);
      const bool up1 = (lane & 2) != 0; ss[0] = (up1 ? s1 : s0) + __shfl_xor(up1 ? s0 : s1, 2); }
    float sst = ss[0];
#pragma unroll
    for (int d = 4; d < 64; d <<= 1) sst += __shfl_xor(sst, d);
    rs = 1.0f / sqrtf(sst * (1.0f / D) + 1e-6f); val = lsum * rs;
}
__device__ __forceinline__ void mls_gates(Ctx& C) {
    const bool half = (C.G == 256); if (half && C.bid < 128) return;
    const int gw = half ? (C.bid - 128) * NWAVES + C.wave : C.gw, ngw = half ? 128 * NWAVES : C.NGW;
    float* GT = WSP(float, WS_ROUTE + RT_GATES); float RW[16][8];
    load_w8(C.in[2] + 2 * D, C.in[14], MLS_SRC, 2304, C.lane, RW);
    const int tk = ((C.lane & 1) << 1) | ((C.lane >> 1) & 1), ex = (((C.lane >> 2) & 1) << 2) | (((C.lane >> 3) & 1) << 1) | ((C.lane >> 4) & 1);
    for (int m0 = 4 * gw; m0 < M; m0 += 4 * ngw) { float val, rs; dots8_x4(C, m0, RW, val, rs);
        if (C.lane < 32) GT[(size_t)(m0 + tk) * 8 + ex] = val; }
}
__device__ __forceinline__ void mls_conv(Ctx& C, const bf16* P, bf16* QKC) {
    const float* cw = C.in[15]; const float* cb = C.in[16];
    const int nthr = C.G * NWAVES * 64, gt = C.bid * NWAVES * 64 + C.tid;
    for (int e = gt; e < (M / 16) * 96; e += nthr) { const int seg = e / 96, c0 = (e % 96) * 8, m0 = seg * 16; const bool first = (m0 & (SEQ - 1)) == 0;
        v4u raw[19];
#pragma unroll
        for (int r = 0; r < 19; ++r) { if (r >= 3 || !first) raw[r] = *(const GAS v4u*)(P + (size_t)(m0 - 3 + r) * N_MLS + c0); else raw[r] = (v4u){0u, 0u, 0u, 0u}; }
        float wv[4][8], bv[8];
#pragma unroll
        for (int j = 0; j < 4; ++j) { const f32x4 a = *(const GAS f32x4*)(cw + j * 768 + c0), b2 = *(const GAS f32x4*)(cw + j * 768 + c0 + 4);
            wv[j][0] = a.x; wv[j][1] = a.y; wv[j][2] = a.z; wv[j][3] = a.w; wv[j][4] = b2.x; wv[j][5] = b2.y; wv[j][6] = b2.z; wv[j][7] = b2.w; }
        { const f32x4 a = *(const GAS f32x4*)(cb + c0), b2 = *(const GAS f32x4*)(cb + c0 + 4); bv[0] = a.x; bv[1] = a.y; bv[2] = a.z; bv[3] = a.w; bv[4] = b2.x; bv[5] = b2.y; bv[6] = b2.z; bv[7] = b2.w; }
        const float sc = c0 >= 384 ? 0.10206207261596577f : 1.0f;
#pragma unroll
        for (int r = 0; r < 16; ++r) { float acc[8];
#pragma unroll
            for (int i = 0; i < 8; ++i) acc[i] = bv[i];
#pragma unroll
            for (int j = 0; j < 4; ++j) { const v4u w = raw[r + j]; const float x[8] = {bflo(w.x), bfhi(w.x), bflo(w.y), bfhi(w.y), bflo(w.z), bfhi(w.z), bflo(w.w), bfhi(w.w)};
#pragma unroll
                for (int i = 0; i < 8; ++i) acc[i] += wv[j][i] * x[i]; }
#pragma unroll
            for (int i = 0; i < 8; ++i) acc[i] = silu1(acc[i]) * sc;
            v4u o; o.x = pk2(acc[0], acc[1]); o.y = pk2(acc[2], acc[3]); o.z = pk2(acc[4], acc[5]); o.w = pk2(acc[6], acc[7]);
            *(GAS v4u*)(QKC + (size_t)(m0 + r) * 768 + c0) = o; }
    }
}
__device__ __forceinline__ bool r1_better(float va, int ea, float vb, int eb) { return va > vb || (va == vb && ea < eb); }
__device__ __forceinline__ void moe_route1(Ctx& C, int j, int layer) {
    f32x4* SEL = WSP(f32x4, WS_ROUTE + RT_SEL); float* RSTD = WSP(float, WS_ROUTE + RT_RSTD); int* CNT = WSP(int, WS_ROUTE + RT_CNT);
    LAS int* lc = (LAS int*)(C.lds + RING_OFF); float RW[16][8]; const int lane = C.lane;
    load_w8(C.in[8] + layer * D, C.in[23] + (size_t)j * D * NE, NE, 0, lane, RW);
    for (int chunk = C.bid; chunk < M / 64; chunk += C.G) {
        __syncthreads();
        if (C.tid < 8) lc[C.tid] = 0;
        __syncthreads();
#pragma unroll 1
        for (int grp = 0; grp < 2; ++grp) {
            const int m0 = chunk * 64 + C.wave * 8 + grp * 4;
            float lval, rs; dots8_x4(C, m0, RW, lval, rs);
            const int tk = ((lane & 1) << 1) | ((lane >> 1) & 1), ex = (((lane >> 2) & 1) << 2) | (((lane >> 3) & 1) << 1) | ((lane >> 4) & 1);
            float v1 = lval, v2 = -3.0e38f; int e1 = ex, e2 = 8;
#pragma unroll
            for (int d = 4; d <= 16; d <<= 1) { const float pv1 = __shfl_xor(v1, d), pv2 = __shfl_xor(v2, d); const int pe1 = __shfl_xor(e1, d), pe2 = __shfl_xor(e2, d);
                float n1, n2; int f1, f2;
                if (r1_better(v1, e1, pv1, pe1)) { n1 = v1; f1 = e1; if (r1_better(v2, e2, pv1, pe1)) { n2 = v2; f2 = e2; } else { n2 = pv1; f2 = pe1; } }
                else { n1 = pv1; f1 = pe1; if (r1_better(v1, e1, pv2, pe2)) { n2 = v1; f2 = e1; } else { n2 = pv2; f2 = pe2; } }
                v1 = n1; e1 = f1; v2 = n2; e2 = f2; }
            if (lane < 4) { const int mm = m0 + tk; const float w1 = 1.0f / (1.0f + __expf(v2 - v1)), w2 = 1.0f - w1;
                f32x4 s; s.x = __int_as_float(e1); s.y = __int_as_float(e2); s.z = w1; s.w = w2; SEL[mm] = s; RSTD[mm] = rs; atomicAdd((int*)&lc[e1], 1); atomicAdd((int*)&lc[e2], 1); }
        }
        __syncthreads();
        if (C.tid < 8) CNT[chunk * 8 + C.tid] = lc[C.tid];
    }
}
__device__ __forceinline__ void moe_route2(Ctx& C) {
    const f32x4* SEL = WSP(f32x4, WS_ROUTE + RT_SEL); const float* RSTD = WSP(float, WS_ROUTE + RT_RSTD); const int* CNT = WSP(int, WS_ROUTE + RT_CNT);
    int* PANEL = WSP(int, WS_ROUTE + RT_PANEL); int* NP = WSP(int, WS_ROUTE + RT_NP); int* TOKSLOT = WSP(int, WS_ROUTE + RT_TOKSLOT); float* SLOTRS = WSP(float, WS_ROUTE + RT_SLOTRS); int* ROWTOK = WSP(int, WS_ROUTE + RT_ROWTOK);
    if (C.wave != 0) return;
    for (int chunk = C.bid; chunk < M / 64; chunk += C.G) {
        const int e = C.lane & 7, sub = C.lane >> 3; int tot = 0, pre = 0;
        const int mtok = chunk * 64 + C.lane; const f32x4 stok = SEL[mtok]; const float rstok = RSTD[mtok];
        int cv[32];
#pragma unroll
        for (int q = 0; q < 32; ++q) cv[q] = CNT[(sub + 8 * q) * 8 + e];
#pragma unroll
        for (int q = 0; q < 32; ++q) { tot += cv[q]; pre += (sub + 8 * q < chunk) ? cv[q] : 0; }
        tot += __shfl_xor(tot, 8); tot += __shfl_xor(tot, 16); tot += __shfl_xor(tot, 32);
        pre += __shfl_xor(pre, 8); pre += __shfl_xor(pre, 16); pre += __shfl_xor(pre, 32);
        const int np = (tot + 255) >> 8; int pstart = 0;
#pragma unroll
        for (int k = 0; k < 8; ++k) { const int v = __shfl(np, k); pstart += (k < e) ? v : 0; }
        const int mybase = pstart * 256 + pre;
        if (chunk == 0) { int* TAILIDX = WSP(int, WS_ROUTE + RT_TAILIDX); for (int q = C.lane; q < 576; q += 64) TAILIDX[q] = -1;
            if (C.lane < 8) { for (int p = 0; p < np; ++p) PANEL[pstart + p] = e; if (e == 7) NP[0] = pstart + np; }
            for (int sl = pstart * 256 + tot + sub; sl < (pstart + np) * 256; sl += 8) { ROWTOK[sl] = 0; SLOTRS[sl] = 0.f; } }
        const int m = mtok; const f32x4 s = stok; const int e1 = __float_as_int(s.x), e2 = __float_as_int(s.y);
        const unsigned long long lt = (1ull << C.lane) - 1ull; int s1 = 0, s2 = 0;
#pragma unroll
        for (int ee = 0; ee < 8; ++ee) { const unsigned long long both = __ballot(e1 == ee) | __ballot(e2 == ee); const int r = __popcll(both & lt); const int be = __shfl(mybase, ee);
            if (e1 == ee) s1 = be + r; if (e2 == ee) s2 = be + r; }
        TOKSLOT[2 * m] = s1; TOKSLOT[2 * m + 1] = s2; const float rs = rstok; SLOTRS[s1] = rs; SLOTRS[s2] = rs; ROWTOK[s1] = m; ROWTOK[s2] = m;
    }
}
struct CombRow { unsigned long long hw[4]; v2u y1[4], y2[4]; };
__device__ __forceinline__ f32x4 slab_sum(const float* SLAB, int tl, int slot, int lane) {
    const float* sp = SLAB + (size_t)tl * 7 * 65536 + (size_t)(slot & 255) * 256 + 4 * lane; f32x4 a = *(const GAS f32x4*)sp;
#pragma unroll
    for (int k = 1; k < 7; ++k) a = a + *(const GAS f32x4*)(sp + (size_t)k * 65536);
    return a;
}
template <bool FINAL>
__device__ __forceinline__ void moe_combine(Ctx& C) {
    const f32x4* SEL = WSP(f32x4, WS_ROUTE + RT_SEL); const int* TOKSLOT = WSP(int, WS_ROUTE + RT_TOKSLOT); const bf16* Y = WSP(bf16, WS_Y);
    const float* SLAB = WSP(float, WS_SLAB); const int* TAILIDX = WSP(int, WS_ROUTE + RT_TAILIDX); const int lane = C.lane;
    typedef int i32x4 __attribute__((ext_vector_type(4)));
    for (int base = C.gw; base < M; base += 8 * C.NGW) {
        const int mrow = base + (lane & 7) * C.NGW; const bool okl = mrow < M; const int mr = okl ? mrow : base;
        const f32x4 sel = SEL[mr]; const int s1l = TOKSLOT[2 * mr], s2l = TOKSLOT[2 * mr + 1];
        const i32x4 t1l = *(const GAS i32x4*)(TAILIDX + (s1l >> 8) * 4), t2l = *(const GAS i32x4*)(TAILIDX + (s2l >> 8) * 4);
#pragma unroll
        for (int k0 = 0; k0 < 8; k0 += 2) {
            CombRow R[2]; int mm[2], s1[2], s2[2], tl1[2][4], tl2[2][4]; float w1[2], w2[2]; bool ok[2];
#pragma unroll
            for (int u = 0; u < 2; ++u) { const int k = k0 + u; mm[u] = base + k * C.NGW; ok[u] = mm[u] < M;
                s1[u] = __shfl(s1l, k); s2[u] = __shfl(s2l, k); w1[u] = __shfl(sel.z, k); w2[u] = __shfl(sel.w, k);
#pragma unroll
                for (int jj = 0; jj < 4; ++jj) { tl1[u][jj] = __shfl(t1l[jj], k); tl2[u][jj] = __shfl(t2l[jj], k); }
                if (ok[u]) { const GAS unsigned long long* o8 = (const GAS unsigned long long*)(WSP(bf16, WS_HB) + (size_t)mm[u] * D) + lane;
#pragma unroll
                    for (int jj = 0; jj < 4; ++jj) { R[u].hw[jj] = o8[64 * jj];
                        R[u].y1[jj] = tl1[u][jj] < 0 ? *(const GAS v2u*)(Y + (size_t)s1[u] * D + 256 * jj + 4 * lane) : (v2u){0u, 0u};
                        R[u].y2[jj] = tl2[u][jj] < 0 ? *(const GAS v2u*)(Y + (size_t)s2[u] * D + 256 * jj + 4 * lane) : (v2u){0u, 0u}; } } }
#pragma unroll
            for (int u = 0; u < 2; ++u) if (ok[u]) {
                GAS unsigned long long* o8 = (GAS unsigned long long*)(WSP(bf16, WS_HB) + (size_t)mm[u] * D) + lane; float ss = 0.f;
#pragma unroll
                for (int jj = 0; jj < 4; ++jj) { const unsigned lo = (unsigned)R[u].hw[jj], hi = (unsigned)(R[u].hw[jj] >> 32);
                    f32x4 v = (f32x4){bflo(lo), bfhi(lo), bflo(hi), bfhi(hi)};
                    f32x4 a = (f32x4){bflo(R[u].y1[jj].x), bfhi(R[u].y1[jj].x), bflo(R[u].y1[jj].y), bfhi(R[u].y1[jj].y)}; if (tl1[u][jj] >= 0) a = slab_sum(SLAB, tl1[u][jj], s1[u], lane);
                    f32x4 b2 = (f32x4){bflo(R[u].y2[jj].x), bfhi(R[u].y2[jj].x), bflo(R[u].y2[jj].y), bfhi(R[u].y2[jj].y)}; if (tl2[u][jj] >= 0) b2 = slab_sum(SLAB, tl2[u][jj], s2[u], lane);
                    v = v + (a * w1[u] + b2 * w2[u]);
                    if (FINAL) { ((GAS f32x4*)(C.out + (size_t)mm[u] * D) + lane)[64 * jj] = v; }
                    else { ss += (v.x * v.x + v.y * v.y) + (v.z * v.z + v.w * v.w); o8[64 * jj] = (unsigned long long)pk2(v.x, v.y) | ((unsigned long long)pk2(v.z, v.w) << 32); } }
                if (!FINAL) { ss = wave_sum(ss); if (lane < 4) WSP(float, WS_SS)[(size_t)mm[u] * 4 + lane] = lane == 0 ? ss : 0.f; } }
        }
    }
}

template <class Sched> __device__ __forceinline__ const LAS float* rstd_table(Ctx& C, const Sched& S, const float* SS) {
    LAS float* tab = (LAS float*)(C.lds + 131072 + 4096);
    pg8::Unit u0, u; bool one = S.next(0, u0);
    for (int i = 1; one && S.next(i, u); ++i) one = (u.pm == u0.pm);
    __syncthreads();
    if (one && C.tid < 256) tab[C.tid] = pg8::row_rstd16(SS, u0.pm * 256 + C.tid);
    __syncthreads();
    return one ? tab : nullptr;
}
typedef short v4i16_t __attribute__((ext_vector_type(4)));
typedef const LAS unsigned char* ldsc;
__device__ __forceinline__ bf16x8 frag_rows(ldsc base, int ld, int row0, int kbyte0, int i, int g) { return *(const LAS bf16x8*)(base + (row0 + i) * ld + kbyte0 + 16 * g); }
__device__ __forceinline__ bf16x8 frag_tr(ldsc base, int ld, int k0, int nbyte0, int i, int g, bool perm) {
    const int q = i >> 2, p = i & 3;
    ldsc p1 = base + (k0 + (perm ? 4 * g : 8 * g) + q) * ld + nbyte0 + 8 * p; ldsc p2 = p1 + (perm ? 16 : 4) * ld;
    const v4i16_t a = __builtin_amdgcn_ds_read_tr16_b64_v4i16((LAS v4i16_t*)p1), b = __builtin_amdgcn_ds_read_tr16_b64_v4i16((LAS v4i16_t*)p2);
    return (bf16x8){a[0], a[1], a[2], a[3], b[0], b[1], b[2], b[3]};
}
__device__ __forceinline__ unsigned cvtpk(float lo, float hi) { unsigned r; asm volatile("v_cvt_pk_bf16_f32 %0, %1, %2" : "=v"(r) : "v"(lo), "v"(hi)); return r; }
__device__ __forceinline__ bf16x8 pack_acc2(const f32x4& t0, const f32x4& t1) {
    v4u w; w.x = cvtpk(t0[0], t0[1]); w.y = cvtpk(t0[2], t0[3]); w.z = cvtpk(t1[0], t1[1]); w.w = cvtpk(t1[2], t1[3]); return __builtin_bit_cast(bf16x8, w);
}
#define MFMA16(a, b, c) __builtin_amdgcn_mfma_f32_16x16x32_bf16(a, b, c, 0, 0, 0)
__device__ __forceinline__ void st8_lds(LAS unsigned char* p, const float (&f)[8]) { v4u w; w.x = cvtpk(f[0], f[1]); w.y = cvtpk(f[2], f[3]); w.z = cvtpk(f[4], f[5]); w.w = cvtpk(f[6], f[7]); *(LAS v4u*)p = w; }

constexpr int AT_LD = 144, AT_K = 0, AT_V = 256 * AT_LD, AT_Q = 2 * 256 * AT_LD;
struct AttnKV { v4u k[4], v[4]; };
template <int QIT> struct AttnQ { v4u q[QIT][4]; };
__device__ __forceinline__ void attn_ld_kv(AttnKV& R, const bf16* Kb, long krow0, int ldk, int kcol, int vcol, bool ok, int t) {
    const int row = t >> 1, half = t & 1;
#pragma unroll
    for (int c = 0; c < 4; ++c) { if (ok) { R.k[c] = *(const GAS v4u*)(Kb + (size_t)(krow0 + row) * ldk + kcol + half * 32 + c * 8); R.v[c] = *(const GAS v4u*)(Kb + (size_t)(krow0 + row) * ldk + vcol + half * 32 + c * 8); }
        else { R.k[c] = (v4u){0u, 0u, 0u, 0u}; R.v[c] = (v4u){0u, 0u, 0u, 0u}; } }
}
template <int NQH, bool SWA>
__device__ __forceinline__ void attn_ld_q(AttnQ<(NQH * 256 + 511) / 512>& R, const bf16* P, int ldp, long tok0, int qcol, int hh, int t) {
    constexpr int QIT = (NQH * 256 + 511) / 512;
#pragma unroll
    for (int it = 0; it < QIT; ++it) { const int hr = t + 512 * it; if (hr < NQH * 256) { const int qrow = hr >> 1, qhalf = hr & 1, qh = qrow >> 7, r = qrow & 127; const int hq = SWA ? hh * 3 + qh : hh;
#pragma unroll
        for (int c = 0; c < 4; ++c) R.q[it][c] = *(const GAS v4u*)(P + (size_t)(tok0 + r) * ldp + qcol + hq * 64 + qhalf * 32 + c * 8); } }
}
__device__ __forceinline__ void attn_st_kv(const AttnKV& R, LAS unsigned char* L, const float (&kg)[32], int t) {
    const int row = t >> 1, half = t & 1; float ss = 0.f; float kf[4][8];
#pragma unroll
    for (int c = 0; c < 4; ++c) { const v4u w4 = R.k[c]; kf[c][0] = bflo(w4.x); kf[c][1] = bfhi(w4.x); kf[c][2] = bflo(w4.y); kf[c][3] = bfhi(w4.y); kf[c][4] = bflo(w4.z); kf[c][5] = bfhi(w4.z); kf[c][6] = bflo(w4.w); kf[c][7] = bfhi(w4.w);
#pragma unroll
        for (int j = 0; j < 8; ++j) ss += kf[c][j] * kf[c][j]; }
    ss += __shfl_xor(ss, 1);
    const float rs = 1.0f / sqrtf(ss * (1.0f / 64.0f) + 1e-6f);
#pragma unroll
    for (int c = 0; c < 4; ++c) {
#pragma unroll
        for (int j = 0; j < 8; ++j) kf[c][j] = kf[c][j] * rs * kg[c * 8 + j];
        st8_lds(L + AT_K + row * AT_LD + half * 64 + c * 16, kf[c]); *(LAS v4u*)(L + AT_V + row * AT_LD + half * 64 + c * 16) = R.v[c]; }
}
template <int NQH>
__device__ __forceinline__ void attn_st_q(const AttnQ<(NQH * 256 + 511) / 512>& R, LAS unsigned char* L, const float (&qg)[32], int t) {
    constexpr int QIT = (NQH * 256 + 511) / 512;
#pragma unroll
    for (int it = 0; it < QIT; ++it) { const int hr = t + 512 * it; if (hr < NQH * 256) { const int qrow = hr >> 1, qhalf = hr & 1;
        float ss = 0.f; float qf[4][8];
#pragma unroll
        for (int c = 0; c < 4; ++c) { const v4u w4 = R.q[it][c]; qf[c][0] = bflo(w4.x); qf[c][1] = bfhi(w4.x); qf[c][2] = bflo(w4.y); qf[c][3] = bfhi(w4.y); qf[c][4] = bflo(w4.z); qf[c][5] = bfhi(w4.z); qf[c][6] = bflo(w4.w); qf[c][7] = bfhi(w4.w);
#pragma unroll
            for (int j = 0; j < 8; ++j) ss += qf[c][j] * qf[c][j]; }
        ss += __shfl_xor(ss, 1);
        const float rs = 0.18033688011112042f / sqrtf(ss * (1.0f / 64.0f) + 1e-6f);
#pragma unroll
        for (int c = 0; c < 4; ++c) {
#pragma unroll
            for (int j = 0; j < 8; ++j) qf[c][j] = qf[c][j] * rs * qg[c * 8 + j];
            st8_lds(L + AT_Q + qrow * AT_LD + qhalf * 64 + c * 16, qf[c]); } } }
}
template <bool SWA>
__device__ __forceinline__ void attn_compute(Ctx& C, int hh, long tok0, bool prev_valid, const float* sink, bf16* MIX) {
    LAS unsigned char* L = C.lds + RING_OFF;
    const int lane = C.lane, w = C.wave, i = lane & 15, g = lane >> 4;
    constexpr int NQH = SWA ? 3 : 1, NT = SWA ? 10 : 16;
    const int t0 = SWA ? w : 0;
#pragma unroll 1
    for (int qh = 0; qh < NQH; ++qh) {
        const int hq = SWA ? hh * 3 + qh : hh;
        const bf16x8 q0 = frag_rows(L + AT_Q, AT_LD, qh * 128 + 16 * w, 0, i, g), q1 = frag_rows(L + AT_Q, AT_LD, qh * 128 + 16 * w, 64, i, g);
        f32x4 s[NT];
#pragma unroll
        for (int tt = 0; tt < NT; ++tt) { const int kt = (t0 + tt) > 15 ? 15 : (t0 + tt);
            s[tt] = (f32x4){0.f, 0.f, 0.f, 0.f};
            s[tt] = MFMA16(frag_rows(L + AT_K, AT_LD, 16 * kt, 0, i, g), q0, s[tt]);
            s[tt] = MFMA16(frag_rows(L + AT_K, AT_LD, 16 * kt, 64, i, g), q1, s[tt]); }
        const float slope = SWA ? exp2f(-8.0f * (float)(hq + 1) / 12.0f) * 1.4426950408889634f : 0.f;
        const float sk = SWA ? sink[hq] * 1.4426950408889634f : 0.f;
        float mx = SWA ? sk : -1e30f;
        if (SWA) {
            const int base = i - 4 * g + 128; const float sb = slope * (float)base;
#pragma unroll
            for (int tt = 0; tt < NT; ++tt)
#pragma unroll
                for (int r = 0; r < 4; ++r) { const bool valid = (unsigned)(base - (16 * tt + r)) < 128u;
                    s[tt][r] = valid ? fmaf(slope, (float)(16 * tt + r), s[tt][r]) - sb : -1e30f; }
            if (!prev_valid) {
#pragma unroll
                for (int tt = 0; tt < NT; ++tt)
#pragma unroll
                    for (int r = 0; r < 4; ++r) { if (16 * (t0 + tt) + 4 * g + r < 128) s[tt][r] = -1e30f; } }
        }
#pragma unroll
        for (int tt = 0; tt < NT; ++tt) mx = fmaxf(mx, fmaxf(fmaxf(s[tt][0], s[tt][1]), fmaxf(s[tt][2], s[tt][3])));
        mx = fmaxf(mx, __shfl_xor(mx, 16)); mx = fmaxf(mx, __shfl_xor(mx, 32));
        float l = 0.f;
#pragma unroll
        for (int tt = 0; tt < NT; ++tt)
#pragma unroll
            for (int r = 0; r < 4; ++r) { const float p = __builtin_amdgcn_exp2f(s[tt][r] - mx); s[tt][r] = p; l += p; }
        l += __shfl_xor(l, 16); l += __shfl_xor(l, 32);
        if (SWA) l += __builtin_amdgcn_exp2f(sk - mx);
        const float inv = 1.0f / l;
        f32x4 o[4];
#pragma unroll
        for (int dv = 0; dv < 4; ++dv) o[dv] = (f32x4){0.f, 0.f, 0.f, 0.f};
#pragma unroll
        for (int pr = 0; pr < NT / 2; ++pr) {
            const bf16x8 pb = pack_acc2(s[2 * pr], s[2 * pr + 1]);
            const int k0 = 16 * (t0 + 2 * pr);
#pragma unroll
            for (int dv = 0; dv < 4; ++dv) o[dv] = MFMA16(frag_tr(L + AT_V, AT_LD, k0, 32 * dv, i, g, true), pb, o[dv]);
        }
        bf16* op = MIX + (size_t)(tok0 + 16 * w + i) * D + (SWA ? hq * 64 : 768 + hq * 64) + 4 * g;
#pragma unroll
        for (int dv = 0; dv < 4; ++dv) { v2u wv; wv.x = cvtpk(o[dv][0] * inv, o[dv][1] * inv); wv.y = cvtpk(o[dv][2] * inv, o[dv][3] * inv); *(GAS v2u*)(op + 16 * dv) = wv; }
    }
}

__device__ __forceinline__ void attn_swa_unit(Ctx& C, int unit, const bf16* P, int ldp, const float* qgain, const float* kgain, const float* sink, int kcol0, int vcol0, bf16* MIX) {
    LAS unsigned char* L = C.lds + RING_OFF; const int t = C.tid;
    const int hh = unit & 3, blk = (unit >> 2) & 63, b = unit >> 8; const long krow0 = (long)b * SEQ + (long)blk * 128 - 128, tok0 = (long)b * SEQ + (long)blk * 128; const bool prev_valid = blk > 0;
    AttnKV rkv; AttnQ<2> rq; float kg[32], qg[32];
#pragma unroll
    for (int q = 0; q < 32; ++q) { kg[q] = kgain[(t & 1) * 32 + q]; qg[q] = qgain[(t & 1) * 32 + q]; }
    attn_ld_kv(rkv, P, krow0, ldp, kcol0 + hh * 64, vcol0 + hh * 64, prev_valid || (t >> 1) >= 128, t);
    attn_ld_q<3, true>(rq, P, ldp, tok0, 0, hh, t);
    __syncthreads();
    attn_st_kv(rkv, L, kg, t); attn_st_q<3>(rq, L, qg, t);
    __syncthreads();
    attn_compute<true>(C, hh, tok0, prev_valid, sink, MIX);
}
__device__ __forceinline__ void attn_mem_pair(Ctx& C, int pair, const bf16* P, int ldp, const float* qgain, const float* kgain, int layer, bf16* MIX) {
    LAS unsigned char* L = C.lds + RING_OFF; const int t = C.tid;
    const int hh = pair & 3, bp = (pair >> 2) & 31, b = pair >> 7; const long tok0 = (long)b * SEQ + (long)bp * 256; const int qcol = ldp - 256;
    AttnKV rkv; AttnQ<1> rq; float kg[32], qg[32];
#pragma unroll
    for (int q = 0; q < 32; ++q) { kg[q] = kgain[(t & 1) * 32 + q]; qg[q] = qgain[(t & 1) * 32 + q]; }
    attn_ld_kv(rkv, WSP(bf16, WS_MKV), (long)b * MEMT, 2048, layer * 512 + hh * 64, layer * 512 + 256 + hh * 64, true, t);
    attn_ld_q<1, false>(rq, P, ldp, tok0, qcol, hh, t);
    __syncthreads();
    attn_st_kv(rkv, L, kg, t); attn_st_q<1>(rq, L, qg, t);
    __syncthreads();
    attn_ld_q<1, false>(rq, P, ldp, tok0 + 128, qcol, hh, t);
    attn_compute<false>(C, hh, tok0, true, nullptr, MIX);
    __syncthreads();
    attn_st_q<1>(rq, L, qg, t);
    __syncthreads();
    attn_compute<false>(C, hh, tok0 + 128, true, nullptr, MIX);
}

template <int MODE> struct CMT;
template <> struct CMT<0> { static constexpr int DK = 64, DV = 128, NH = 6, LDP = N_RET; };
template <> struct CMT<1> { static constexpr int DK = 96, DV = 192, NH = 4, LDP = N_MLS; };
template <int MODE> struct CML {
    static constexpr int DK = CMT<MODE>::DK, DV = CMT<MODE>::DV, LDQK = DK * 2 + 16, LDV = DV * 2 + 16;
    static constexpr int Q = 0, K = 128 * LDQK, V = 2 * 128 * LDQK, S = V + 128 * LDV, AUX = S + DK * LDV;
    static_assert(AUX + 832 * 4 <= RING_BYTES, "chunk mixer LDS");
};
constexpr size_t RT_NLOC = 1536 * KiB, RT_NIN = 1792 * KiB, RT_CHG = 2048 * KiB, RT_CHA = 2052 * KiB, RT_MIN = 2056 * KiB;
constexpr size_t SCR2_STATE = 24 * MiB;

template <int NROWS, int NCOLS> struct StageRegs { static constexpr int CPR = NCOLS / 8, TOTAL = NROWS * CPR, ITER = (TOTAL + 511) / 512; v4u r[ITER]; };
template <int NROWS, int NCOLS>
__device__ __forceinline__ void stage_ld(StageRegs<NROWS, NCOLS>& R, const bf16* src, size_t lds_src, int t) {
    typedef StageRegs<NROWS, NCOLS> SR;
#pragma unroll
    for (int it = 0; it < SR::ITER; ++it) { const int e = t + 512 * it; if (e < SR::TOTAL) { const int row = e / SR::CPR, c = e % SR::CPR; R.r[it] = *(const GAS v4u*)(src + (size_t)row * lds_src + c * 8); } }
}
template <int NROWS, int NCOLS, bool SCALE>
__device__ __forceinline__ void stage_st(const StageRegs<NROWS, NCOLS>& R, LAS unsigned char* dst, int ldd, const LAS float* rsc, float cs, int t) {
    typedef StageRegs<NROWS, NCOLS> SR;
#pragma unroll
    for (int it = 0; it < SR::ITER; ++it) { const int e = t + 512 * it; if (e < SR::TOTAL) { const int row = e / SR::CPR, c = e % SR::CPR;
        if (!SCALE) { *(LAS v4u*)(dst + row * ldd + c * 16) = R.r[it]; }
        else { const v4u w = R.r[it]; float f[8] = {bflo(w.x), bfhi(w.x), bflo(w.y), bfhi(w.y), bflo(w.z), bfhi(w.z), bflo(w.w), bfhi(w.w)}; const float sc = cs * (rsc ? rsc[row] : 1.0f);
#pragma unroll
            for (int j = 0; j < 8; ++j) f[j] *= sc;
            st8_lds(dst + row * ldd + c * 16, f); } } }
}
__device__ __forceinline__ void mls_chunk_scans(Ctx& C, float* aux, size_t row0, int h, float& btot, float& cmax) {
    const float* GT = WSP(float, WS_ROUTE + RT_GATES); const float ib = C.in[17][h], fb = C.in[18][h]; const int l = C.lane;
    float li0 = GT[(row0 + 2 * l) * 8 + h] + ib, li1 = GT[(row0 + 2 * l + 1) * 8 + h] + ib;
    float x0 = GT[(row0 + 2 * l) * 8 + 4 + h] + fb, x1 = GT[(row0 + 2 * l + 1) * 8 + 4 + h] + fb;
    x0 = fminf(x0, 0.f) - log1pf(__expf(-fabsf(x0))); x1 = fminf(x1, 0.f) - log1pf(__expf(-fabsf(x1)));
    const float s = x0 + x1; float inc = s;
#pragma unroll
    for (int d = 1; d < 64; d <<= 1) { const float v = __shfl_up(inc, d); if (l >= d) inc += v; }
    const float b0 = inc - s + x0, b1 = inc; const float c0 = li0 - b0, c1 = li1 - b1;
    float pm = fmaxf(c0, c1);
#pragma unroll
    for (int d = 1; d < 64; d <<= 1) { const float v = __shfl_up(pm, d); if (l >= d) pm = fmaxf(pm, v); }
    const float pmprev = __shfl_up(pm, 1); const float m0 = (l == 0) ? c0 : fmaxf(pmprev, c0);
    aux[2 * l] = b0; aux[2 * l + 1] = b1; aux[128 + 2 * l] = c0; aux[128 + 2 * l + 1] = c1; aux[256 + 2 * l] = m0; aux[256 + 2 * l + 1] = pm;
    const float cm = __shfl(pm, 63); aux[384 + 2 * l] = __expf(c0 - cm); aux[384 + 2 * l + 1] = __expf(c1 - cm);
    btot = __shfl(b1, 63); cmax = cm;
}
__device__ __forceinline__ void mls_aux(Ctx& C) {
    float* AUXG = WSP(float, WS_ROUTE + RT_AUXG);
    for (int unit = C.gw; unit < 512; unit += C.NGW) { const int bh = unit >> 6, c = unit & 63, b = bh >> 2, h = bh & 3; const size_t row0 = (size_t)b * SEQ + (size_t)c * 128;
        float* aux = AUXG + (size_t)unit * 512; float b127, cm; mls_chunk_scans(C, aux, row0, h, b127, cm);
        if (C.lane == 63) { WSP(float, WS_ROUTE + RT_CHG)[unit] = b127; WSP(float, WS_ROUTE + RT_CHA)[unit] = b127 + cm; } }
}
template <int MODE>
__device__ __forceinline__ void chunk_state_unit(Ctx& C, int unit, const bf16* P, const bf16* QKC, float* U) {
    typedef CML<MODE> Lm; constexpr int DK = Lm::DK, DV = Lm::DV, NH = CMT<MODE>::NH, LDP = CMT<MODE>::LDP, ND = DK / 16, NV = DV / 16, TPW = ND * NV / 8;
    LAS unsigned char* L = C.lds + RING_OFF; LAS float* aux = (LAS float*)(L + Lm::AUX);
    const int bh = unit >> 6, c = unit & 63, b = bh / NH, h = bh % NH, t = C.tid, i = C.lane & 15, g = C.lane >> 4, w = C.wave;
    const size_t row0 = (size_t)b * SEQ + (size_t)c * 128;
    StageRegs<128, DK> rK; StageRegs<128, DV> rV;
    stage_ld<128, DK>(rK, MODE == 0 ? P + row0 * LDP + 384 + h * 64 : QKC + row0 * 768 + 384 + h * 96, MODE == 0 ? LDP : 768, t);
    stage_ld<128, DV>(rV, P + row0 * LDP + 768 + h * DV, LDP, t);
    float wsc = 0.f; if (MODE == 1 && t < 128) wsc = WSP(float, WS_ROUTE + RT_AUXG)[(size_t)unit * 512 + 384 + t];
    __syncthreads();
    if (MODE == 0) { if (t < 128) { const float l2g = log2f(1.0f - exp2f(-5.0f - (float)h)); aux[384 + t] = 0.125f * exp2f((float)(127 - t) * l2g); } }
    else { if (t < 128) aux[384 + t] = wsc; }
    __syncthreads();
    stage_st<128, DK, true>(rK, L + Lm::K, Lm::LDQK, aux + 384, 1.0f, t);
    stage_st<128, DV, false>(rV, L + Lm::V, Lm::LDV, nullptr, 1.0f, t);
    __syncthreads();
#pragma unroll 1
    for (int n = 0; n < TPW; ++n) { const int id = w * TPW + n, dt = id / NV, vt = id % NV;
        f32x4 acc = (f32x4){0.f, 0.f, 0.f, 0.f};
#pragma unroll
        for (int ks = 0; ks < 4; ++ks) acc = MFMA16(frag_tr(L + Lm::K, Lm::LDQK, 32 * ks, 32 * dt, i, g, false), frag_tr(L + Lm::V, Lm::LDV, 32 * ks, 32 * vt, i, g, false), acc);
        float* up = U + (size_t)unit * DK * DV + (size_t)(16 * dt + 4 * g) * DV + 16 * vt + i;
#pragma unroll
        for (int r = 0; r < 4; ++r) up[r * DV] = acc[r]; }
    if (MODE == 1 && t < 4 * DK) { const int dcol = t >> 2, part = t & 3; float s0 = 0.f, s1 = 0.f;
#pragma unroll 8
        for (int j = 0; j < 32; j += 2) { s0 += bflo((unsigned)*(const LAS unsigned short*)(L + Lm::K + (part * 32 + j) * Lm::LDQK + 2 * dcol)); s1 += bflo((unsigned)*(const LAS unsigned short*)(L + Lm::K + (part * 32 + j + 1) * Lm::LDQK + 2 * dcol)); }
        float s = s0 + s1; s += __shfl_xor(s, 1); s += __shfl_xor(s, 2);
        if (part == 0) WSP(float, WS_ROUTE + RT_NLOC)[(size_t)unit * 96 + dcol] = s; }
}
__device__ __forceinline__ void ret_scan(Ctx& C, const float* U, bf16* SIN) {
    const int gt = C.bid * 512 + C.tid, nthr = C.G * 512;
    for (int e = gt; e < 12 * 8192; e += nthr) { const int bh = e >> 13, idx = e & 8191, h = bh % 6;
        const float gL = exp2f(128.0f * log2f(1.0f - exp2f(-5.0f - (float)h))); float S = 0.f;
        const float* up = U + (size_t)bh * 64 * 8192 + idx; bf16* sp = SIN + (size_t)bh * 64 * 8192 + idx;
        float u[64];
#pragma unroll
        for (int c = 0; c < 64; ++c) u[c] = up[(size_t)c * 8192];
#pragma unroll
        for (int c = 0; c < 64; ++c) { sp[(size_t)c * 8192] = (bf16)f2bf(S); S = gL * S + u[c]; } }
}
__device__ __forceinline__ void mls_scan(Ctx& C, const float* U, bf16* CIN) {
    constexpr int NC = 96 * 192, SEG = NC / 1024;
    typedef float f32x2 __attribute__((ext_vector_type(2)));
    const float* CHG = WSP(float, WS_ROUTE + RT_CHG); const float* CHA = WSP(float, WS_ROUTE + RT_CHA); float* MIN_ = WSP(float, WS_ROUTE + RT_MIN);
    const float* NLOC = WSP(float, WS_ROUTE + RT_NLOC); float* NIN = WSP(float, WS_ROUTE + RT_NIN);
    LAS float* sc = (LAS float*)(C.lds + RING_OFF);
    for (int task = C.bid; task < 8 * (SEG + 1); task += C.G) { const int bh = task / (SEG + 1), seg = task % (SEG + 1);
        __syncthreads();
        if (C.wave == 0) { const float gg = CHG[bh * 64 + C.lane], aa = CHA[bh * 64 + C.lane]; float m = 0.f, dmine = 0.f, wmine = 0.f, mmine = 0.f;
            for (int c = 0; c < 64; ++c) { const float g1 = __shfl(gg, c), a1 = __shfl(aa, c); const float mn = fmaxf(g1 + m, a1); const float dd = __expf(g1 + m - mn), ww = __expf(a1 - mn);
                if (C.lane == c) { dmine = dd; wmine = ww; mmine = m; } m = mn; }
            sc[C.lane] = dmine; sc[64 + C.lane] = wmine; if (seg == SEG) MIN_[bh * 64 + C.lane] = mmine; }
        __syncthreads();
        if (seg < SEG) { const int idx = seg * 1024 + 2 * C.tid; const float* src = U + (size_t)bh * 64 * NC + idx; bf16* dst = CIN + (size_t)bh * 64 * NC + idx;
            f32x2 u[64];
#pragma unroll
            for (int c = 0; c < 64; ++c) u[c] = *(const GAS f32x2*)(src + (size_t)c * NC);
            float v0 = 0.f, v1 = 0.f;
#pragma unroll
            for (int c = 0; c < 64; ++c) { *(GAS unsigned*)(dst + (size_t)c * NC) = pk2(v0, v1); const float dd = sc[c], ww = sc[64 + c]; v0 = dd * v0 + ww * u[c].x; v1 = dd * v1 + ww * u[c].y; } }
        else if (C.tid < 96) { const float* src = NLOC + (size_t)bh * 64 * 96 + C.tid; float u[64];
#pragma unroll
            for (int c = 0; c < 64; ++c) u[c] = src[(size_t)c * 96];
            float val = 0.f;
#pragma unroll
            for (int c = 0; c < 64; ++c) { NIN[(size_t)(bh * 64 + c) * 96 + C.tid] = val; val = sc[c] * val + sc[64 + c] * u[c]; } }
    }
}
template <int MODE>
__device__ __forceinline__ void chunk_out_unit(Ctx& C, int unit, const bf16* P, const bf16* QKC, const bf16* SIN, bf16* MIX) {
    typedef CML<MODE> Lm; constexpr int DK = Lm::DK, DV = Lm::DV, NH = CMT<MODE>::NH, LDP = CMT<MODE>::LDP, NV = DV / 16, NKS = DK / 32;
    LAS unsigned char* L = C.lds + RING_OFF; LAS float* aux = (LAS float*)(L + Lm::AUX);
    const int bh = unit >> 6, c = unit & 63, b = bh / NH, h = bh % NH, t = C.tid, i = C.lane & 15, g = C.lane >> 4, w = C.wave;
    const size_t row0 = (size_t)b * SEQ + (size_t)c * 128;
    StageRegs<128, DK> rQ, rK; StageRegs<128, DV> rV; StageRegs<DK, DV> rS;
    stage_ld<128, DK>(rQ, MODE == 0 ? P + row0 * LDP + h * 64 : QKC + row0 * 768 + h * 96, MODE == 0 ? LDP : 768, t);
    stage_ld<128, DK>(rK, MODE == 0 ? P + row0 * LDP + 384 + h * 64 : QKC + row0 * 768 + 384 + h * 96, MODE == 0 ? LDP : 768, t);
    stage_ld<128, DV>(rV, P + row0 * LDP + 768 + h * DV, LDP, t);
    stage_ld<DK, DV>(rS, SIN + (size_t)unit * DK * DV, DV, t);
    float auxv = 0.f; if (MODE == 1) { if (t < 384) auxv = WSP(float, WS_ROUTE + RT_AUXG)[(size_t)unit * 512 + t]; else if (t < 384 + 96) auxv = WSP(float, WS_ROUTE + RT_NIN)[(size_t)unit * 96 + t - 384]; }
    f32x4 gnv = (f32x4){0.f, 0.f, 0.f, 0.f}; if (MODE == 1 && t < 48) gnv = *(const GAS f32x4*)(C.in[19] + h * DV + 4 * t);
    __syncthreads();
    if (MODE == 1) { if (t < 384) aux[t] = auxv; else if (t < 384 + 96) aux[512 + t - 384] = auxv; if (t < 48) *(LAS f32x4*)(aux + 640 + 4 * t) = gnv; }
    stage_st<128, DK, false>(rQ, L + Lm::Q, Lm::LDQK, nullptr, 1.0f, t);
    if (MODE == 0) stage_st<128, DK, true>(rK, L + Lm::K, Lm::LDQK, nullptr, 0.125f, t); else stage_st<128, DK, false>(rK, L + Lm::K, Lm::LDQK, nullptr, 1.0f, t);
    stage_st<128, DV, false>(rV, L + Lm::V, Lm::LDV, nullptr, 1.0f, t);
    stage_st<DK, DV, false>(rS, L + Lm::S, Lm::LDV, nullptr, 1.0f, t);
    __syncthreads();
    const int qt = w < 4 ? w : 11 - w;
    const int iq = 16 * qt + i;
    v2u gwv[NV];
    { const bf16* gp0 = P + (row0 + iq) * LDP + 1536 + h * DV + 4 * g;
#pragma unroll
      for (int vt = 0; vt < NV; ++vt) gwv[vt] = *(const GAS v2u*)(gp0 + 16 * vt); }
    float m_in_early = 0.f; if (MODE == 1) m_in_early = WSP(float, WS_ROUTE + RT_MIN)[unit];
    bf16x8 qf[NKS];
#pragma unroll
    for (int s = 0; s < NKS; ++s) qf[s] = frag_rows(L + Lm::Q, Lm::LDQK, 16 * qt, 64 * s, i, g);
    f32x4 o[NV];
    constexpr int QB = NV / 4, NB1 = 4 * NKS;
    bf16x8 fb[2][QB];
#pragma unroll
    for (int vt = 0; vt < NV; ++vt) o[vt] = (f32x4){0.f, 0.f, 0.f, 0.f};
#define CO_LDS(b_) { _Pragma("unroll") for (int k = 0; k < QB; ++k) fb[(b_) & 1][k] = frag_tr(L + Lm::S, Lm::LDV, 32 * ((b_) >> 2), 32 * (((b_) & 3) * QB + k), i, g, false); asm volatile("" ::: "memory"); }
    CO_LDS(0)
#pragma unroll
    for (int b = 0; b < NB1; ++b) { if (b + 1 < NB1) CO_LDS(b + 1)
#pragma unroll
        for (int k = 0; k < QB; ++k) o[(b & 3) * QB + k] = MFMA16(fb[b & 1][k], qf[b >> 2], o[(b & 3) * QB + k]); }
#undef CO_LDS
    float colscale, ri = 0.f, emi = 1.f, den = 0.f;
    const float l2g = MODE == 0 ? log2f(1.0f - exp2f(-5.0f - (float)h)) : 0.f;
    if (MODE == 0) colscale = exp2f((float)(iq + 1) * l2g);
    else { const float m_in = m_in_early; const float bi = aux[iq], mxc = fmaxf(m_in, aux[256 + iq]);
        ri = -mxc; colscale = __expf(m_in - mxc); emi = __expf(-(bi + mxc));
        float nq = 0.f;
#pragma unroll
        for (int s = 0; s < NKS; ++s) { const v4u qw = __builtin_bit_cast(v4u, qf[s]); const f32x4 n0 = *(const LAS f32x4*)(aux + 512 + 32 * s + 8 * g), n1 = *(const LAS f32x4*)(aux + 512 + 32 * s + 8 * g + 4);
            nq += bflo(qw.x) * n0[0] + bfhi(qw.x) * n0[1] + bflo(qw.y) * n0[2] + bfhi(qw.y) * n0[3] + bflo(qw.z) * n1[0] + bfhi(qw.z) * n1[1] + bflo(qw.w) * n1[2] + bfhi(qw.w) * n1[3]; }
        nq += __shfl_xor(nq, 16); nq += __shfl_xor(nq, 32);
        den = colscale * nq; }
#pragma unroll
    for (int vt = 0; vt < NV; ++vt) o[vt] = o[vt] * colscale;
    float dsum = 0.f;
#pragma unroll
    for (int pr = 0; pr < 4; ++pr) {
        if (2 * pr <= qt) {
            f32x4 st[2]; bf16x8 kf[2][NKS];
#pragma unroll
            for (int u = 0; u < 2; ++u)
#pragma unroll
                for (int s = 0; s < NKS; ++s) kf[u][s] = frag_rows(L + Lm::K, Lm::LDQK, 16 * (2 * pr + u), 64 * s, i, g);
            f32x4 cjv[2]; if (MODE == 1) { cjv[0] = *(const LAS f32x4*)(aux + 128 + 32 * pr + 4 * g); cjv[1] = *(const LAS f32x4*)(aux + 128 + 32 * pr + 16 + 4 * g); }
#define CO_LDV(q_) { _Pragma("unroll") for (int k = 0; k < QB; ++k) fb[(q_) & 1][k] = frag_tr(L + Lm::V, Lm::LDV, 32 * pr, 32 * ((q_) * QB + k), i, g, true); asm volatile("" ::: "memory"); }
            CO_LDV(0)
            st[0] = (f32x4){0.f, 0.f, 0.f, 0.f}; st[1] = (f32x4){0.f, 0.f, 0.f, 0.f};
#pragma unroll
            for (int s = 0; s < NKS; ++s) { st[0] = MFMA16(kf[0][s], qf[s], st[0]); st[1] = MFMA16(kf[1][s], qf[s], st[1]); }
            CO_LDV(1)
#pragma unroll
            for (int u = 0; u < 2; ++u) { const int tt = 2 * pr + u;
                f32x4 cj; if (MODE == 1) cj = cjv[u];
#pragma unroll
                for (int r = 0; r < 4; ++r) { const int j = 16 * tt + 4 * g + r; const bool valid = j <= iq;
                    const float wgt = MODE == 0 ? exp2f((float)(iq - j) * l2g) : __expf(fminf(ri + cj[r], 0.f));
                    st[u][r] = valid ? st[u][r] * wgt : 0.f; dsum += st[u][r]; } }
            const bf16x8 pb = pack_acc2(st[0], st[1]);
#pragma unroll
            for (int q = 0; q < 4; ++q) {
#pragma unroll
                for (int k = 0; k < QB; ++k) o[q * QB + k] = MFMA16(fb[q & 1][k], pb, o[q * QB + k]);
                if (q + 2 < 4) CO_LDV(q + 2) }
#undef CO_LDV
        }
    }
    const size_t tok = row0 + iq; float ss = 0.f;
    if (MODE == 1) { dsum += __shfl_xor(dsum, 16); dsum += __shfl_xor(dsum, 32); den += dsum; const float inv = 1.0f / fmaxf(fabsf(den), emi);
#pragma unroll
        for (int vt = 0; vt < NV; ++vt) o[vt] = o[vt] * inv; }
#pragma unroll
    for (int vt = 0; vt < NV; ++vt) ss += (o[vt][0] * o[vt][0] + o[vt][1] * o[vt][1]) + (o[vt][2] * o[vt][2] + o[vt][3] * o[vt][3]);
    ss += __shfl_xor(ss, 16); ss += __shfl_xor(ss, 32);
    const float rs = 1.0f / sqrtf(ss * (1.0f / DV) + 1e-6f);
    bf16* op = MIX + tok * D + h * DV + 4 * g;
#pragma unroll
    for (int vt = 0; vt < NV; ++vt) { const v2u gw = gwv[vt]; float gv[4] = {bflo(gw.x), bfhi(gw.x), bflo(gw.y), bfhi(gw.y)}; float r4[4];
        if (MODE == 0) {
#pragma unroll
            for (int r = 0; r < 4; ++r) r4[r] = silu1(gv[r]) * o[vt][r] * rs; }
        else { const f32x4 gn = *(const LAS f32x4*)(aux + 640 + 16 * vt + 4 * g);
#pragma unroll
            for (int r = 0; r < 4; ++r) r4[r] = sigmoid1(gv[r]) * o[vt][r] * rs * gn[r]; }
        v2u wv; wv.x = cvtpk(r4[0], r4[1]); wv.y = cvtpk(r4[2], r4[3]); *(GAS v2u*)(op + 16 * vt) = wv; }
}

struct Args { const float* in[27]; float* out; unsigned char* ws; int ph_lo, ph_hi; };
static_assert(sizeof(Args) == 27 * 8 + 8 + 8 + 8, "Args has no padding");

#define GEMM_CALL(EpiT, SchedT, g, S, E) pg8::gemm_phase<EpiT, SchedT, true, true>(C.lds + RING_OFF, g, S, E)

__global__ void __launch_bounds__(NWAVES * 64, 2) trunk_fwd(Args args) {
    extern __shared__ __attribute__((aligned(16))) unsigned char lds_raw[];
    Ctx C;
    C.lds = (LAS unsigned char*)lds_raw;
    C.tid = threadIdx.x; C.lane = C.tid & 63; C.wave = __builtin_amdgcn_readfirstlane(C.tid >> 6);
    C.G = gridDim.x; C.bid = blockIdx.x; C.gw = C.bid * NWAVES + C.wave; C.NGW = C.G * NWAVES;
#pragma unroll
    for (int i = 0; i < 27; ++i) C.in[i] = args.in[i];
    C.out = args.out; C.ws = args.ws;
    volatile LAS unsigned* MISC = (volatile LAS unsigned*)(C.lds + MISC_OFF);
    for (int u = C.tid; u < (LDS_BYTES - LDSCTL_OFF) / 4; u += NWAVES * 64) ((LAS unsigned*)(C.lds + LDSCTL_OFF))[u] = 0u;
    __syncthreads();
    XcdBarrier bar; bar.bar = (unsigned*)(C.ws + WS_CTL) + CW_BAR; bar.x = 0; bar.st = nullptr;
    if (MK_SINGLE) bar = xcd_barrier_post((unsigned*)(C.ws + WS_CTL) + CW_BAR, MISC + 8);
    const int lo = args.ph_lo, hi = args.ph_hi;
#define IN(k) (lo <= (k) && (k) < hi)
#define DBL(k) (((DBL_MASK >> (k)) & 1ull) != 0ull)
#define SEAM(k) do { if (MK_SINGLE && IN((k) + 1)) xcd_barrier(bar); } while (0)
#define PH(k, ...) if (IN(k)) { __VA_ARGS__ if (DBL(k)) { for (int rep_ = 0; rep_ < DBL_REPS; ++rep_) { if (MK_SINGLE) xcd_barrier(bar); __VA_ARGS__ } } }

    bf16* HB = WSP(bf16, WS_HB); float* SS = WSP(float, WS_SS); bf16* Pb = WSP(bf16, WS_BIG + BIG_P); bf16* MIX = WSP(bf16, WS_BIG + BIG_MIX);
    float* SCR1 = WSP(float, WS_BIG + BIG_SCR1); bf16* QKC = WSP(bf16, WS_BIG + BIG_SCR2); bf16* SIN = WSP(bf16, WS_BIG + BIG_SCR2 + SCR2_STATE); bf16* HID = WSP(bf16, WS_BIG);
    const int* PANEL = WSP(int, WS_ROUTE + RT_PANEL); const int* NPp = WSP(int, WS_ROUTE + RT_NP); const float* SLOTRS = WSP(float, WS_ROUTE + RT_SLOTRS);

#define G_INPROJ(layer, NN) { pg8::Gemm g{HB, WSP(bf16, WS_WIN + WIN_OFF[layer]), M, NN, D}; pg8::StaticOrder S; S.init(M, NN, C.G, C.bid); \
        pg8::EpiScaleBf16 E{Pb, NN, SS, rstd_table(C, S, SS)}; GEMM_CALL(pg8::EpiScaleBf16, pg8::StaticOrder, g, S, E); }
#define G_OUTPROJ(layer) { pg8::Gemm g{MIX, WSP(bf16, WS_WOUT + (size_t)(layer) * 2 * MiB), M, D, D}; pg8::StaticOrder S; S.init(M, D, C.G, C.bid); \
        pg8::EpiResid E{HB, SS, (PG8_LAS float*)(C.lds + 131072)}; GEMM_CALL(pg8::EpiResid, pg8::StaticOrder, g, S, E); }
#define G_GATEUP_DENSE(j) { pg8::Gemm g{HB, WSP(bf16, WS_WFD + (j) * FD_STRIDE), M, 2 * FF, D}; pg8::StaticOrder S; S.init(M, 2 * FF, C.G, C.bid); \
        pg8::EpiSwiglu<false> E{HID, SS, rstd_table(C, S, SS)}; GEMM_CALL(pg8::EpiSwiglu<false>, pg8::StaticOrder, g, S, E); }
#define G_DOWN_DENSE(j) { pg8::Gemm g{HID, WSP(bf16, WS_WFD + (j) * FD_STRIDE + FD_WD), M, D, FF}; pg8::StaticOrder S; S.init(M, D, C.G, C.bid); \
        pg8::EpiResid E{HB, SS, (PG8_LAS float*)(C.lds + 131072)}; GEMM_CALL(pg8::EpiResid, pg8::StaticOrder, g, S, E); }
#define G_GATEUP_MOE(j) { pg8::Gemm g{HB, WSP(bf16, WS_WMOE + (j) * MOE_STRIDE), MAXSLOT, NE * 2 * FF, D, WSP(int, WS_ROUTE + RT_ROWTOK)}; pg8::MoeOrder S; S.init(NPp, PANEL, 28, C.G, C.bid); \
        pg8::EpiSwiglu<true> E{HID, SLOTRS, nullptr}; pg8::gemm_phase<pg8::EpiSwiglu<true>, pg8::MoeOrder, true, true, true>(C.lds + RING_OFF, g, S, E); }
#define G_DOWN_MOE(j) { pg8::Gemm g{HID, WSP(bf16, WS_WMOE + (j) * MOE_STRIDE + MOE_WD), MAXSLOT, NE * D, FF}; pg8::MoeOrder S; S.init(NPp, PANEL, 4, C.G, C.bid); \
        if (C.G == 256) S.max_rounds = 2; pg8::EpiYBf16 E{WSP(bf16, WS_Y)}; GEMM_CALL(pg8::EpiYBf16, pg8::MoeOrder, g, S, E); } \
    if (C.G == 256) { const int tail = C.bid / 7, ks = C.bid % 7; \
        pg8::Gemm g{HID + ks * 512, WSP(bf16, WS_WMOE + (j) * MOE_STRIDE + MOE_WD) + ks * 512, MAXSLOT, NE * D, 512, nullptr, FF}; \
        pg8::MoeOrder S; S.init(NPp, PANEL, 4, C.G, tail); S.first_round = 2; S.max_rounds = (C.bid < 224) ? 3 : 0; \
        pg8::EpiSlab E{WSP(float, WS_SLAB), WSP(int, WS_ROUTE + RT_TAILIDX), tail, ks}; GEMM_CALL(pg8::EpiSlab, pg8::MoeOrder, g, S, E); }
#define G_MEMKV() { pg8::Gemm g{WSP(bf16, WS_MEMN), WSP(bf16, WS_WMEM), MROWS, 2048, D}; pg8::StaticOrder S; S.init(MROWS, 2048, C.G, (C.bid + 16) % C.G); \
        pg8::EpiPlainBf16 E{WSP(bf16, WS_MKV), 2048}; GEMM_CALL(pg8::EpiPlainBf16, pg8::StaticOrder, g, S, E); }
#define MEMATTN(layer, NN) for (int u = C.bid; u < 256; u += C.G) attn_mem_pair(C, u, Pb, NN, C.in[5] + (layer) * 64, C.in[6] + (layer) * 64, layer, MIX);
#define FFN_DENSE(k, j) PH(k, G_GATEUP_DENSE(j) SEAM(k);) PH((k) + 1, G_DOWN_DENSE(j) SEAM((k) + 1);)
#define FFN_MOE(k, j, layer) PH(k, moe_route1(C, j, layer); SEAM(k);) PH((k) + 1, moe_route2(C); SEAM((k) + 1);) PH((k) + 2, G_GATEUP_MOE(j) SEAM((k) + 2);) \
        PH((k) + 3, G_DOWN_MOE(j) SEAM((k) + 3);) PH((k) + 4, moe_combine<(layer) == 3>(C); SEAM((k) + 4);)

    PH(0, p_prologue(C); SEAM(0);)
    PH(1, G_MEMKV() G_INPROJ(0, N_SWA) SEAM(1);)
    PH(2, for (int u = C.bid; u < 512; u += C.G) attn_swa_unit(C, u, Pb, N_SWA, C.in[10], C.in[11], C.in[12], 768, 1024, MIX);
          MEMATTN(0, N_SWA) SEAM(2);)
    PH(3, G_OUTPROJ(0) SEAM(3);)
    FFN_DENSE(4, 0)
#define IDLE_TP(win) if (C.G == 256 && C.bid >= 128) tp_run(C, TP_MOVED_LO + (win) * TP_WIN_N + C.bid - 128, 128, TP_MOVED_LO + ((win) + 1) * TP_WIN_N, 1 << 30, 0);
    PH(6, G_INPROJ(1, N_RET) IDLE_TP(0) SEAM(6);)
    PH(7, for (int u = C.bid; u < 768; u += C.G) chunk_state_unit<0>(C, u, Pb, nullptr, SCR1); MEMATTN(1, N_RET) SEAM(7);)
    PH(8, ret_scan(C, SCR1, SIN); SEAM(8);)
    PH(9, for (int u = C.bid; u < 768; u += C.G) chunk_out_unit<0>(C, u, Pb, nullptr, SIN, MIX); SEAM(9);)
    PH(10, G_OUTPROJ(1) SEAM(10);)
    FFN_MOE(11, 0, 1)
    PH(16, G_INPROJ(2, N_MLS) mls_gates(C); IDLE_TP(1) SEAM(16);)
    PH(17, mls_aux(C); mls_conv(C, Pb, QKC); SEAM(17);)
    PH(18, for (int u = C.bid; u < 512; u += C.G) chunk_state_unit<1>(C, u, Pb, QKC, SCR1); MEMATTN(2, N_MLS) SEAM(18);)
    PH(19, mls_scan(C, SCR1, SIN); SEAM(19);)
    PH(20, for (int u = C.bid; u < 512; u += C.G) chunk_out_unit<1>(C, u, Pb, QKC, SIN, MIX); SEAM(20);)
    PH(21, G_OUTPROJ(2) SEAM(21);)
    FFN_DENSE(22, 1)
    PH(24, G_INPROJ(3, N_SWA) IDLE_TP(2) SEAM(24);)
    PH(25, for (int u = C.bid; u < 512; u += C.G) attn_swa_unit(C, u, Pb, N_SWA, C.in[10] + 64, C.in[11] + 64, C.in[12] + 12, 768, 1024, MIX);
           MEMATTN(3, N_SWA) SEAM(25);)
    PH(26, G_OUTPROJ(3) SEAM(26);)
    FFN_MOE(27, 1, 3)
#undef IN
}

extern "C" void kernel_launch(void* const* d_in, const int* in_sizes, int n_in, void* d_out, int out_size, void* d_ws, size_t ws_size, hipStream_t stream) {
    static int grid = 0;
    if (grid == 0) {
        if (n_in != 27 || in_sizes[0] != M * D || out_size != M * D || ws_size < WS_END) { fprintf(stderr, "kernel_launch: unexpected shapes (n_in %d, in0 %d, out %d, ws %zu < %zu)\n", n_in, n_in > 0 ? in_sizes[0] : -1, out_size, ws_size, (size_t)WS_END); grid = -1; return; }
        int dev = 0, cus = 0, per_cu = 0;
        if (hipGetDevice(&dev) != hipSuccess || hipDeviceGetAttribute(&cus, hipDeviceAttributeMultiprocessorCount, dev) != hipSuccess) { grid = -1; return; }
        if (hipFuncSetAttribute((const void*)trunk_fwd, hipFuncAttributeMaxDynamicSharedMemorySize, LDS_BYTES) != hipSuccess) { fprintf(stderr, "kernel_launch: hipFuncSetAttribute failed\n"); grid = -1; return; }
        if (hipOccupancyMaxActiveBlocksPerMultiprocessor(&per_cu, (const void*)trunk_fwd, NWAVES * 64, LDS_BYTES) != hipSuccess || per_cu < 1) fprintf(stderr, "kernel_launch: occupancy query says %d\n", per_cu);
        (void)hipGetLastError();
        grid = cus;
    }
    if (grid < 0) return;
    if (hipMemsetAsync((char*)d_ws + WS_CTL, 0, CTL_ZERO_BYTES, stream) != hipSuccess) return;
    Args a{};
    for (int i = 0; i < 27; ++i) a.in[i] = (const float*)d_in[i];
    a.out = (float*)d_out; a.ws = (unsigned char*)d_ws;
    if (MK_SINGLE) { a.ph_lo = 0; a.ph_hi = NPHASE; hipLaunchKernelGGL(trunk_fwd, dim3(grid), dim3(NWAVES * 64), LDS_BYTES, stream, a); }
    else for (int p = 0; p < NPHASE; ++p) { a.ph_lo = p; a.ph_hi = p + 1; hipLaunchKernelGGL(trunk_fwd, dim3(grid), dim3(NWAVES * 64), LDS_BYTES, stream, a); }
}
```

```cpp
#include <hip/hip_runtime.h>
#include <cstdio>
#include <cstdint>
namespace pg8 {
#define PG8_LAS __attribute__((address_space(3)))
typedef unsigned short bf16_t;
typedef short bf16x8 __attribute__((ext_vector_type(8)));
typedef float f32x4 __attribute__((ext_vector_type(4)));
typedef unsigned u32x4 __attribute__((ext_vector_type(4)));
constexpr int BM = 256, BK = 64, HALF = 128, HTB = HALF * BK * 2  , STAGE_BYTES = 8 * HTB, NXCD = 8, WGM = 8;

__host__ __device__ __forceinline__ int lds_byte(int r, int c) { const int st = (r >> 4) * 2 + (c >> 5), rr = r & 15, cc = c & 31, ob = rr * 64 + cc * 2; return st * 1024 + (ob ^ (((ob >> 9) & 1) << 5)); }
__host__ __device__ __forceinline__ void stage_rc(int b, int& R, int& C) { const int st = b / 1024, sb = b % 1024, swz = sb ^ (((sb >> 9) & 1) << 5); R = (st >> 1) * 16 + swz / 64; C = (st & 1) * 32 + (swz % 64) / 2; }
__host__ __device__ __forceinline__ int perm32(int rho) { const int n = rho >> 4, i = rho & 15; return 8 * (i >> 2) + 4 * n + (i & 3); }

struct Unit { int pm, pn; };
struct Gemm { const bf16_t* A; const bf16_t* Bt; int M, N, K; const int* rowmap; int ld; };

struct StaticOrder {
    int nM, nN, nwg, G, c;
    __host__ __device__ void init(int M, int N, int G_, int c_) { nM = M / BM; nN = N / BM; nwg = nM * nN; G = G_; c = c_; }
    __host__ __device__ bool next(int i, Unit& u) const {
        const long L = (long)i * G + c; if (L >= nwg) return false;
        int wgid = (int)L; { const int q = nwg / NXCD, r = nwg % NXCD, xcd = wgid % NXCD, off = wgid / NXCD; wgid = (xcd < r ? xcd * (q + 1) : r * (q + 1) + (xcd - r) * q) + off; }
        const int nig = WGM * nN, gid = wgid / nig, fm = gid * WGM, gsz = (nM - fm) < WGM ? (nM - fm) : WGM;
        u.pm = fm + ((wgid % nig) % gsz); u.pn = (wgid % nig) / gsz; return true;
    }
    __device__ __forceinline__ void a_ready(const Unit&) const {}
    __device__ __forceinline__ void done(const Unit&) const {}
};

__device__ __forceinline__ unsigned cvt_pk_bf16(float lo, float hi) { unsigned r; asm volatile("v_cvt_pk_bf16_f32 %0, %1, %2" : "=v"(r) : "v"(lo), "v"(hi)); return r; }
__device__ __forceinline__ float row_rstd16(const float* SS, int row) {
    const f32x4 a = *(const f32x4*)(SS + (size_t)row * 4);
    return 1.0f / sqrtf(((a[0] + a[1]) + (a[2] + a[3])) * (1.0f / 1024.0f) + 1e-6f);
}
typedef float f32x2 __attribute__((ext_vector_type(2)));

struct EpiPlainBf16 {
    static constexpr bool PERM = true, AFTER_DRAIN = false;
    bf16_t* O; int ldc;
    __device__ __forceinline__ void operator()(const f32x4 (&acc)[2][2][4][2], const Unit& u, int wr, int wc, int fr, int fq) const {
        const int row0 = u.pm * BM + wr * 64 + fr, col0 = u.pn * BM + wc * 32 + 8 * fq;
#pragma unroll
        for (int ai = 0; ai < 2; ++ai)
#pragma unroll
            for (int m = 0; m < 4; ++m) { bf16_t* rowp = O + (size_t)(row0 + ai * HALF + m * 16) * ldc + col0;
#pragma unroll
                for (int bj = 0; bj < 2; ++bj) { const f32x4 v0 = acc[ai][bj][m][0], v1 = acc[ai][bj][m][1];
                    u32x4 w; w.x = cvt_pk_bf16(v0[0], v0[1]); w.y = cvt_pk_bf16(v0[2], v0[3]); w.z = cvt_pk_bf16(v1[0], v1[1]); w.w = cvt_pk_bf16(v1[2], v1[3]);
                    *(u32x4*)(rowp + bj * HALF) = w; } }
    }
};
struct EpiScaleBf16 {
    static constexpr bool PERM = true, AFTER_DRAIN = false;
    bf16_t* O; int ldc; const float* SS; const PG8_LAS float* rsl;
    __device__ __forceinline__ void operator()(const f32x4 (&acc)[2][2][4][2], const Unit& u, int wr, int wc, int fr, int fq) const {
        const int row0 = u.pm * BM + wr * 64 + fr, col0 = u.pn * BM + wc * 32 + 8 * fq;
#pragma unroll
        for (int ai = 0; ai < 2; ++ai)
#pragma unroll
            for (int m = 0; m < 4; ++m) { const int row = row0 + ai * HALF + m * 16; const float sc = rsl ? rsl[row & 255] : row_rstd16(SS, row); bf16_t* rowp = O + (size_t)row * ldc + col0;
#pragma unroll
                for (int bj = 0; bj < 2; ++bj) { const f32x4 v0 = acc[ai][bj][m][0] * sc, v1 = acc[ai][bj][m][1] * sc;
                    u32x4 w; w.x = cvt_pk_bf16(v0[0], v0[1]); w.y = cvt_pk_bf16(v0[2], v0[3]); w.z = cvt_pk_bf16(v1[0], v1[1]); w.w = cvt_pk_bf16(v1[2], v1[3]);
                    *(u32x4*)(rowp + bj * HALF) = w; } }
    }
};
struct EpiResid {
    static constexpr bool PERM = true, AFTER_DRAIN = false;
    bf16_t* HB; float* SS; PG8_LAS float* xs;
    __device__ __forceinline__ void operator()(const f32x4 (&acc)[2][2][4][2], const Unit& u, int wr, int wc, int fr, int fq) const {
        const int row0 = u.pm * BM + wr * 64 + fr, col0 = u.pn * BM + wc * 32 + 8 * fq;
        u32x4 hv[2][4][2];
#pragma unroll
        for (int ai = 0; ai < 2; ++ai)
#pragma unroll
            for (int m = 0; m < 4; ++m) { const bf16_t* bp = HB + (size_t)(row0 + ai * HALF + m * 16) * 1024 + col0;
                hv[ai][m][0] = *(const u32x4*)bp; hv[ai][m][1] = *(const u32x4*)(bp + HALF); }
#pragma unroll
        for (int ai = 0; ai < 2; ++ai)
#pragma unroll
            for (int m = 0; m < 4; ++m) { const int row = row0 + ai * HALF + m * 16; bf16_t* bp = HB + (size_t)row * 1024 + col0; float ss = 0.f;
#pragma unroll
                for (int bj = 0; bj < 2; ++bj) { const u32x4 hw = hv[ai][m][bj];
                    f32x4 h0 = (f32x4){__uint_as_float(hw.x << 16), __uint_as_float(hw.x & 0xffff0000u), __uint_as_float(hw.y << 16), __uint_as_float(hw.y & 0xffff0000u)};
                    f32x4 h1 = (f32x4){__uint_as_float(hw.z << 16), __uint_as_float(hw.z & 0xffff0000u), __uint_as_float(hw.w << 16), __uint_as_float(hw.w & 0xffff0000u)};
                    h0 = h0 + acc[ai][bj][m][0]; h1 = h1 + acc[ai][bj][m][1];
                    ss += ((h0[0] * h0[0] + h0[1] * h0[1]) + (h0[2] * h0[2] + h0[3] * h0[3])) + ((h1[0] * h1[0] + h1[1] * h1[1]) + (h1[2] * h1[2] + h1[3] * h1[3]));
                    u32x4 w; w.x = cvt_pk_bf16(h0[0], h0[1]); w.y = cvt_pk_bf16(h0[2], h0[3]); w.z = cvt_pk_bf16(h1[0], h1[1]); w.w = cvt_pk_bf16(h1[2], h1[3]);
                    *(u32x4*)(bp + bj * HALF) = w; }
                ss += __shfl_xor(ss, 16); ss += __shfl_xor(ss, 32);
                if (fq == 0) xs[(ai * HALF + wr * 64 + m * 16 + fr) * 4 + wc] = ss; }
        asm volatile("s_waitcnt lgkmcnt(0)" ::: "memory"); __builtin_amdgcn_s_barrier(); asm volatile("" ::: "memory");
        if (threadIdx.x < 256) { const f32x4 v = *(const PG8_LAS f32x4*)(xs + 4 * threadIdx.x); SS[(size_t)(u.pm * BM + threadIdx.x) * 4 + u.pn] = (v[0] + v[1]) + (v[2] + v[3]); }
    }
};
template <bool MOE> struct EpiSwiglu {
    static constexpr bool PERM = true, AFTER_DRAIN = false;
    bf16_t* O; const float* RS; const PG8_LAS float* rsl;
    static __device__ __forceinline__ f32x2 swi2(f32x2 g, f32x2 u, float nsc, float sc2) {
        const f32x2 t = g * nsc; f32x2 d; d.x = __builtin_amdgcn_exp2f(t.x); d.y = __builtin_amdgcn_exp2f(t.y); d = d + 1.0f;
        f32x2 r; r.x = __builtin_amdgcn_rcpf(d.x); r.y = __builtin_amdgcn_rcpf(d.y);
        return ((g * u) * sc2) * r;
    }
    __device__ __forceinline__ void operator()(const f32x4 (&acc)[2][2][4][2], const Unit& u, int wr, int wc, int fr, int fq) const {
        const int pnl = MOE ? (u.pn % 28) : u.pn;
        const int row0 = u.pm * BM + wr * 64 + fr, col0 = pnl * HALF + wc * 32 + 8 * fq;
        float scv[2][4];
#pragma unroll
        for (int ai = 0; ai < 2; ++ai)
#pragma unroll
            for (int m = 0; m < 4; ++m) { const int row = row0 + ai * HALF + m * 16; scv[ai][m] = MOE ? RS[row] : (rsl ? rsl[row & 255] : row_rstd16(RS, row)); }
#pragma unroll
        for (int ai = 0; ai < 2; ++ai)
#pragma unroll
            for (int m = 0; m < 4; ++m) { const int row = row0 + ai * HALF + m * 16; const float sc = scv[ai][m], nsc = -1.4426950408889634f * sc, sc2 = sc * sc;
                const f32x4 g0 = acc[ai][0][m][0], g1 = acc[ai][0][m][1], u0 = acc[ai][1][m][0], u1 = acc[ai][1][m][1];
                const f32x2 a = swi2((f32x2){g0[0], g0[1]}, (f32x2){u0[0], u0[1]}, nsc, sc2), b = swi2((f32x2){g0[2], g0[3]}, (f32x2){u0[2], u0[3]}, nsc, sc2);
                const f32x2 c = swi2((f32x2){g1[0], g1[1]}, (f32x2){u1[0], u1[1]}, nsc, sc2), d = swi2((f32x2){g1[2], g1[3]}, (f32x2){u1[2], u1[3]}, nsc, sc2);
                u32x4 w; w.x = cvt_pk_bf16(a.x, a.y); w.y = cvt_pk_bf16(b.x, b.y); w.z = cvt_pk_bf16(c.x, c.y); w.w = cvt_pk_bf16(d.x, d.y);
                *(u32x4*)(O + (size_t)row * 3584 + col0) = w; }
    }
};
struct EpiYBf16 {
    static constexpr bool PERM = true, AFTER_DRAIN = false;
    bf16_t* Y;
    __device__ __forceinline__ void operator()(const f32x4 (&acc)[2][2][4][2], const Unit& u, int wr, int wc, int fr, int fq) const {
        const int pnl = u.pn & 3;
        const int row0 = u.pm * BM + wr * 64 + fr, col0 = pnl * BM + wc * 32 + 8 * fq;
#pragma unroll
        for (int ai = 0; ai < 2; ++ai)
#pragma unroll
            for (int m = 0; m < 4; ++m) { bf16_t* yp = Y + (size_t)(row0 + ai * HALF + m * 16) * 1024 + col0;
#pragma unroll
                for (int bj = 0; bj < 2; ++bj) { const f32x4 v0 = acc[ai][bj][m][0], v1 = acc[ai][bj][m][1];
                    u32x4 w; w.x = cvt_pk_bf16(v0[0], v0[1]); w.y = cvt_pk_bf16(v0[2], v0[3]); w.z = cvt_pk_bf16(v1[0], v1[1]); w.w = cvt_pk_bf16(v1[2], v1[3]);
                    *(u32x4*)(yp + bj * HALF) = w; } }
    }
};
struct EpiSlab {
    static constexpr bool PERM = true, AFTER_DRAIN = false;
    float* S; int* tailidx; int tail, ks;
    __device__ __forceinline__ void operator()(const f32x4 (&acc)[2][2][4][2], const Unit& u, int wr, int wc, int fr, int fq) const {
        float* sp = S + (size_t)(tail * 7 + ks) * 65536; const int row0 = wr * 64 + fr, col0 = wc * 32 + 8 * fq;
        if (ks == 0 && threadIdx.x == 0) tailidx[u.pm * 4 + (u.pn & 3)] = tail;
#pragma unroll
        for (int ai = 0; ai < 2; ++ai)
#pragma unroll
            for (int m = 0; m < 4; ++m) { float* yp = sp + (size_t)(row0 + ai * HALF + m * 16) * 256 + col0;
#pragma unroll
                for (int bj = 0; bj < 2; ++bj) { *(f32x4*)(yp + bj * HALF) = acc[ai][bj][m][0]; *(f32x4*)(yp + bj * HALF + 4) = acc[ai][bj][m][1]; } }
    }
};
struct MoeOrder {
    StaticOrder so; const int* panel_e; int ntn, max_rounds, first_round;
    __device__ void init(const int* np_ptr, const int* panel_e_, int ntn_, int G, int c) { const int np = __builtin_amdgcn_readfirstlane(*np_ptr); so.init(np * BM, ntn_ * BM, G, c); panel_e = panel_e_; ntn = ntn_; max_rounds = 1 << 20; first_round = 0; }
    __device__ bool next(int i, Unit& u) const { i += first_round; if (i >= max_rounds || !so.next(i, u)) return false; const int e = __builtin_amdgcn_readfirstlane(panel_e[u.pm]); u.pn += e * ntn; return true; }
    __device__ __forceinline__ void a_ready(const Unit&) const {}
    __device__ __forceinline__ void done(const Unit&) const {}
};
template <class Epi, class Sched, bool ALIGN_EPI = false, bool SP2 = false, bool GATHER = false>
__device__ __forceinline__ void gemm_phase(PG8_LAS unsigned char* lds, const Gemm g, const Sched& S, const Epi& E) {
    const int tid = threadIdx.x, wid = __builtin_amdgcn_readfirstlane(tid >> 6), lane = tid & 63, wr = wid >> 2, wc = wid & 3, fr = lane & 15, fq = lane >> 4;
    const int K = g.K, nt = K / BK, LD = g.ld ? g.ld : g.K;
    unsigned voffA[2], voffB[2]; int gR[2]; unsigned gC[2];
#pragma unroll
    for (int i = 0; i < 2; ++i) { int R, C; stage_rc(tid * 16 + i * 8192, R, C); const int Rb = Epi::PERM ? ((R & ~31) + perm32(R & 31)) : R;
        voffA[i] = (unsigned)(R * LD + C) * 2u; voffB[i] = (unsigned)(Rb * LD + C) * 2u; gR[i] = R; gC[i] = (unsigned)C * 2u; }
    const size_t kstep = (size_t)(BK * 2);
    const size_t hstep = (size_t)HALF * LD * 2;
    const size_t tstep = 2 * hstep;
    const unsigned ldsw = (unsigned)wid * 1024u;
    const int aoff = lds_byte(wr * 64 + fr, fq * 8), boff = lds_byte(wc * 32 + fr, fq * 8);
#define PG8_SA(b, h) (((b) * 2 + (h)) * HTB)
#define PG8_SB(b, h) ((4 + (b) * 2 + (h)) * HTB)
#define PG8_STAGE(bufoff, gbase, voff) do { _Pragma("unroll") for (int _i = 0; _i < 2; ++_i) \
        __builtin_amdgcn_global_load_lds((const unsigned*)((const char*)(gbase) + (voff)[_i]), (PG8_LAS unsigned*)(lds + (bufoff) + ldsw + _i * 8192), 16, 0, 0); } while (0)
#define PG8_GOFF(dst, pm_) do { _Pragma("unroll") for (int _h = 0; _h < 2; ++_h) _Pragma("unroll") for (int _i = 0; _i < 2; ++_i) \
        dst[_h][_i] = (unsigned)g.rowmap[(pm_) * BM + _h * HALF + gR[_i]] * (unsigned)(LD * 2) + gC[_i]; } while (0)
#define PG8_STAGE_A(bufoff, ptr, half, nx) do { if constexpr (GATHER) { const unsigned _o0 = (nx) ? gvN[half][0] : gvC[half][0], _o1 = (nx) ? gvN[half][1] : gvC[half][1]; \
        __builtin_amdgcn_global_load_lds((const unsigned*)((const char*)(ptr) + _o0), (PG8_LAS unsigned*)(lds + (bufoff) + ldsw), 16, 0, 0); \
        __builtin_amdgcn_global_load_lds((const unsigned*)((const char*)(ptr) + _o1), (PG8_LAS unsigned*)(lds + (bufoff) + ldsw + 8192), 16, 0, 0); } \
        else { PG8_STAGE(bufoff, (ptr) + (half) * hstep, voffA); } } while (0)
#define PG8_LDA(dst, b, h) do { _Pragma("unroll") for (int m = 0; m < 4; ++m) _Pragma("unroll") for (int k = 0; k < 2; ++k) dst[m][k] = *(const PG8_LAS bf16x8*)(lds + PG8_SA(b, h) + aoff + m * 2048 + k * 1024); } while (0)
#define PG8_LDB(dst, b, h) do { _Pragma("unroll") for (int n = 0; n < 2; ++n) _Pragma("unroll") for (int k = 0; k < 2; ++k) dst[n][k] = *(const PG8_LAS bf16x8*)(lds + PG8_SB(b, h) + boff + n * 2048 + k * 1024); } while (0)
#define PG8_MMA(ai, bj, At, Bt) do { __builtin_amdgcn_s_setprio(1); _Pragma("unroll") for (int m = 0; m < 4; ++m) _Pragma("unroll") for (int n = 0; n < 2; ++n) _Pragma("unroll") for (int k = 0; k < 2; ++k) \
        acc[ai][bj][m][n] = __builtin_amdgcn_mfma_f32_16x16x32_bf16(Bt[n][k], At[m][k], acc[ai][bj][m][n], 0, 0, 0); __builtin_amdgcn_s_setprio(0); } while (0)
#define PG8_WAIT_V(n) asm volatile("s_waitcnt vmcnt(" #n ")" ::: "memory")
#define PG8_WAIT_L(n) asm volatile("s_waitcnt lgkmcnt(" #n ")" ::: "memory")
#define PG8_BAR __builtin_amdgcn_s_barrier()
#define PG8_SCHED __builtin_amdgcn_sched_barrier(0)
    Unit cur, nxt; int ui = 0;
    if (!S.next(0, cur)) return;
    f32x4 acc[2][2][4][2];
#pragma unroll
    for (int a = 0; a < 2; ++a)
#pragma unroll
        for (int b = 0; b < 2; ++b)
#pragma unroll
            for (int m = 0; m < 4; ++m)
#pragma unroll
                for (int n = 0; n < 2; ++n) acc[a][b][m][n] = (f32x4){0.f, 0.f, 0.f, 0.f};
    bf16x8 At[4][2], B0[2][2], B1[2][2];
    unsigned gvC[2][2], gvN[2][2]; if constexpr (GATHER) { PG8_GOFF(gvC, cur.pm); PG8_GOFF(gvN, cur.pm); }
    const char* cA = GATHER ? (const char*)g.A : (const char*)g.A + (size_t)cur.pm * tstep; const char* cB = (const char*)g.Bt + (size_t)cur.pn * tstep;
    S.a_ready(cur);
    if constexpr (SP2) {
        PG8_STAGE(PG8_SB(0, 0), cB, voffB); PG8_STAGE(PG8_SB(0, 1), cB + hstep, voffB); PG8_STAGE_A(PG8_SA(0, 0), cA, 0, false); PG8_STAGE_A(PG8_SA(0, 1), cA, 1, false);
        if (wr == 1) PG8_BAR;
        PG8_WAIT_V(2); PG8_BAR;
        PG8_STAGE(PG8_SB(1, 0), cB + kstep, voffB); PG8_STAGE_A(PG8_SA(1, 0), cA + kstep, 0, false); PG8_STAGE(PG8_SB(1, 1), cB + hstep + kstep, voffB);
        PG8_WAIT_V(6); PG8_BAR;
    } else {
        PG8_STAGE(PG8_SB(0, 0), cB, voffB); PG8_STAGE_A(PG8_SA(0, 0), cA, 0, false); PG8_STAGE(PG8_SB(0, 1), cB + hstep, voffB); PG8_STAGE_A(PG8_SA(0, 1), cA, 1, false);
        if (wr == 1) PG8_BAR;
        PG8_WAIT_V(4); PG8_BAR;
        PG8_STAGE(PG8_SB(1, 0), cB + kstep, voffB); PG8_STAGE_A(PG8_SA(1, 0), cA + kstep, 0, false); PG8_STAGE(PG8_SB(1, 1), cB + hstep + kstep, voffB);
        PG8_WAIT_V(6); PG8_BAR;
    }
    for (;;) {
        const bool has_next = S.next(ui + 1, nxt);
        if constexpr (GATHER) { if (has_next) { PG8_GOFF(gvN, nxt.pm); } else { _Pragma("unroll") for (int _h = 0; _h < 2; ++_h) { gvN[_h][0] = gvC[_h][0]; gvN[_h][1] = gvC[_h][1]; } } }
        const char* nA = GATHER ? (const char*)g.A : (has_next ? (const char*)g.A + (size_t)nxt.pm * tstep : cA); const char* nB = has_next ? (const char*)g.Bt + (size_t)nxt.pn * tstep : cB;
        for (int t = 0; t < nt; t += 2) {
            const bool last = (t == nt - 2);
            const char* a1 = cA + (size_t)(t + 1) * kstep;
            const char* a2 = last ? nA : cA + (size_t)(t + 2) * kstep; const char* b2 = last ? nB : cB + (size_t)(t + 2) * kstep;
            const char* a3 = a2 + kstep; const char* b3 = b2 + kstep;
            if (last && has_next) S.a_ready(nxt);
            if constexpr (SP2) {
            PG8_LDB(B0, 0, 0); PG8_LDB(B1, 0, 1); PG8_SCHED; PG8_LDA(At, 0, 0); PG8_STAGE_A(PG8_SA(1, 1), a1, 1, false);
            PG8_WAIT_V(8); PG8_WAIT_L(0); PG8_BAR; PG8_MMA(0, 0, At, B0); PG8_MMA(0, 1, At, B1); PG8_BAR; PG8_SCHED;
            PG8_LDA(At, 0, 1); PG8_STAGE(PG8_SB(0, 0), b2, voffB); PG8_STAGE(PG8_SB(0, 1), b2 + hstep, voffB); PG8_STAGE_A(PG8_SA(0, 0), a2, 0, last);
            PG8_WAIT_V(8); PG8_WAIT_L(0); PG8_BAR; PG8_MMA(1, 0, At, B0); PG8_MMA(1, 1, At, B1); PG8_BAR; PG8_SCHED;
            PG8_LDB(B0, 1, 0); PG8_LDB(B1, 1, 1); PG8_SCHED; PG8_LDA(At, 1, 0); PG8_STAGE_A(PG8_SA(0, 1), a2, 1, last);
            PG8_WAIT_V(8); PG8_WAIT_L(0); PG8_BAR; PG8_MMA(0, 0, At, B0); PG8_MMA(0, 1, At, B1); PG8_BAR; PG8_SCHED;
            PG8_LDA(At, 1, 1); PG8_STAGE(PG8_SB(1, 0), b3, voffB); PG8_STAGE(PG8_SB(1, 1), b3 + hstep, voffB); PG8_STAGE_A(PG8_SA(1, 0), a3, 0, last);
            PG8_WAIT_V(8); PG8_WAIT_L(0); PG8_BAR; PG8_MMA(1, 0, At, B0); PG8_MMA(1, 1, At, B1); PG8_BAR; PG8_SCHED;
            } else {
            PG8_LDB(B0, 0, 0); PG8_SCHED; PG8_LDA(At, 0, 0); PG8_STAGE_A(PG8_SA(1, 1), a1, 1, false);
            PG8_WAIT_L(8); PG8_BAR; PG8_WAIT_L(0); PG8_MMA(0, 0, At, B0); PG8_BAR; PG8_SCHED;
            PG8_LDB(B1, 0, 1); PG8_STAGE(PG8_SB(0, 0), b2, voffB);
            PG8_BAR; PG8_WAIT_L(0); PG8_MMA(0, 1, At, B1); PG8_BAR;
            PG8_LDA(At, 0, 1); PG8_STAGE_A(PG8_SA(0, 0), a2, 0, last);
            PG8_BAR; PG8_WAIT_L(0); PG8_MMA(1, 0, At, B0); PG8_BAR; PG8_SCHED;
            PG8_STAGE(PG8_SB(0, 1), b2 + hstep, voffB);
            PG8_WAIT_V(6); PG8_BAR; PG8_MMA(1, 1, At, B1); PG8_BAR;
            PG8_LDB(B0, 1, 0); PG8_SCHED; PG8_LDA(At, 1, 0); PG8_STAGE_A(PG8_SA(0, 1), a2, 1, last);
            PG8_WAIT_L(8); PG8_BAR; PG8_WAIT_L(0); PG8_MMA(0, 0, At, B0); PG8_BAR; PG8_SCHED;
            PG8_LDB(B1, 1, 1); PG8_STAGE(PG8_SB(1, 0), b3, voffB);
            PG8_BAR; PG8_WAIT_L(0); PG8_MMA(0, 1, At, B1); PG8_BAR;
            PG8_LDA(At, 1, 1); PG8_STAGE_A(PG8_SA(1, 0), a3, 0, last);
            PG8_BAR; PG8_WAIT_L(0); PG8_MMA(1, 0, At, B0); PG8_BAR; PG8_SCHED;
            PG8_STAGE(PG8_SB(1, 1), b3 + hstep, voffB);
            PG8_WAIT_V(6); PG8_BAR; PG8_MMA(1, 1, At, B1); PG8_BAR;
            }
        }
        if constexpr (ALIGN_EPI) { if (wr == 0) PG8_BAR; }
        if constexpr (!Epi::AFTER_DRAIN) { E(acc, cur, wr, wc, fr, fq); S.done(cur); }
        if (!has_next) break;
#pragma unroll
        for (int a = 0; a < 2; ++a)
#pragma unroll
            for (int b = 0; b < 2; ++b)
#pragma unroll
                for (int m = 0; m < 4; ++m)
#pragma unroll
                    for (int n = 0; n < 2; ++n) acc[a][b][m][n] = (f32x4){0.f, 0.f, 0.f, 0.f};
        cur = nxt; cA = nA; cB = nB; ++ui;
        if constexpr (GATHER) { _Pragma("unroll") for (int _h = 0; _h < 2; ++_h) { gvC[_h][0] = gvN[_h][0]; gvC[_h][1] = gvN[_h][1]; } }
        if constexpr (ALIGN_EPI) { if (wr == 1) PG8_BAR; }
    }
    PG8_WAIT_V(0);
    if constexpr (!ALIGN_EPI) { if (wr == 0) PG8_BAR; }
    PG8_BAR;
    if constexpr (Epi::AFTER_DRAIN) { E.fused(acc, cur, wr, wc, fr, fq, lds, wid, lane); S.done(cur); }
#undef PG8_SA
#undef PG8_SB
#undef PG8_STAGE
#undef PG8_GOFF
#undef PG8_STAGE_A
#undef PG8_LDA
#undef PG8_LDB
#undef PG8_MMA
#undef PG8_WAIT_V
#undef PG8_WAIT_L
#undef PG8_BAR
#undef PG8_SCHED
}
}
constexpr int NWAVES = 8;
constexpr int BATCH = 2, SEQ = 8192, D = 1024, M = BATCH * SEQ, FF = 3584, NE = 8, MEMT = 256, MROWS = BATCH * MEMT;
constexpr int N_SWA = 1536, N_RET = 2560, N_MLS = 2560, MLS_SRC = 2568;
constexpr int MAXSLOT = 2 * M + NE * 256;
constexpr int NPHASE = 32;
#ifndef DBL_MASK
#define DBL_MASK 0ull
#endif
#ifndef DBL_REPS
#define DBL_REPS 1
#endif
#define PROF_MASK 0ull
#define PROF_SEC -1
#define PROF_AMP 10
#define TB(id) do { if (PROF_SEC == (id)) C.pt0 = rt(); } while (0)
#define TE(id) do { if (PROF_SEC == (id)) C.pacc += rt() - C.pt0; } while (0)
#ifndef MK_SINGLE
#define MK_SINGLE 1
#endif
constexpr size_t MiB = 1u << 20, KiB = 1024;
constexpr size_t WS_CTL = 0, CTL_ZERO_BYTES = 32 * KiB;
constexpr size_t WS_SS = 1 * MiB, WS_MEMN = 2 * MiB, WS_MKV = 3 * MiB, WS_ROUTE = 5 * MiB;
constexpr size_t RT_SEL = 0, RT_RSTD = 256 * KiB, RT_CNT = 320 * KiB, RT_PANEL = 328 * KiB, RT_NP = 329 * KiB, RT_TOKSLOT = 384 * KiB, RT_ROWTOK = 512 * KiB, RT_SLOTRS = 704 * KiB, RT_TAILIDX = 896 * KiB, RT_GATES = 1 * MiB, RT_AUXG = 2304 * KiB;
constexpr size_t WS_WIN = 8 * MiB, WS_WOUT = 24 * MiB, WS_WMEM = 32 * MiB, WS_WFD = 36 * MiB, WS_WMOE = 78 * MiB;
constexpr size_t WIN_OFF[4] = {0, 3 * MiB, 8 * MiB, 13 * MiB};
constexpr size_t FD_STRIDE = 21 * MiB, FD_WD = 14 * MiB, MOE_STRIDE = 168 * MiB, MOE_WD = 112 * MiB;
constexpr size_t WS_HB = 414 * MiB, WS_BIG = 446 * MiB, WS_Y = 684 * MiB, WS_SLAB = 820 * MiB, WS_END = 876 * MiB;
constexpr size_t BIG_P = 0, BIG_MIX = 80 * MiB, BIG_SCR1 = 112 * MiB, BIG_SCR2 = 160 * MiB;
constexpr int CW_BAR = 4096;
constexpr int RING_OFF = 0, RING_BYTES = 163328;
constexpr int LDSCTL_OFF = RING_BYTES, MISC_OFF = LDSCTL_OFF + 320;
constexpr int LDS_BYTES = 163840;


#define GAS __attribute__((address_space(1)))
#define LAS __attribute__((address_space(3)))
typedef unsigned short bf16;
typedef unsigned v4u __attribute__((ext_vector_type(4)));
typedef float f32x4 __attribute__((ext_vector_type(4)));
typedef short bf16x8 __attribute__((ext_vector_type(8)));
typedef GAS unsigned gu32;
typedef GAS unsigned long long gu64;
#define RLX_AGENT __ATOMIC_RELAXED, __HIP_MEMORY_SCOPE_AGENT
#define LDS_WAIT() asm volatile("s_waitcnt lgkmcnt(0)" ::: "memory")
#define VM_WAIT() asm volatile("s_waitcnt vmcnt(0)" ::: "memory")
__device__ __forceinline__ unsigned long long rt() { return __builtin_amdgcn_s_memrealtime(); }
__device__ __forceinline__ unsigned f2bf(float f) { unsigned u = __builtin_bit_cast(unsigned, f); return (u + 0x7fffu + ((u >> 16) & 1u)) >> 16; }
__device__ __forceinline__ unsigned pk2(float lo, float hi) { return f2bf(lo) | (f2bf(hi) << 16); }

#define XB_TMO      128
#define XB_XCNT(j)  (256  + 64 * (j))
#define XB_XSUB(j)  (1280 + 64 * (j))
#define XB_XGEN(j)  (2304 + 64 * (j))
#define XB_TOP      3328
#define XB_TOPGEN   3392
#define XCD_BAR_WORDS 3456
#define XB_SPIN_CAP (1u << 18)

__device__ __forceinline__ unsigned xb_ld(unsigned* p)              { return __hip_atomic_load(p, __ATOMIC_RELAXED, __HIP_MEMORY_SCOPE_AGENT); }
__device__ __forceinline__ unsigned xb_add(unsigned* p, unsigned v) { return __hip_atomic_fetch_add(p, v, __ATOMIC_RELAXED, __HIP_MEMORY_SCOPE_AGENT); }
__device__ __forceinline__ unsigned xb_xcc_id() { return (unsigned)__builtin_amdgcn_s_getreg((3 << 11) | 20) & 0xFu; }
#define XB_SPIN(cond, bar) do { unsigned _sp = 0; while (cond) { __builtin_amdgcn_s_sleep(1); \
    if ((++_sp & 255u) == 0u) { if (xb_ld(&(bar)[XB_TMO])) break; if (_sp > XB_SPIN_CAP) { atomicAdd(&(bar)[XB_TMO], 1u); break; } } } } while (0)

struct XcdBarrier {
    unsigned* bar; unsigned x;
    volatile LAS unsigned* st;
};

__device__ __forceinline__ XcdBarrier xcd_barrier_post(unsigned* bar, volatile LAS unsigned* st) {
    XcdBarrier b; b.bar = bar; b.x = xb_xcc_id(); b.st = st;
    if (threadIdx.x == 0) (void)xb_add(&bar[XB_XCNT(b.x)], 1u);
    return b;
}
__device__ __forceinline__ void xcd_barrier_complete(unsigned* bar, unsigned x, unsigned& nloc, unsigned& nx) {
    const unsigned G = gridDim.x * gridDim.y * gridDim.z;
    unsigned sum, cnt, mine, sp = 0u;
    for (;;) {
        sum = 0u; cnt = 0u; mine = 0u;
#pragma unroll
        for (unsigned j = 0; j < 16; ++j) { const unsigned c = xb_ld(&bar[XB_XCNT(j)]); sum += c; cnt += (c > 0u) ? 1u : 0u; mine = (j == x) ? c : mine; }
        if (sum == G) break;
        __builtin_amdgcn_s_sleep(1);
        if ((++sp & 255u) == 0u) { if (xb_ld(&bar[XB_TMO])) break; if (sp > XB_SPIN_CAP) { atomicAdd(&bar[XB_TMO], 1u); break; } }
    }
    nloc = mine > 0u ? mine : 1u; nx = cnt > 0u ? cnt : 1u;
}

__device__ __forceinline__ void xcd_barrier(const XcdBarrier& b) {
    asm volatile("s_waitcnt vmcnt(0)" ::: "memory");
    __syncthreads();
    if (threadIdx.x == 0) {
        unsigned* bar = b.bar;
        __builtin_amdgcn_s_waitcnt(0);
        unsigned nloc = b.st[0], nx = b.st[1];
        if (nloc == 0u) { xcd_barrier_complete(bar, b.x, nloc, nx); b.st[0] = nloc; b.st[1] = nx; }
        const unsigned old = xb_add(&bar[XB_XSUB(b.x)], 1u);
        const unsigned gen = old / nloc;
        if (old + 1u == (gen + 1u) * nloc) {
            __builtin_amdgcn_fence(__ATOMIC_RELEASE, "agent");
            asm volatile("s_waitcnt vmcnt(0)" ::: "memory");
            const unsigned og = xb_add(&bar[XB_TOP], 1u);
            const unsigned tg = og / nx;
            if (og + 1u == (tg + 1u) * nx) xb_add(&bar[XB_TOPGEN], 1u);
            else XB_SPIN(xb_ld(&bar[XB_TOPGEN]) == tg, bar);
            __builtin_amdgcn_fence(__ATOMIC_ACQUIRE, "agent");
            xb_add(&bar[XB_XGEN(b.x)], 1u);
            asm volatile("s_waitcnt vmcnt(0)" ::: "memory");
        } else {
            XB_SPIN(xb_ld(&bar[XB_XGEN(b.x)]) == gen, bar);
            __builtin_amdgcn_fence(__ATOMIC_ACQUIRE, "agent");
            asm volatile("s_waitcnt vmcnt(0)" ::: "memory");
        }
    }
    __syncthreads();
}


typedef unsigned v2u __attribute__((ext_vector_type(2)));
__device__ __forceinline__ float bflo(unsigned w) { return __uint_as_float(w << 16); }
__device__ __forceinline__ float bfhi(unsigned w) { return __uint_as_float(w & 0xffff0000u); }
__device__ __forceinline__ float wave_sum(float v) {
#pragma unroll
    for (int o = 1; o < 64; o <<= 1) v += __shfl_xor(v, o);
    return v;
}
__device__ __forceinline__ float silu1(float x) { return x / (1.0f + __expf(-x)); }
__device__ __forceinline__ float sigmoid1(float x) { return 1.0f / (1.0f + __expf(-x)); }

struct Ctx {
    LAS unsigned char* lds;
    int tid, lane, wave, gw, NGW, G, bid;
    const float* in[27];
    float* out;
    unsigned char* ws;
    unsigned long long pacc, pt0;
};
#define WSP(T, off) ((T*)(C.ws + (off)))

__device__ __forceinline__ unsigned cvt2(float lo, float hi) { unsigned r; asm volatile("v_cvt_pk_bf16_f32 %0, %1, %2" : "=v"(r) : "v"(lo), "v"(hi)); return r; }
struct TpDesc { const float* W; bf16* WT; const float* gain; int ldw, K, csrc0, drow0, mode, kb, nb; };
__device__ __forceinline__ void tp_decode(Ctx& C, int tile, TpDesc& d) {
    constexpr int T_FFN = 54 * 224, T_IN = 512, T_OUT = 256;
    d.gain = nullptr; d.csrc0 = 0; d.drow0 = 0; d.mode = 0;
    if (tile < T_FFN) {
        const int job = tile / 224, r = tile % 224; int which;
        if (job < 6) { const int j = job / 3; which = job % 3; unsigned char* base = C.ws + WS_WFD + j * FD_STRIDE;
            if (which < 2) { d.W = (which == 0 ? C.in[20] : C.in[21]) + (size_t)j * D * FF; d.WT = (bf16*)base; d.gain = C.in[8] + (2 * j) * D; }
            else { d.W = C.in[22] + (size_t)j * FF * D; d.WT = (bf16*)(base + FD_WD); }
        } else { const int q = job - 6, j = q / 24, e = (q % 24) / 3; which = q % 3; unsigned char* base = C.ws + WS_WMOE + j * MOE_STRIDE;
            if (which < 2) { d.W = (which == 0 ? C.in[24] : C.in[25]) + (size_t)(j * NE + e) * D * FF; d.WT = (bf16*)base + (size_t)e * 7168 * D; d.gain = C.in[8] + (2 * j + 1) * D; }
            else { d.W = C.in[26] + (size_t)(j * NE + e) * FF * D; d.WT = (bf16*)(base + MOE_WD) + (size_t)e * D * FF; }
        }
        if (which < 2) { d.ldw = FF; d.K = D; d.drow0 = which ? 128 : 0; d.mode = 1; d.kb = r / 14; d.nb = r % 14; }
        else { d.ldw = D; d.K = FF; d.kb = r / 4; d.nb = r % 4; }
    } else if (tile < T_FFN + T_IN) {
        int r = tile - T_FFN; d.K = D;
        if (r < 96) { d.W = C.in[9]; d.ldw = N_SWA; d.WT = WSP(bf16, WS_WIN + WIN_OFF[0]); d.gain = C.in[2] + 0 * D; d.kb = r / 6; d.nb = r % 6; }
        else if ((r -= 96) < 160) { d.W = C.in[13]; d.ldw = N_RET; d.WT = WSP(bf16, WS_WIN + WIN_OFF[1]); d.gain = C.in[2] + 1 * D; d.kb = r / 10; d.nb = r % 10; }
        else if ((r -= 160) < 144) { d.W = C.in[14]; d.ldw = MLS_SRC; d.WT = WSP(bf16, WS_WIN + WIN_OFF[2]); d.gain = C.in[2] + 2 * D; d.kb = r / 9; d.nb = r % 9; }
        else if ((r -= 144) < 16) { d.W = C.in[14]; d.ldw = MLS_SRC; d.csrc0 = 2312; d.drow0 = 2304; d.WT = WSP(bf16, WS_WIN + WIN_OFF[2]); d.gain = C.in[2] + 2 * D; d.kb = r; d.nb = 0; }
        else { r -= 16; d.W = C.in[9] + (size_t)D * N_SWA; d.ldw = N_SWA; d.WT = WSP(bf16, WS_WIN + WIN_OFF[3]); d.gain = C.in[2] + 3 * D; d.kb = r / 6; d.nb = r % 6; }
    } else if (tile < T_FFN + T_IN + T_OUT) {
        const int r = tile - T_FFN - T_IN, l = r >> 6, q = r & 63;
        d.W = C.in[7] + (size_t)l * D * D; d.ldw = D; d.K = D; d.WT = WSP(bf16, WS_WOUT + (size_t)l * 2 * MiB); d.kb = q >> 2; d.nb = q & 3;
    } else {
        const int r = tile - T_FFN - T_IN - T_OUT, l = r >> 5, q = r & 31;
        d.W = C.in[4] + (size_t)l * D * 512; d.ldw = 512; d.K = D; d.WT = WSP(bf16, WS_WMEM); d.drow0 = 512 * l; d.gain = C.in[3] + l * D; d.kb = q >> 1; d.nb = q & 1;
    }
}
__device__ __forceinline__ void tp_load(Ctx& C, const TpDesc& d, f32x4 (&v)[8], f32x4 (&gn)[2]) {
    const int k0 = d.kb * 64 + 8 * C.wave, n = d.nb * 256 + 4 * C.lane;
    if (d.gain) { gn[0] = *(const GAS f32x4*)(d.gain + k0); gn[1] = *(const GAS f32x4*)(d.gain + k0 + 4); }
#pragma unroll
    for (int kk = 0; kk < 8; ++kk) v[kk] = __builtin_nontemporal_load((const GAS f32x4*)(d.W + (size_t)(k0 + kk) * d.ldw + d.csrc0 + n));
}
constexpr int TP_ALL = 54 * 224 + 512 + 256 + 128;
constexpr int TP_WIN_N = 768, TP_MOVED_LO = 30 * 224, TP_MOVED_N = 3 * TP_WIN_N;
__device__ __forceinline__ void tp_run(Ctx& C, int first, int stride, int count, int skip_lo, int skip_len) {
    constexpr int TP_LD = 144, TP_BUF = 256 * TP_LD;
    TpDesc da, db; f32x4 va[8], vb[8], ga[2], gb[2]; int buf = 0;
    int tile = first;
    __syncthreads();
    if (tile < count) { tp_decode(C, tile >= skip_lo ? tile + skip_len : tile, da); tp_load(C, da, va, ga); }
    if (tile + stride < count) { const int t1 = tile + stride; tp_decode(C, t1 >= skip_lo ? t1 + skip_len : t1, db); tp_load(C, db, vb, gb); }
#define TP_STEP(d, v, gn) { LAS unsigned char* Lb = C.lds + RING_OFF + buf * TP_BUF; \
        if (d.gain) { _Pragma("unroll") for (int kk = 0; kk < 8; ++kk) v[kk] = v[kk] * gn[kk >> 2][kk & 3]; } \
        _Pragma("unroll") for (int c = 0; c < 4; ++c) { v4u o; o.x = cvt2(v[0][c], v[1][c]); o.y = cvt2(v[2][c], v[3][c]); o.z = cvt2(v[4][c], v[5][c]); o.w = cvt2(v[6][c], v[7][c]); \
            *(LAS v4u*)(Lb + (4 * C.lane + c) * TP_LD + 16 * C.wave) = o; } \
        const TpDesc dc = d; const int nx = tile + 2 * stride; \
        if (nx < count) { tp_decode(C, nx >= skip_lo ? nx + skip_len : nx, d); tp_load(C, d, v, gn); } \
        __syncthreads(); \
        _Pragma("unroll") for (int q = 0; q < 4; ++q) { const int id = C.tid + 512 * q, row = id >> 3, pc = id & 7; const int n = dc.nb * 256 + row; \
            const int drow = dc.mode ? dc.drow0 + (n >> 7) * 256 + (n & 127) : dc.drow0 + n; \
            *(GAS v4u*)(dc.WT + (size_t)drow * dc.K + dc.kb * 64 + 8 * pc) = *(const LAS v4u*)(Lb + row * TP_LD + 16 * pc); } \
        tile += stride; buf ^= 1; }
    while (tile < count) { TP_STEP(da, va, ga) if (tile >= count) break; TP_STEP(db, vb, gb) }
#undef TP_STEP
    __syncthreads();
}
__device__ __forceinline__ void p_prologue(Ctx& C) {
    if (C.G == 256) tp_run(C, C.bid, C.G, TP_ALL - TP_MOVED_N, TP_MOVED_LO, TP_MOVED_N); else tp_run(C, C.bid, C.G, TP_ALL, 1 << 30, 0);
    for (int m0 = C.gw; m0 < M; m0 += 4 * C.NGW) {
        f32x4 xv[4][4];
#pragma unroll
        for (int u = 0; u < 4; ++u) { const int m = m0 + u * C.NGW; if (m < M) { const GAS f32x4* xr = (const GAS f32x4*)(C.in[0] + (size_t)m * D) + C.lane;
#pragma unroll
            for (int j = 0; j < 4; ++j) xv[u][j] = __builtin_nontemporal_load(xr + 64 * j); } }
#pragma unroll
        for (int u = 0; u < 4; ++u) { const int m = m0 + u * C.NGW; if (m < M) {
            GAS unsigned long long* o8 = (GAS unsigned long long*)(WSP(bf16, WS_HB) + (size_t)m * D) + C.lane; float s = 0.f;
#pragma unroll
            for (int j = 0; j < 4; ++j) { const f32x4 v = xv[u][j]; s += (v.x * v.x + v.y * v.y) + (v.z * v.z + v.w * v.w);
                o8[64 * j] = (unsigned long long)pk2(v.x, v.y) | ((unsigned long long)pk2(v.z, v.w) << 32); }
            s = wave_sum(s);
            if (C.lane < 4) WSP(float, WS_SS)[(size_t)m * 4 + C.lane] = C.lane == 0 ? s : 0.f; } }
    }
    for (int m = C.gw; m < MROWS; m += C.NGW) {
        const GAS f32x4* xr = (const GAS f32x4*)(C.in[1] + (size_t)m * D) + C.lane; f32x4 v[4]; float s = 0.f;
#pragma unroll
        for (int j = 0; j < 4; ++j) { v[j] = xr[64 * j]; s += (v[j].x * v[j].x + v[j].y * v[j].y) + (v[j].z * v[j].z + v[j].w * v[j].w); }
        const float rs = 1.0f / sqrtf(wave_sum(s) * (1.0f / D) + 1e-6f);
        GAS unsigned long long* o8 = (GAS unsigned long long*)(WSP(bf16, WS_MEMN) + (size_t)m * D) + C.lane;
#pragma unroll
        for (int j = 0; j < 4; ++j) o8[64 * j] = (unsigned long long)pk2(v[j].x * rs, v[j].y * rs) | ((unsigned long long)pk2(v[j].z * rs, v[j].w * rs) << 32);
    }
}

__device__ __forceinline__ void ld8(const bf16* p, float (&f)[8]) { const v4u w = *(const GAS v4u*)p; f[0] = bflo(w.x); f[1] = bfhi(w.x); f[2] = bflo(w.y); f[3] = bfhi(w.y); f[4] = bflo(w.z); f[5] = bfhi(w.z); f[6] = bflo(w.w); f[7] = bfhi(w.w); }
__device__ __forceinline__ void load_w8(const float* gain, const float* W, int ldw, int c0, int lane, float (&RW)[16][8]) {
#pragma unroll
    for (int j = 0; j < 2; ++j)
#pragma unroll
        for (int i = 0; i < 8; ++i) { const int k = 8 * lane + 512 * j + i; const float gk = gain[k]; const float* wp = W + (size_t)k * ldw + c0;
#pragma unroll
            for (int e = 0; e < 8; ++e) RW[j * 8 + i][e] = gk * wp[e]; }
}
__device__ __forceinline__ void dots8(const bf16* hrow, const float (&RW)[16][8], int lane, float (&out)[8], float& rstd) {
    float acc[8]; float ss = 0.f;
#pragma unroll
    for (int e = 0; e < 8; ++e) acc[e] = 0.f;
#pragma unroll
    for (int j = 0; j < 2; ++j) { float hv[8]; ld8(hrow + 8 * lane + 512 * j, hv);
#pragma unroll
        for (int i = 0; i < 8; ++i) { ss += hv[i] * hv[i];
#pragma unroll
            for (int e = 0; e < 8; ++e) acc[e] += hv[i] * RW[j * 8 + i][e]; } }
    rstd = 1.0f / sqrtf(wave_sum(ss) * (1.0f / D) + 1e-6f);
#pragma unroll
    for (int e = 0; e < 8; ++e) out[e] = wave_sum(acc[e]) * rstd;
}
__device__ __forceinline__ void dots8_x4(Ctx& C, int m0, const float (&RW)[16][8], float& val, float& rs) {
    const int lane = C.lane; v4u raw[4][2];
#pragma unroll
    for (int t = 0; t < 4; ++t) { const bf16* hrow = WSP(bf16, WS_HB) + (size_t)(m0 + t) * D; raw[t][0] = *(const GAS v4u*)(hrow + 8 * lane); raw[t][1] = *(const GAS v4u*)(hrow + 8 * lane + 512); }
    float acc[32], ss[4];
#pragma unroll
    for (int t = 0; t < 4; ++t) { ss[t] = 0.f;
#pragma unroll
        for (int e = 0; e < 8; ++e) acc[t * 8 + e] = 0.f;
#pragma unroll
        for (int jj = 0; jj < 2; ++jj) { const v4u w = raw[t][jj]; const float hv[8] = {bflo(w.x), bfhi(w.x), bflo(w.y), bfhi(w.y), bflo(w.z), bfhi(w.z), bflo(w.w), bfhi(w.w)};
#pragma unroll
            for (int i = 0; i < 8; ++i) { ss[t] += hv[i] * hv[i];
#pragma unroll
                for (int e = 0; e < 8; ++e) acc[t * 8 + e] += hv[i] * RW[jj * 8 + i][e]; } } }
#pragma unroll
    for (int s = 0; s < 5; ++s) { const int d = 1 << s, hn = 16 >> s; const bool up = (lane & d) != 0;
#pragma unroll
        for (int q = 0; q < hn; ++q) { const float send = up ? acc[q] : acc[q + hn], keep = up ? acc[q + hn] : acc[q]; acc[q] = keep + __shfl_xor(send, d); } }
    const float lsum = acc[0] + __shfl_xor(acc[0], 32);
    { const bool up0 = (lane & 1) != 0; const float s0 = (up0 ? ss[2] : ss[0]) + __shfl_xor(up0 ? ss[0] : ss[2], 1), s1 = (up0 ? ss[3] : ss[1]) + __shfl_xor(up0 ? ss[1] : ss[3], 1);
      const bool up1 = (lane & 2) != 0; ss[0] = (up1 ? s1 : s0) + __shfl_xor(up1 ? s0 : s1, 2); }
    float sst = ss[0];
#pragma unroll
    for (int d = 4; d < 64; d <<= 1) sst += __shfl_xor(sst, d);
    rs = 1.0f / sqrtf(sst * (1.0f / D) + 1e-6f); val = lsum * rs;
}
__device__ __forceinline__ void mls_gates(Ctx& C) {
    const bool half = (C.G == 256); if (half && C.bid < 128) return;
    const int gw = half ? (C.bid - 128) * NWAVES + C.wave : C.gw, ngw = half ? 128 * NWAVES : C.NGW;
    float* GT = WSP(float, WS_ROUTE + RT_GATES); float RW[16][8];
    load_w8(C.in[2] + 2 * D, C.in[14], MLS_SRC, 2304, C.lane, RW);
    const int tk = ((C.lane & 1) << 1) | ((C.lane >> 1) & 1), ex = (((C.lane >> 2) & 1) << 2) | (((C.lane >> 3) & 1) << 1) | ((C.lane >> 4) & 1);
    for (int m0 = 4 * gw; m0 < M; m0 += 4 * ngw) { float val, rs; dots8_x4(C, m0, RW, val, rs);
        if (C.lane < 32) GT[(size_t)(m0 + tk) * 8 + ex] = val; }
}
__device__ __forceinline__ void mls_conv(Ctx& C, const bf16* P, bf16* QKC) {
    const float* cw = C.in[15]; const float* cb = C.in[16];
    const int nthr = C.G * NWAVES * 64, gt = C.bid * NWAVES * 64 + C.tid;
    for (int e = gt; e < (M / 16) * 96; e += nthr) { const int seg = e / 96, c0 = (e % 96) * 8, m0 = seg * 16; const bool first = (m0 & (SEQ - 1)) == 0;
        v4u raw[19];
#pragma unroll
        for (int r = 0; r < 19; ++r) { if (r >= 3 || !first) raw[r] = *(const GAS v4u*)(P + (size_t)(m0 - 3 + r) * N_MLS + c0); else raw[r] = (v4u){0u, 0u, 0u, 0u}; }
        float wv[4][8], bv[8];
#pragma unroll
        for (int j = 0; j < 4; ++j) { const f32x4 a = *(const GAS f32x4*)(cw + j * 768 + c0), b2 = *(const GAS f32x4*)(cw + j * 768 + c0 + 4);
            wv[j][0] = a.x; wv[j][1] = a.y; wv[j][2] = a.z; wv[j][3] = a.w; wv[j][4] = b2.x; wv[j][5] = b2.y; wv[j][6] = b2.z; wv[j][7] = b2.w; }
        { const f32x4 a = *(const GAS f32x4*)(cb + c0), b2 = *(const GAS f32x4*)(cb + c0 + 4); bv[0] = a.x; bv[1] = a.y; bv[2] = a.z; bv[3] = a.w; bv[4] = b2.x; bv[5] = b2.y; bv[6] = b2.z; bv[7] = b2.w; }
        const float sc = c0 >= 384 ? 0.10206207261596577f : 1.0f;
#pragma unroll
        for (int r = 0; r < 16; ++r) { float acc[8];
#pragma unroll
            for (int i = 0; i < 8; ++i) acc[i] = bv[i];
#pragma unroll
            for (int j = 0; j < 4; ++j) { const v4u w = raw[r + j]; const float x[8] = {bflo(w.x), bfhi(w.x), bflo(w.y), bfhi(w.y), bflo(w.z), bfhi(w.z), bflo(w.w), bfhi(w.w)};
#pragma unroll
                for (int i = 0; i < 8; ++i) acc[i] += wv[j][i] * x[i]; }
#pragma unroll
            for (int i = 0; i < 8; ++i) acc[i] = silu1(acc[i]) * sc;
            v4u o; o.x = pk2(acc[0], acc[1]); o.y = pk2(acc[2], acc[3]); o.z = pk2(acc[4], acc[5]); o.w = pk2(acc[6], acc[7]);
            *(GAS v4u*)(QKC + (size_t)(m0 + r) * 768 + c0) = o; }
    }
}
__device__ __forceinline__ bool r1_better(float va, int ea, float vb, int eb) { return va > vb || (va == vb && ea < eb); }
__device__ __forceinline__ void moe_route1(Ctx& C, int j, int layer) {
    f32x4* SEL = WSP(f32x4, WS_ROUTE + RT_SEL); float* RSTD = WSP(float, WS_ROUTE + RT_RSTD); int* CNT = WSP(int, WS_ROUTE + RT_CNT);
    LAS int* lc = (LAS int*)(C.lds + RING_OFF); float RW[16][8]; const int lane = C.lane;
    load_w8(C.in[8] + layer * D, C.in[23] + (size_t)j * D * NE, NE, 0, lane, RW);
    for (int chunk = C.bid; chunk < M / 64; chunk += C.G) {
        __syncthreads();
        if (C.tid < 8) lc[C.tid] = 0;
        __syncthreads();
#pragma unroll 1
        for (int grp = 0; grp < 2; ++grp) {
            const int m0 = chunk * 64 + C.wave * 8 + grp * 4;
            float lval, rs; dots8_x4(C, m0, RW, lval, rs);
            const int tk = ((lane & 1) << 1) | ((lane >> 1) & 1), ex = (((lane >> 2) & 1) << 2) | (((lane >> 3) & 1) << 1) | ((lane >> 4) & 1);
            float v1 = lval, v2 = -3.0e38f; int e1 = ex, e2 = 8;
#pragma unroll
            for (int d = 4; d <= 16; d <<= 1) { const float pv1 = __shfl_xor(v1, d), pv2 = __shfl_xor(v2, d); const int pe1 = __shfl_xor(e1, d), pe2 = __shfl_xor(e2, d);
                float n1, n2; int f1, f2;
                if (r1_better(v1, e1, pv1, pe1)) { n1 = v1; f1 = e1; if (r1_better(v2, e2, pv1, pe1)) { n2 = v2; f2 = e2; } else { n2 = pv1; f2 = pe1; } }
                else { n1 = pv1; f1 = pe1; if (r1_better(v1, e1, pv2, pe2)) { n2 = v1; f2 = e1; } else { n2 = pv2; f2 = pe2; } }
                v1 = n1; e1 = f1; v2 = n2; e2 = f2; }
            if (lane < 4) { const int mm = m0 + tk; const float w1 = 1.0f / (1.0f + __expf(v2 - v1)), w2 = 1.0f - w1;
                f32x4 s; s.x = __int_as_float(e1); s.y = __int_as_float(e2); s.z = w1; s.w = w2; SEL[mm] = s; RSTD[mm] = rs; atomicAdd((int*)&lc[e1], 1); atomicAdd((int*)&lc[e2], 1); }
        }
        __syncthreads();
        if (C.tid < 8) CNT[chunk * 8 + C.tid] = lc[C.tid];
    }
}
__device__ __forceinline__ void moe_route2(Ctx& C) {
    const f32x4* SEL = WSP(f32x4, WS_ROUTE + RT_SEL); const float* RSTD = WSP(float, WS_ROUTE + RT_RSTD); const int* CNT = WSP(int, WS_ROUTE + RT_CNT);
    int* PANEL = WSP(int, WS_ROUTE + RT_PANEL); int* NP = WSP(int, WS_ROUTE + RT_NP); int* TOKSLOT = WSP(int, WS_ROUTE + RT_TOKSLOT); float* SLOTRS = WSP(float, WS_ROUTE + RT_SLOTRS); int* ROWTOK = WSP(int, WS_ROUTE + RT_ROWTOK);
    if (C.wave != 0) return;
    for (int chunk = C.bid; chunk < M / 64; chunk += C.G) {
        const int e = C.lane & 7, sub = C.lane >> 3; int tot = 0, pre = 0;
        const int mtok = chunk * 64 + C.lane; const f32x4 stok = SEL[mtok]; const float rstok = RSTD[mtok];
        int cv[32];
#pragma unroll
        for (int q = 0; q < 32; ++q) cv[q] = CNT[(sub + 8 * q) * 8 + e];
#pragma unroll
        for (int q = 0; q < 32; ++q) { tot += cv[q]; pre += (sub + 8 * q < chunk) ? cv[q] : 0; }
        tot += __shfl_xor(tot, 8); tot += __shfl_xor(tot, 16); tot += __shfl_xor(tot, 32);
        pre += __shfl_xor(pre, 8); pre += __shfl_xor(pre, 16); pre += __shfl_xor(pre, 32);
        const int np = (tot + 255) >> 8; int pstart = 0;
#pragma unroll
        for (int k = 0; k < 8; ++k) { const int v = __shfl(np, k); pstart += (k < e) ? v : 0; }
        const int mybase = pstart * 256 + pre;
        if (chunk == 0) { int* TAILIDX = WSP(int, WS_ROUTE + RT_TAILIDX); for (int q = C.lane; q < 576; q += 64) TAILIDX[q] = -1;
            if (C.lane < 8) { for (int p = 0; p < np; ++p) PANEL[pstart + p] = e; if (e == 7) NP[0] = pstart + np; }
            for (int sl = pstart * 256 + tot + sub; sl < (pstart + np) * 256; sl += 8) { ROWTOK[sl] = 0; SLOTRS[sl] = 0.f; } }
        const int m = mtok; const f32x4 s = stok; const int e1 = __float_as_int(s.x), e2 = __float_as_int(s.y);
        const unsigned long long lt = (1ull << C.lane) - 1ull; int s1 = 0, s2 = 0;
#pragma unroll
        for (int ee = 0; ee < 8; ++ee) { const unsigned long long both = __ballot(e1 == ee) | __ballot(e2 == ee); const int r = __popcll(both & lt); const int be = __shfl(mybase, ee);
            if (e1 == ee) s1 = be + r; if (e2 == ee) s2 = be + r; }
        TOKSLOT[2 * m] = s1; TOKSLOT[2 * m + 1] = s2; const float rs = rstok; SLOTRS[s1] = rs; SLOTRS[s2] = rs; ROWTOK[s1] = m; ROWTOK[s2] = m;
    }
}
struct CombRow { unsigned long long hw[4]; v2u y1[4], y2[4]; };
__device__ __forceinline__ f32x4 slab_sum(const float* SLAB, int tl, int slot, int lane) {
    const float* sp = SLAB + (size_t)tl * 7 * 65536 + (size_t)(slot & 255) * 256 + 4 * lane; f32x4 a = *(const GAS f32x4*)sp;
#pragma unroll
    for (int k = 1; k < 7; ++k) a = a + *(const GAS f32x4*)(sp + (size_t)k * 65536);
    return a;
}
template <bool FINAL>
__device__ __forceinline__ void moe_combine(Ctx& C) {
    const f32x4* SEL = WSP(f32x4, WS_ROUTE + RT_SEL); const int* TOKSLOT = WSP(int, WS_ROUTE + RT_TOKSLOT); const bf16* Y = WSP(bf16, WS_Y);
    const float* SLAB = WSP(float, WS_SLAB); const int* TAILIDX = WSP(int, WS_ROUTE + RT_TAILIDX); const int lane = C.lane;
    typedef int i32x4 __attribute__((ext_vector_type(4)));
    for (int base = C.gw; base < M; base += 8 * C.NGW) {
        const int mrow = base + (lane & 7) * C.NGW; const bool okl = mrow < M; const int mr = okl ? mrow : base;
        const f32x4 sel = SEL[mr]; const int s1l = TOKSLOT[2 * mr], s2l = TOKSLOT[2 * mr + 1];
        const i32x4 t1l = *(const GAS i32x4*)(TAILIDX + (s1l >> 8) * 4), t2l = *(const GAS i32x4*)(TAILIDX + (s2l >> 8) * 4);
#pragma unroll
        for (int k0 = 0; k0 < 8; k0 += 2) {
            CombRow R[2]; int mm[2], s1[2], s2[2], tl1[2][4], tl2[2][4]; float w1[2], w2[2]; bool ok[2];
#pragma unroll
            for (int u = 0; u < 2; ++u) { const int k = k0 + u; mm[u] = base + k * C.NGW; ok[u] = mm[u] < M;
                s1[u] = __shfl(s1l, k); s2[u] = __shfl(s2l, k); w1[u] = __shfl(sel.z, k); w2[u] = __shfl(sel.w, k);
#pragma unroll
                for (int jj = 0; jj < 4; ++jj) { tl1[u][jj] = __shfl(t1l[jj], k); tl2[u][jj] = __shfl(t2l[jj], k); }
                if (ok[u]) { const GAS unsigned long long* o8 = (const GAS unsigned long long*)(WSP(bf16, WS_HB) + (size_t)mm[u] * D) + lane;
#pragma unroll
                    for (int jj = 0; jj < 4; ++jj) { R[u].hw[jj] = o8[64 * jj];
                        R[u].y1[jj] = tl1[u][jj] < 0 ? *(const GAS v2u*)(Y + (size_t)s1[u] * D + 256 * jj + 4 * lane) : (v2u){0u, 0u};
                        R[u].y2[jj] = tl2[u][jj] < 0 ? *(const GAS v2u*)(Y + (size_t)s2[u] * D + 256 * jj + 4 * lane) : (v2u){0u, 0u}; } } }
#pragma unroll
            for (int u = 0; u < 2; ++u) if (ok[u]) {
                GAS unsigned long long* o8 = (GAS unsigned long long*)(WSP(bf16, WS_HB) + (size_t)mm[u] * D) + lane; float ss = 0.f;
#pragma unroll
                for (int jj = 0; jj < 4; ++jj) { const unsigned lo = (unsigned)R[u].hw[jj], hi = (unsigned)(R[u].hw[jj] >> 32);
                    f32x4 v = (f32x4){bflo(lo), bfhi(lo), bflo(hi), bfhi(hi)};
                    f32x4 a = (f32x4){bflo(R[u].y1[jj].x), bfhi(R[u].y1[jj].x), bflo(R[u].y1[jj].y), bfhi(R[u].y1[jj].y)}; if (tl1[u][jj] >= 0) a = slab_sum(SLAB, tl1[u][jj], s1[u], lane);
                    f32x4 b2 = (f32x4){bflo(R[u].y2[jj].x), bfhi(R[u].y2[jj].x), bflo(R[u].y2[jj].y), bfhi(R[u].y2[jj].y)}; if (tl2[u][jj] >= 0) b2 = slab_sum(SLAB, tl2[u][jj], s2[u], lane);
                    v = v + (a * w1[u] + b2 * w2[u]);
                    if (FINAL) { ((GAS f32x4*)(C.out + (size_t)mm[u] * D) + lane)[64 * jj] = v; }
                    else { ss += (v.x * v.x + v.y * v.y) + (v.z * v.z + v.w * v.w); o8[64 * jj] = (unsigned long long)pk2(v.x, v.y) | ((unsigned long long)pk2(v.z, v.w) << 32); } }
                if (!FINAL) { ss = wave_sum(ss); if (lane < 4) WSP(float, WS_SS)[(size_t)mm[u] * 4 + lane] = lane == 0 ? ss : 0.f; } }
        }
    }
}

template <class Sched> __device__ __forceinline__ const LAS float* rstd_table(Ctx& C, const Sched& S, const float* SS) {
    LAS float* tab = (LAS float*)(C.lds + 131072 + 4096);
    pg8::Unit u0, u; bool one = S.next(0, u0);
    for (int i = 1; one && S.next(i, u); ++i) one = (u.pm == u0.pm);
    __syncthreads();
    if (one && C.tid < 256) tab[C.tid] = pg8::row_rstd16(SS, u0.pm * 256 + C.tid);
    __syncthreads();
    return one ? tab : nullptr;
}
typedef short v4i16_t __attribute__((ext_vector_type(4)));
typedef const LAS unsigned char* ldsc;
__device__ __forceinline__ bf16x8 frag_rows(ldsc base, int ld, int row0, int kbyte0, int i, int g) { return *(const LAS bf16x8*)(base + (row0 + i) * ld + kbyte0 + 16 * g); }
__device__ __forceinline__ bf16x8 frag_tr(ldsc base, int ld, int k0, int nbyte0, int i, int g, bool perm) {
    const int q = i >> 2, p = i & 3;
    ldsc p1 = base + (k0 + (perm ? 4 * g : 8 * g) + q) * ld + nbyte0 + 8 * p; ldsc p2 = p1 + (perm ? 16 : 4) * ld;
    const v4i16_t a = __builtin_amdgcn_ds_read_tr16_b64_v4i16((LAS v4i16_t*)p1), b = __builtin_amdgcn_ds_read_tr16_b64_v4i16((LAS v4i16_t*)p2);
    return (bf16x8){a[0], a[1], a[2], a[3], b[0], b[1], b[2], b[3]};
}
__device__ __forceinline__ unsigned cvtpk(float lo, float hi) { unsigned r; asm volatile("v_cvt_pk_bf16_f32 %0, %1, %2" : "=v"(r) : "v"(lo), "v"(hi)); return r; }
__device__ __forceinline__ bf16x8 pack_acc2(const f32x4& t0, const f32x4& t1) {
    v4u w; w.x = cvtpk(t0[0], t0[1]); w.y = cvtpk(t0[2], t0[3]); w.z = cvtpk(t1[0], t1[1]); w.w = cvtpk(t1[2], t1[3]); return __builtin_bit_cast(bf16x8, w);
}
#define MFMA16(a, b, c) __builtin_amdgcn_mfma_f32_16x16x32_bf16(a, b, c, 0, 0, 0)
__device__ __forceinline__ void st8_lds(LAS unsigned char* p, const float (&f)[8]) { v4u w; w.x = cvtpk(f[0], f[1]); w.y = cvtpk(f[2], f[3]); w.z = cvtpk(f[4], f[5]); w.w = cvtpk(f[6], f[7]); *(LAS v4u*)p = w; }

constexpr int AT_LD = 144, AT_K = 0, AT_V = 256 * AT_LD, AT_Q = 2 * 256 * AT_LD;
struct AttnKV { v4u k[4], v[4]; };
template <int QIT> struct AttnQ { v4u q[QIT][4]; };
__device__ __forceinline__ void attn_ld_kv(AttnKV& R, const bf16* Kb, long krow0, int ldk, int kcol, int vcol, bool ok, int t) {
    const int row = t >> 1, half = t & 1;
#pragma unroll
    for (int c = 0; c < 4; ++c) { if (ok) { R.k[c] = *(const GAS v4u*)(Kb + (size_t)(krow0 + row) * ldk + kcol + half * 32 + c * 8); R.v[c] = *(const GAS v4u*)(Kb + (size_t)(krow0 + row) * ldk + vcol + half * 32 + c * 8); }
        else { R.k[c] = (v4u){0u, 0u, 0u, 0u}; R.v[c] = (v4u){0u, 0u, 0u, 0u}; } }
}
template <int NQH, bool SWA>
__device__ __forceinline__ void attn_ld_q(AttnQ<(NQH * 256 + 511) / 512>& R, const bf16* P, int ldp, long tok0, int qcol, int hh, int t) {
    constexpr int QIT = (NQH * 256 + 511) / 512;
#pragma unroll
    for (int it = 0; it < QIT; ++it) { const int hr = t + 512 * it; if (hr < NQH * 256) { const int qrow = hr >> 1, qhalf = hr & 1, qh = qrow >> 7, r = qrow & 127; const int hq = SWA ? hh * 3 + qh : hh;
#pragma unroll
        for (int c = 0; c < 4; ++c) R.q[it][c] = *(const GAS v4u*)(P + (size_t)(tok0 + r) * ldp + qcol + hq * 64 + qhalf * 32 + c * 8); } }
}
__device__ __forceinline__ void attn_st_kv(const AttnKV& R, LAS unsigned char* L, const float (&kg)[32], int t) {
    const int row = t >> 1, half = t & 1; float ss = 0.f; float kf[4][8];
#pragma unroll
    for (int c = 0; c < 4; ++c) { const v4u w4 = R.k[c]; kf[c][0] = bflo(w4.x); kf[c][1] = bfhi(w4.x); kf[c][2] = bflo(w4.y); kf[c][3] = bfhi(w4.y); kf[c][4] = bflo(w4.z); kf[c][5] = bfhi(w4.z); kf[c][6] = bflo(w4.w); kf[c][7] = bfhi(w4.w);
#pragma unroll
        for (int j = 0; j < 8; ++j) ss += kf[c][j] * kf[c][j]; }
    ss += __shfl_xor(ss, 1);
    const float rs = 1.0f / sqrtf(ss * (1.0f / 64.0f) + 1e-6f);
#pragma unroll
    for (int c = 0; c < 4; ++c) {
#pragma unroll
        for (int j = 0; j < 8; ++j) kf[c][j] = kf[c][j] * rs * kg[c * 8 + j];
        st8_lds(L + AT_K + row * AT_LD + half * 64 + c * 16, kf[c]); *(LAS v4u*)(L + AT_V + row * AT_LD + half * 64 + c * 16) = R.v[c]; }
}
template <int NQH>
__device__ __forceinline__ void attn_st_q(const AttnQ<(NQH * 256 + 511) / 512>& R, LAS unsigned char* L, const float (&qg)[32], int t) {
    constexpr int QIT = (NQH * 256 + 511) / 512;
#pragma unroll
    for (int it = 0; it < QIT; ++it) { const int hr = t + 512 * it; if (hr < NQH * 256) { const int qrow = hr >> 1, qhalf = hr & 1;
        float ss = 0.f; float qf[4][8];
#pragma unroll
        for (int c = 0; c < 4; ++c) { const v4u w4 = R.q[it][c]; qf[c][0] = bflo(w4.x); qf[c][1] = bfhi(w4.x); qf[c][2] = bflo(w4.y); qf[c][3] = bfhi(w4.y); qf[c][4] = bflo(w4.z); qf[c][5] = bfhi(w4.z); qf[c][6] = bflo(w4.w); qf[c][7] = bfhi(w4.w);
#pragma unroll
            for (int j = 0; j < 8; ++j) ss += qf[c][j] * qf[c][j]; }
        ss += __shfl_xor(ss, 1);
        const float rs = 0.18033688011112042f / sqrtf(ss * (1.0f / 64.0f) + 1e-6f);
#pragma unroll
        for (int c = 0; c < 4; ++c) {
#pragma unroll
            for (int j = 0; j < 8; ++j) qf[c][j] = qf[c][j] * rs * qg[c * 8 + j];
            st8_lds(L + AT_Q + qrow * AT_LD + qhalf * 64 + c * 16, qf[c]); } } }
}
template <bool SWA>
__device__ __forceinline__ void attn_compute(Ctx& C, int hh, long tok0, bool prev_valid, const float* sink, bf16* MIX) {
    LAS unsigned char* L = C.lds + RING_OFF;
    const int lane = C.lane, w = C.wave, i = lane & 15, g = lane >> 4;
    constexpr int NQH = SWA ? 3 : 1, NT = SWA ? 10 : 16;
    const int t0 = SWA ? w : 0;
#pragma unroll 1
    for (int qh = 0; qh < NQH; ++qh) {
        const int hq = SWA ? hh * 3 + qh : hh;
        const bf16x8 q0 = frag_rows(L + AT_Q, AT_LD, qh * 128 + 16 * w, 0, i, g), q1 = frag_rows(L + AT_Q, AT_LD, qh * 128 + 16 * w, 64, i, g);
        const float slope = SWA ? exp2f(-8.0f * (float)(hq + 1) / 12.0f) * 1.4426950408889634f : 0.f;
        const float sg = slope * (float)(4 * g);
        f32x4 s[NT];
#pragma unroll
        for (int tt = 0; tt < NT; ++tt) { const int kt = (t0 + tt) > 15 ? 15 : (t0 + tt);
            s[tt] = (f32x4){0.f, 0.f, 0.f, 0.f};
            if (SWA && tt == NT - 1) continue;
            s[tt] = MFMA16(frag_rows(L + AT_K, AT_LD, 16 * kt, 0, i, g), q0, ((f32x4){sg, sg, sg, sg}));
            s[tt] = MFMA16(frag_rows(L + AT_K, AT_LD, 16 * kt, 64, i, g), q1, s[tt]); }
        const int dq = i - 4 * g;
        const float sk = SWA ? fmaf(slope, (float)(128 + i), sink[hq] * 1.4426950408889634f) : 0.f;
        float mx = SWA ? sk : -1e30f;
        constexpr int NTV = SWA ? NT - 1 : NT;
        if (SWA) {
#pragma unroll
            for (int tt = 0; tt < NTV; ++tt)
#pragma unroll
                for (int r = 0; r < 4; ++r) { const float b = fmaf(slope, (float)(16 * tt + r), s[tt][r]);
                    s[tt][r] = (tt == 0) ? (r > dq ? b : -1e30f) : (tt == NTV - 1) ? (r <= dq ? b : -1e30f) : b; }
            if (!prev_valid) {
#pragma unroll
                for (int tt = 0; tt < NTV; ++tt)
#pragma unroll
                    for (int r = 0; r < 4; ++r) { if (16 * (t0 + tt) + 4 * g + r < 128) s[tt][r] = -1e30f; } }
        }
#pragma unroll
        for (int tt = 0; tt < NTV; ++tt) mx = fmaxf(mx, fmaxf(fmaxf(s[tt][0], s[tt][1]), fmaxf(s[tt][2], s[tt][3])));
        mx = fmaxf(mx, __shfl_xor(mx, 16)); mx = fmaxf(mx, __shfl_xor(mx, 32));
        typedef float f32x2_t __attribute__((ext_vector_type(2)));
        f32x2_t l2 = (f32x2_t){0.f, 0.f};
#pragma unroll
        for (int tt = 0; tt < NTV; ++tt) {
#pragma unroll
            for (int r = 0; r < 4; ++r) s[tt][r] = __builtin_amdgcn_exp2f(s[tt][r] - mx);
            l2 += (f32x2_t){s[tt][0], s[tt][1]}; l2 += (f32x2_t){s[tt][2], s[tt][3]}; }
        float l = l2.x + l2.y;
        l += __shfl_xor(l, 16); l += __shfl_xor(l, 32);
        if (SWA) l += __builtin_amdgcn_exp2f(sk - mx);
        const float inv = 1.0f / l;
        f32x4 o[4];
#pragma unroll
        for (int dv = 0; dv < 4; ++dv) o[dv] = (f32x4){0.f, 0.f, 0.f, 0.f};
#pragma unroll
        for (int pr = 0; pr < NT / 2; ++pr) {
            const bf16x8 pb = pack_acc2(s[2 * pr], s[2 * pr + 1]);
            const int k0 = 16 * (t0 + 2 * pr);
#pragma unroll
            for (int dv = 0; dv < 4; ++dv) o[dv] = MFMA16(frag_tr(L + AT_V, AT_LD, k0, 32 * dv, i, g, true), pb, o[dv]);
        }
        bf16* op = MIX + (size_t)(tok0 + 16 * w + i) * D + (SWA ? hq * 64 : 768 + hq * 64) + 4 * g;
#pragma unroll
        for (int dv = 0; dv < 4; ++dv) { v2u wv; wv.x = cvtpk(o[dv][0] * inv, o[dv][1] * inv); wv.y = cvtpk(o[dv][2] * inv, o[dv][3] * inv); *(GAS v2u*)(op + 16 * dv) = wv; }
    }
}

__device__ __forceinline__ void attn_swa_unit(Ctx& C, int unit, const bf16* P, int ldp, const float* qgain, const float* kgain, const float* sink, int kcol0, int vcol0, bf16* MIX) {
    LAS unsigned char* L = C.lds + RING_OFF; const int t = C.tid;
    const int hh = unit & 3, blk = (unit >> 2) & 63, b = unit >> 8; const long krow0 = (long)b * SEQ + (long)blk * 128 - 128, tok0 = (long)b * SEQ + (long)blk * 128; const bool prev_valid = blk > 0;
    AttnKV rkv; AttnQ<2> rq; float kg[32], qg[32];
#pragma unroll
    for (int q = 0; q < 32; ++q) { kg[q] = kgain[(t & 1) * 32 + q]; qg[q] = qgain[(t & 1) * 32 + q]; }
    attn_ld_kv(rkv, P, krow0, ldp, kcol0 + hh * 64, vcol0 + hh * 64, prev_valid || (t >> 1) >= 128, t);
    attn_ld_q<3, true>(rq, P, ldp, tok0, 0, hh, t);
    __syncthreads();
    attn_st_kv(rkv, L, kg, t); attn_st_q<3>(rq, L, qg, t);
    __syncthreads();
    attn_compute<true>(C, hh, tok0, prev_valid, sink, MIX);
}
__device__ __forceinline__ void attn_mem_pair(Ctx& C, int pair, const bf16* P, int ldp, const float* qgain, const float* kgain, int layer, bf16* MIX) {
    LAS unsigned char* L = C.lds + RING_OFF; const int t = C.tid;
    const int hh = pair & 3, bp = (pair >> 2) & 31, b = pair >> 7; const long tok0 = (long)b * SEQ + (long)bp * 256; const int qcol = ldp - 256;
    AttnKV rkv; AttnQ<1> rq; float kg[32], qg[32];
#pragma unroll
    for (int q = 0; q < 32; ++q) { kg[q] = kgain[(t & 1) * 32 + q]; qg[q] = qgain[(t & 1) * 32 + q]; }
    attn_ld_kv(rkv, WSP(bf16, WS_MKV), (long)b * MEMT, 2048, layer * 512 + hh * 64, layer * 512 + 256 + hh * 64, true, t);
    attn_ld_q<1, false>(rq, P, ldp, tok0, qcol, hh, t);
    __syncthreads();
    attn_st_kv(rkv, L, kg, t); attn_st_q<1>(rq, L, qg, t);
    __syncthreads();
    attn_ld_q<1, false>(rq, P, ldp, tok0 + 128, qcol, hh, t);
    attn_compute<false>(C, hh, tok0, true, nullptr, MIX);
    __syncthreads();
    attn_st_q<1>(rq, L, qg, t);
    __syncthreads();
    attn_compute<false>(C, hh, tok0 + 128, true, nullptr, MIX);
}

template <int MODE> struct CMT;
template <> struct CMT<0> { static constexpr int DK = 64, DV = 128, NH = 6, LDP = N_RET; };
template <> struct CMT<1> { static constexpr int DK = 96, DV = 192, NH = 4, LDP = N_MLS; };
template <int MODE> struct CML {
    static constexpr int DK = CMT<MODE>::DK, DV = CMT<MODE>::DV, LDQK = DK * 2 + 16, LDV = DV * 2 + 16;
    static constexpr int Q = 0, K = 128 * LDQK, V = 2 * 128 * LDQK, S = V + 128 * LDV, AUX = S + DK * LDV;
    static_assert(AUX + 832 * 4 <= RING_BYTES, "chunk mixer LDS");
};
constexpr size_t RT_NLOC = 1536 * KiB, RT_NIN = 1792 * KiB, RT_CHG = 2048 * KiB, RT_CHA = 2052 * KiB, RT_MIN = 2056 * KiB;
constexpr size_t SCR2_STATE = 24 * MiB;

template <int NROWS, int NCOLS> struct StageRegs { static constexpr int CPR = NCOLS / 8, TOTAL = NROWS * CPR, ITER = (TOTAL + 511) / 512; v4u r[ITER]; };
template <int NROWS, int NCOLS>
__device__ __forceinline__ void stage_ld(StageRegs<NROWS, NCOLS>& R, const bf16* src, size_t lds_src, int t) {
    typedef StageRegs<NROWS, NCOLS> SR;
#pragma unroll
    for (int it = 0; it < SR::ITER; ++it) { const int e = t + 512 * it; if (e < SR::TOTAL) { const int row = e / SR::CPR, c = e % SR::CPR; R.r[it] = *(const GAS v4u*)(src + (size_t)row * lds_src + c * 8); } }
}
template <int NROWS, int NCOLS, bool SCALE>
__device__ __forceinline__ void stage_st(const StageRegs<NROWS, NCOLS>& R, LAS unsigned char* dst, int ldd, const LAS float* rsc, float cs, int t) {
    typedef StageRegs<NROWS, NCOLS> SR;
#pragma unroll
    for (int it = 0; it < SR::ITER; ++it) { const int e = t + 512 * it; if (e < SR::TOTAL) { const int row = e / SR::CPR, c = e % SR::CPR;
        if (!SCALE) { *(LAS v4u*)(dst + row * ldd + c * 16) = R.r[it]; }
        else { const v4u w = R.r[it]; float f[8] = {bflo(w.x), bfhi(w.x), bflo(w.y), bfhi(w.y), bflo(w.z), bfhi(w.z), bflo(w.w), bfhi(w.w)}; const float sc = cs * (rsc ? rsc[row] : 1.0f);
#pragma unroll
            for (int j = 0; j < 8; ++j) f[j] *= sc;
            st8_lds(dst + row * ldd + c * 16, f); } } }
}
__device__ __forceinline__ void mls_chunk_scans(Ctx& C, float* aux, size_t row0, int h, float& btot, float& cmax) {
    const float* GT = WSP(float, WS_ROUTE + RT_GATES); const float ib = C.in[17][h], fb = C.in[18][h]; const int l = C.lane;
    float li0 = GT[(row0 + 2 * l) * 8 + h] + ib, li1 = GT[(row0 + 2 * l + 1) * 8 + h] + ib;
    float x0 = GT[(row0 + 2 * l) * 8 + 4 + h] + fb, x1 = GT[(row0 + 2 * l + 1) * 8 + 4 + h] + fb;
    x0 = fminf(x0, 0.f) - log1pf(__expf(-fabsf(x0))); x1 = fminf(x1, 0.f) - log1pf(__expf(-fabsf(x1)));
    const float s = x0 + x1; float inc = s;
#pragma unroll
    for (int d = 1; d < 64; d <<= 1) { const float v = __shfl_up(inc, d); if (l >= d) inc += v; }
    const float b0 = inc - s + x0, b1 = inc; const float c0 = li0 - b0, c1 = li1 - b1;
    float pm = fmaxf(c0, c1);
#pragma unroll
    for (int d = 1; d < 64; d <<= 1) { const float v = __shfl_up(pm, d); if (l >= d) pm = fmaxf(pm, v); }
    const float pmprev = __shfl_up(pm, 1); const float m0 = (l == 0) ? c0 : fmaxf(pmprev, c0);
    aux[2 * l] = b0; aux[2 * l + 1] = b1; aux[128 + 2 * l] = c0; aux[128 + 2 * l + 1] = c1; aux[256 + 2 * l] = m0; aux[256 + 2 * l + 1] = pm;
    const float cm = __shfl(pm, 63); aux[384 + 2 * l] = __expf(c0 - cm); aux[384 + 2 * l + 1] = __expf(c1 - cm);
    btot = __shfl(b1, 63); cmax = cm;
}
__device__ __forceinline__ void mls_aux(Ctx& C) {
    float* AUXG = WSP(float, WS_ROUTE + RT_AUXG);
    for (int unit = C.gw; unit < 512; unit += C.NGW) { const int bh = unit >> 6, c = unit & 63, b = bh >> 2, h = bh & 3; const size_t row0 = (size_t)b * SEQ + (size_t)c * 128;
        float* aux = AUXG + (size_t)unit * 512; float b127, cm; mls_chunk_scans(C, aux, row0, h, b127, cm);
        if (C.lane == 63) { WSP(float, WS_ROUTE + RT_CHG)[unit] = b127; WSP(float, WS_ROUTE + RT_CHA)[unit] = b127 + cm; } }
}
template <int MODE>
__device__ __forceinline__ void chunk_state_unit(Ctx& C, int unit, const bf16* P, const bf16* QKC, float* U) {
    typedef CML<MODE> Lm; constexpr int DK = Lm::DK, DV = Lm::DV, NH = CMT<MODE>::NH, LDP = CMT<MODE>::LDP, ND = DK / 16, NV = DV / 16, TPW = ND * NV / 8;
    LAS unsigned char* L = C.lds + RING_OFF; LAS float* aux = (LAS float*)(L + Lm::AUX);
    const int bh = unit >> 6, c = unit & 63, b = bh / NH, h = bh % NH, t = C.tid, i = C.lane & 15, g = C.lane >> 4, w = C.wave;
    const size_t row0 = (size_t)b * SEQ + (size_t)c * 128;
    StageRegs<128, DK> rK; StageRegs<128, DV> rV;
    stage_ld<128, DK>(rK, MODE == 0 ? P + row0 * LDP + 384 + h * 64 : QKC + row0 * 768 + 384 + h * 96, MODE == 0 ? LDP : 768, t);
    stage_ld<128, DV>(rV, P + row0 * LDP + 768 + h * DV, LDP, t);
    float wsc = 0.f; if (MODE == 1 && t < 128) wsc = WSP(float, WS_ROUTE + RT_AUXG)[(size_t)unit * 512 + 384 + t];
    __syncthreads();
    if (MODE == 0) { if (t < 128) { const float l2g = log2f(1.0f - exp2f(-5.0f - (float)h)); aux[384 + t] = 0.125f * exp2f((float)(127 - t) * l2g); } }
    else { if (t < 128) aux[384 + t] = wsc; }
    __syncthreads();
    stage_st<128, DK, true>(rK, L + Lm::K, Lm::LDQK, aux + 384, 1.0f, t);
    stage_st<128, DV, false>(rV, L + Lm::V, Lm::LDV, nullptr, 1.0f, t);
    __syncthreads();
#pragma unroll 1
    for (int n = 0; n < TPW; ++n) { const int id = w * TPW + n, dt = id / NV, vt = id % NV;
        f32x4 acc = (f32x4){0.f, 0.f, 0.f, 0.f};
#pragma unroll
        for (int ks = 0; ks < 4; ++ks) acc = MFMA16(frag_tr(L + Lm::K, Lm::LDQK, 32 * ks, 32 * dt, i, g, false), frag_tr(L + Lm::V, Lm::LDV, 32 * ks, 32 * vt, i, g, false), acc);
        float* up = U + (size_t)unit * DK * DV + (size_t)(16 * dt + 4 * g) * DV + 16 * vt + i;
#pragma unroll
        for (int r = 0; r < 4; ++r) up[r * DV] = acc[r]; }
    if (MODE == 1 && t < 4 * DK) { const int dcol = t >> 2, part = t & 3; float s0 = 0.f, s1 = 0.f;
#pragma unroll 8
        for (int j = 0; j < 32; j += 2) { s0 += bflo((unsigned)*(const LAS unsigned short*)(L + Lm::K + (part * 32 + j) * Lm::LDQK + 2 * dcol)); s1 += bflo((unsigned)*(const LAS unsigned short*)(L + Lm::K + (part * 32 + j + 1) * Lm::LDQK + 2 * dcol)); }
        float s = s0 + s1; s += __shfl_xor(s, 1); s += __shfl_xor(s, 2);
        if (part == 0) WSP(float, WS_ROUTE + RT_NLOC)[(size_t)unit * 96 + dcol] = s; }
}
__device__ __forceinline__ void ret_scan(Ctx& C, const float* U, bf16* SIN) {
    const int gt = C.bid * 512 + C.tid, nthr = C.G * 512;
    for (int e = gt; e < 12 * 8192; e += nthr) { const int bh = e >> 13, idx = e & 8191, h = bh % 6;
        const float gL = exp2f(128.0f * log2f(1.0f - exp2f(-5.0f - (float)h))); float S = 0.f;
        const float* up = U + (size_t)bh * 64 * 8192 + idx; bf16* sp = SIN + (size_t)bh * 64 * 8192 + idx;
        float u[64];
#pragma unroll
        for (int c = 0; c < 64; ++c) u[c] = up[(size_t)c * 8192];
#pragma unroll
        for (int c = 0; c < 64; ++c) { sp[(size_t)c * 8192] = (bf16)f2bf(S); S = gL * S + u[c]; } }
}
__device__ __forceinline__ void mls_scan(Ctx& C, const float* U, bf16* CIN) {
    constexpr int NC = 96 * 192, SEG = NC / 1024;
    typedef float f32x2 __attribute__((ext_vector_type(2)));
    const float* CHG = WSP(float, WS_ROUTE + RT_CHG); const float* CHA = WSP(float, WS_ROUTE + RT_CHA); float* MIN_ = WSP(float, WS_ROUTE + RT_MIN);
    const float* NLOC = WSP(float, WS_ROUTE + RT_NLOC); float* NIN = WSP(float, WS_ROUTE + RT_NIN);
    LAS float* sc = (LAS float*)(C.lds + RING_OFF);
    for (int task = C.bid; task < 8 * (SEG + 1); task += C.G) { const int bh = task / (SEG + 1), seg = task % (SEG + 1);
        __syncthreads();
        if (C.wave == 0) { const float gg = CHG[bh * 64 + C.lane], aa = CHA[bh * 64 + C.lane]; float m = 0.f, dmine = 0.f, wmine = 0.f, mmine = 0.f;
            for (int c = 0; c < 64; ++c) { const float g1 = __shfl(gg, c), a1 = __shfl(aa, c); const float mn = fmaxf(g1 + m, a1); const float dd = __expf(g1 + m - mn), ww = __expf(a1 - mn);
                if (C.lane == c) { dmine = dd; wmine = ww; mmine = m; } m = mn; }
            sc[C.lane] = dmine; sc[64 + C.lane] = wmine; if (seg == SEG) MIN_[bh * 64 + C.lane] = mmine; }
        __syncthreads();
        if (seg < SEG) { const int idx = seg * 1024 + 2 * C.tid; const float* src = U + (size_t)bh * 64 * NC + idx; bf16* dst = CIN + (size_t)bh * 64 * NC + idx;
            f32x2 u[64];
#pragma unroll
            for (int c = 0; c < 64; ++c) u[c] = *(const GAS f32x2*)(src + (size_t)c * NC);
            float v0 = 0.f, v1 = 0.f;
#pragma unroll
            for (int c = 0; c < 64; ++c) { *(GAS unsigned*)(dst + (size_t)c * NC) = pk2(v0, v1); const float dd = sc[c], ww = sc[64 + c]; v0 = dd * v0 + ww * u[c].x; v1 = dd * v1 + ww * u[c].y; } }
        else if (C.tid < 96) { const float* src = NLOC + (size_t)bh * 64 * 96 + C.tid; float u[64];
#pragma unroll
            for (int c = 0; c < 64; ++c) u[c] = src[(size_t)c * 96];
            float val = 0.f;
#pragma unroll
            for (int c = 0; c < 64; ++c) { NIN[(size_t)(bh * 64 + c) * 96 + C.tid] = val; val = sc[c] * val + sc[64 + c] * u[c]; } }
    }
}
template <int MODE>
__device__ __forceinline__ void chunk_out_unit(Ctx& C, int unit, const bf16* P, const bf16* QKC, const bf16* SIN, bf16* MIX) {
    typedef CML<MODE> Lm; constexpr int DK = Lm::DK, DV = Lm::DV, NH = CMT<MODE>::NH, LDP = CMT<MODE>::LDP, NV = DV / 16, NKS = DK / 32;
    LAS unsigned char* L = C.lds + RING_OFF; LAS float* aux = (LAS float*)(L + Lm::AUX);
    const int bh = unit >> 6, c = unit & 63, b = bh / NH, h = bh % NH, t = C.tid, i = C.lane & 15, g = C.lane >> 4, w = C.wave;
    const size_t row0 = (size_t)b * SEQ + (size_t)c * 128;
    StageRegs<128, DK> rQ, rK; StageRegs<128, DV> rV; StageRegs<DK, DV> rS;
    stage_ld<128, DK>(rQ, MODE == 0 ? P + row0 * LDP + h * 64 : QKC + row0 * 768 + h * 96, MODE == 0 ? LDP : 768, t);
    stage_ld<128, DK>(rK, MODE == 0 ? P + row0 * LDP + 384 + h * 64 : QKC + row0 * 768 + 384 + h * 96, MODE == 0 ? LDP : 768, t);
    stage_ld<128, DV>(rV, P + row0 * LDP + 768 + h * DV, LDP, t);
    stage_ld<DK, DV>(rS, SIN + (size_t)unit * DK * DV, DV, t);
    float auxv = 0.f; if (MODE == 1) { if (t < 384) auxv = WSP(float, WS_ROUTE + RT_AUXG)[(size_t)unit * 512 + t]; else if (t < 384 + 96) auxv = WSP(float, WS_ROUTE + RT_NIN)[(size_t)unit * 96 + t - 384]; }
    f32x4 gnv = (f32x4){0.f, 0.f, 0.f, 0.f}; if (MODE == 1 && t < 48) gnv = *(const GAS f32x4*)(C.in[19] + h * DV + 4 * t);
    __syncthreads();
    if (MODE == 1) { if (t < 384) aux[t] = auxv; else if (t < 384 + 96) aux[512 + t - 384] = auxv; if (t < 48) *(LAS f32x4*)(aux + 640 + 4 * t) = gnv; }
    stage_st<128, DK, false>(rQ, L + Lm::Q, Lm::LDQK, nullptr, 1.0f, t);
    if (MODE == 0) stage_st<128, DK, true>(rK, L + Lm::K, Lm::LDQK, nullptr, 0.125f, t); else stage_st<128, DK, false>(rK, L + Lm::K, Lm::LDQK, nullptr, 1.0f, t);
    stage_st<128, DV, false>(rV, L + Lm::V, Lm::LDV, nullptr, 1.0f, t);
    stage_st<DK, DV, false>(rS, L + Lm::S, Lm::LDV, nullptr, 1.0f, t);
    __syncthreads();
    const int qt = w < 4 ? w : 11 - w;
    const int iq = 16 * qt + i;
    v2u gwv[NV];
    { const bf16* gp0 = P + (row0 + iq) * LDP + 1536 + h * DV + 4 * g;
#pragma unroll
      for (int vt = 0; vt < NV; ++vt) gwv[vt] = *(const GAS v2u*)(gp0 + 16 * vt); }
    float m_in_early = 0.f; if (MODE == 1) m_in_early = WSP(float, WS_ROUTE + RT_MIN)[unit];
    bf16x8 qf[NKS];
#pragma unroll
    for (int s = 0; s < NKS; ++s) qf[s] = frag_rows(L + Lm::Q, Lm::LDQK, 16 * qt, 64 * s, i, g);
    f32x4 o[NV];
    constexpr int QB = NV / 4, NB1 = 4 * NKS;
    bf16x8 fb[2][QB];
#pragma unroll
    for (int vt = 0; vt < NV; ++vt) o[vt] = (f32x4){0.f, 0.f, 0.f, 0.f};
#define CO_LDS(b_) { _Pragma("unroll") for (int k = 0; k < QB; ++k) fb[(b_) & 1][k] = frag_tr(L + Lm::S, Lm::LDV, 32 * ((b_) >> 2), 32 * (((b_) & 3) * QB + k), i, g, false); asm volatile("" ::: "memory"); }
    CO_LDS(0)
#pragma unroll
    for (int b = 0; b < NB1; ++b) { if (b + 1 < NB1) CO_LDS(b + 1)
#pragma unroll
        for (int k = 0; k < QB; ++k) o[(b & 3) * QB + k] = MFMA16(fb[b & 1][k], qf[b >> 2], o[(b & 3) * QB + k]); }
#undef CO_LDS
    float colscale, ri = 0.f, emi = 1.f, den = 0.f;
    const float l2g = MODE == 0 ? log2f(1.0f - exp2f(-5.0f - (float)h)) : 0.f;
    if (MODE == 0) colscale = exp2f((float)(iq + 1) * l2g);
    else { const float m_in = m_in_early; const float bi = aux[iq], mxc = fmaxf(m_in, aux[256 + iq]);
        ri = -mxc; colscale = __expf(m_in - mxc); emi = __expf(-(bi + mxc));
        float nq = 0.f;
#pragma unroll
        for (int s = 0; s < NKS; ++s) { const v4u qw = __builtin_bit_cast(v4u, qf[s]); const f32x4 n0 = *(const LAS f32x4*)(aux + 512 + 32 * s + 8 * g), n1 = *(const LAS f32x4*)(aux + 512 + 32 * s + 8 * g + 4);
            nq += bflo(qw.x) * n0[0] + bfhi(qw.x) * n0[1] + bflo(qw.y) * n0[2] + bfhi(qw.y) * n0[3] + bflo(qw.z) * n1[0] + bfhi(qw.z) * n1[1] + bflo(qw.w) * n1[2] + bfhi(qw.w) * n1[3]; }
        nq += __shfl_xor(nq, 16); nq += __shfl_xor(nq, 32);
        den = colscale * nq; }
#pragma unroll
    for (int vt = 0; vt < NV; ++vt) o[vt] = o[vt] * colscale;
    float dsum = 0.f;
#pragma unroll
    for (int pr = 0; pr < 4; ++pr) {
        if (2 * pr <= qt) {
            f32x4 st[2]; bf16x8 kf[2][NKS];
#pragma unroll
            for (int u = 0; u < 2; ++u)
#pragma unroll
                for (int s = 0; s < NKS; ++s) kf[u][s] = frag_rows(L + Lm::K, Lm::LDQK, 16 * (2 * pr + u), 64 * s, i, g);
            f32x4 cjv[2]; if (MODE == 1) { cjv[0] = *(const LAS f32x4*)(aux + 128 + 32 * pr + 4 * g); cjv[1] = *(const LAS f32x4*)(aux + 128 + 32 * pr + 16 + 4 * g); }
#define CO_LDV(q_) { _Pragma("unroll") for (int k = 0; k < QB; ++k) fb[(q_) & 1][k] = frag_tr(L + Lm::V, Lm::LDV, 32 * pr, 32 * ((q_) * QB + k), i, g, true); asm volatile("" ::: "memory"); }
            CO_LDV(0)
            st[0] = (f32x4){0.f, 0.f, 0.f, 0.f}; st[1] = (f32x4){0.f, 0.f, 0.f, 0.f};
#pragma unroll
            for (int s = 0; s < NKS; ++s) { st[0] = MFMA16(kf[0][s], qf[s], st[0]); st[1] = MFMA16(kf[1][s], qf[s], st[1]); }
            CO_LDV(1)
#pragma unroll
            for (int u = 0; u < 2; ++u) { const int tt = 2 * pr + u;
                f32x4 cj; if (MODE == 1) cj = cjv[u];
#pragma unroll
                for (int r = 0; r < 4; ++r) { const int j = 16 * tt + 4 * g + r; const bool valid = j <= iq;
                    const float wgt = MODE == 0 ? exp2f((float)(iq - j) * l2g) : __expf(fminf(ri + cj[r], 0.f));
                    st[u][r] = valid ? st[u][r] * wgt : 0.f; dsum += st[u][r]; } }
            const bf16x8 pb = pack_acc2(st[0], st[1]);
#pragma unroll
            for (int q = 0; q < 4; ++q) {
#pragma unroll
                for (int k = 0; k < QB; ++k) o[q * QB + k] = MFMA16(fb[q & 1][k], pb, o[q * QB + k]);
                if (q + 2 < 4) CO_LDV(q + 2) }
#undef CO_LDV
        }
    }
    const size_t tok = row0 + iq; float ss = 0.f;
    if (MODE == 1) { dsum += __shfl_xor(dsum, 16); dsum += __shfl_xor(dsum, 32); den += dsum; const float inv = 1.0f / fmaxf(fabsf(den), emi);
#pragma unroll
        for (int vt = 0; vt < NV; ++vt) o[vt] = o[vt] * inv; }
#pragma unroll
    for (int vt = 0; vt < NV; ++vt) ss += (o[vt][0] * o[vt][0] + o[vt][1] * o[vt][1]) + (o[vt][2] * o[vt][2] + o[vt][3] * o[vt][3]);
    ss += __shfl_xor(ss, 16); ss += __shfl_xor(ss, 32);
    const float rs = 1.0f / sqrtf(ss * (1.0f / DV) + 1e-6f);
    bf16* op = MIX + tok * D + h * DV + 4 * g;
#pragma unroll
    for (int vt = 0; vt < NV; ++vt) { const v2u gw = gwv[vt]; float gv[4] = {bflo(gw.x), bfhi(gw.x), bflo(gw.y), bfhi(gw.y)}; float r4[4];
        if (MODE == 0) {
#pragma unroll
            for (int r = 0; r < 4; ++r) r4[r] = silu1(gv[r]) * o[vt][r] * rs; }
        else { const f32x4 gn = *(const LAS f32x4*)(aux + 640 + 16 * vt + 4 * g);
#pragma unroll
            for (int r = 0; r < 4; ++r) r4[r] = sigmoid1(gv[r]) * o[vt][r] * rs * gn[r]; }
        v2u wv; wv.x = cvtpk(r4[0], r4[1]); wv.y = cvtpk(r4[2], r4[3]); *(GAS v2u*)(op + 16 * vt) = wv; }
}

struct Args { const float* in[27]; float* out; unsigned char* ws; int ph_lo, ph_hi; };
static_assert(sizeof(Args) == 27 * 8 + 8 + 8 + 8, "Args has no padding");

#define GEMM_CALL(EpiT, SchedT, g, S, E) pg8::gemm_phase<EpiT, SchedT, true, true>(C.lds + RING_OFF, g, S, E)

__global__ void __launch_bounds__(NWAVES * 64, 2) trunk_fwd(Args args) {
    extern __shared__ __attribute__((aligned(16))) unsigned char lds_raw[];
    Ctx C;
    C.lds = (LAS unsigned char*)lds_raw;
    C.tid = threadIdx.x; C.lane = C.tid & 63; C.wave = __builtin_amdgcn_readfirstlane(C.tid >> 6);
    C.G = gridDim.x; C.bid = blockIdx.x; C.gw = C.bid * NWAVES + C.wave; C.NGW = C.G * NWAVES;
#pragma unroll
    for (int i = 0; i < 27; ++i) C.in[i] = args.in[i];
    C.out = args.out; C.ws = args.ws; C.pacc = 0ull; C.pt0 = 0ull;
    volatile LAS unsigned* MISC = (volatile LAS unsigned*)(C.lds + MISC_OFF);
    for (int u = C.tid; u < (LDS_BYTES - LDSCTL_OFF) / 4; u += NWAVES * 64) ((LAS unsigned*)(C.lds + LDSCTL_OFF))[u] = 0u;
    __syncthreads();
    XcdBarrier bar; bar.bar = (unsigned*)(C.ws + WS_CTL) + CW_BAR; bar.x = 0; bar.st = nullptr;
    if (MK_SINGLE) bar = xcd_barrier_post((unsigned*)(C.ws + WS_CTL) + CW_BAR, MISC + 8);
    const int lo = args.ph_lo, hi = args.ph_hi;
#define IN(k) (lo <= (k) && (k) < hi)
#define DBL(k) (((DBL_MASK >> (k)) & 1ull) != 0ull)
#define SEAM(k) do { if (MK_SINGLE && IN((k) + 1)) xcd_barrier(bar); } while (0)
#define PH(k, ...) if (IN(k)) { if ((PROF_MASK >> (k)) & 1ull) C.pt0 = rt(); __VA_ARGS__ if (DBL(k)) { for (int rep_ = 0; rep_ < DBL_REPS; ++rep_) { if (MK_SINGLE) xcd_barrier(bar); __VA_ARGS__ } } if ((PROF_MASK >> (k)) & 1ull) C.pacc += rt() - C.pt0; }

    bf16* HB = WSP(bf16, WS_HB); float* SS = WSP(float, WS_SS); bf16* Pb = WSP(bf16, WS_BIG + BIG_P); bf16* MIX = WSP(bf16, WS_BIG + BIG_MIX);
    float* SCR1 = WSP(float, WS_BIG + BIG_SCR1); bf16* QKC = WSP(bf16, WS_BIG + BIG_SCR2); bf16* SIN = WSP(bf16, WS_BIG + BIG_SCR2 + SCR2_STATE); bf16* HID = WSP(bf16, WS_BIG);
    const int* PANEL = WSP(int, WS_ROUTE + RT_PANEL); const int* NPp = WSP(int, WS_ROUTE + RT_NP); const float* SLOTRS = WSP(float, WS_ROUTE + RT_SLOTRS);

#define G_INPROJ(layer, NN) { pg8::Gemm g{HB, WSP(bf16, WS_WIN + WIN_OFF[layer]), M, NN, D}; pg8::StaticOrder S; S.init(M, NN, C.G, C.bid); \
        pg8::EpiScaleBf16 E{Pb, NN, SS, rstd_table(C, S, SS)}; GEMM_CALL(pg8::EpiScaleBf16, pg8::StaticOrder, g, S, E); }
#define G_OUTPROJ(layer) { pg8::Gemm g{MIX, WSP(bf16, WS_WOUT + (size_t)(layer) * 2 * MiB), M, D, D}; pg8::StaticOrder S; S.init(M, D, C.G, C.bid); \
        pg8::EpiResid E{HB, SS, (PG8_LAS float*)(C.lds + 131072)}; GEMM_CALL(pg8::EpiResid, pg8::StaticOrder, g, S, E); }
#define G_GATEUP_DENSE(j) { pg8::Gemm g{HB, WSP(bf16, WS_WFD + (j) * FD_STRIDE), M, 2 * FF, D}; pg8::StaticOrder S; S.init(M, 2 * FF, C.G, C.bid); \
        pg8::EpiSwiglu<false> E{HID, SS, rstd_table(C, S, SS)}; GEMM_CALL(pg8::EpiSwiglu<false>, pg8::StaticOrder, g, S, E); }
#define G_DOWN_DENSE(j) { pg8::Gemm g{HID, WSP(bf16, WS_WFD + (j) * FD_STRIDE + FD_WD), M, D, FF}; pg8::StaticOrder S; S.init(M, D, C.G, C.bid); \
        pg8::EpiResid E{HB, SS, (PG8_LAS float*)(C.lds + 131072)}; GEMM_CALL(pg8::EpiResid, pg8::StaticOrder, g, S, E); }
#define G_GATEUP_MOE(j) { pg8::Gemm g{HB, WSP(bf16, WS_WMOE + (j) * MOE_STRIDE), MAXSLOT, NE * 2 * FF, D, WSP(int, WS_ROUTE + RT_ROWTOK)}; pg8::MoeOrder S; S.init(NPp, PANEL, 28, C.G, C.bid); \
        pg8::EpiSwiglu<true> E{HID, SLOTRS, nullptr}; pg8::gemm_phase<pg8::EpiSwiglu<true>, pg8::MoeOrder, true, true, true>(C.lds + RING_OFF, g, S, E); }
#define G_DOWN_MOE(j) { pg8::Gemm g{HID, WSP(bf16, WS_WMOE + (j) * MOE_STRIDE + MOE_WD), MAXSLOT, NE * D, FF}; pg8::MoeOrder S; S.init(NPp, PANEL, 4, C.G, C.bid); \
        if (C.G == 256) S.max_rounds = 2; pg8::EpiYBf16 E{WSP(bf16, WS_Y)}; GEMM_CALL(pg8::EpiYBf16, pg8::MoeOrder, g, S, E); } \
    if (C.G == 256) { const int tail = C.bid / 7, ks = C.bid % 7; \
        pg8::Gemm g{HID + ks * 512, WSP(bf16, WS_WMOE + (j) * MOE_STRIDE + MOE_WD) + ks * 512, MAXSLOT, NE * D, 512, nullptr, FF}; \
        pg8::MoeOrder S; S.init(NPp, PANEL, 4, C.G, tail); S.first_round = 2; S.max_rounds = (C.bid < 224) ? 3 : 0; \
        pg8::EpiSlab E{WSP(float, WS_SLAB), WSP(int, WS_ROUTE + RT_TAILIDX), tail, ks}; GEMM_CALL(pg8::EpiSlab, pg8::MoeOrder, g, S, E); }
#define G_MEMKV() { pg8::Gemm g{WSP(bf16, WS_MEMN), WSP(bf16, WS_WMEM), MROWS, 2048, D}; pg8::StaticOrder S; S.init(MROWS, 2048, C.G, (C.bid + 16) % C.G); \
        pg8::EpiPlainBf16 E{WSP(bf16, WS_MKV), 2048}; GEMM_CALL(pg8::EpiPlainBf16, pg8::StaticOrder, g, S, E); }
#define MEMATTN(layer, NN) { TB(102); for (int u = C.bid; u < 256; u += C.G) attn_mem_pair(C, u, Pb, NN, C.in[5] + (layer) * 64, C.in[6] + (layer) * 64, layer, MIX); TE(102); }
#define FFN_DENSE(k, j) PH(k, G_GATEUP_DENSE(j) SEAM(k);) PH((k) + 1, G_DOWN_DENSE(j) SEAM((k) + 1);)
#define FFN_MOE(k, j, layer) PH(k, moe_route1(C, j, layer); SEAM(k);) PH((k) + 1, moe_route2(C); SEAM((k) + 1);) PH((k) + 2, G_GATEUP_MOE(j) SEAM((k) + 2);) \
        PH((k) + 3, G_DOWN_MOE(j) SEAM((k) + 3);) PH((k) + 4, moe_combine<(layer) == 3>(C); SEAM((k) + 4);)

    PH(0, p_prologue(C); SEAM(0);)
    PH(1, G_MEMKV() G_INPROJ(0, N_SWA) SEAM(1);)
    PH(2, for (int u = C.bid; u < 512; u += C.G) { if (u == C.bid) TB(100); else TB(101); attn_swa_unit(C, u, Pb, N_SWA, C.in[10], C.in[11], C.in[12], 768, 1024, MIX); if (u == C.bid) TE(100); else TE(101); }
          MEMATTN(0, N_SWA) SEAM(2);)
    PH(3, G_OUTPROJ(0) SEAM(3);)
    FFN_DENSE(4, 0)
#define IDLE_TP(win) if (C.G == 256 && C.bid >= 128) tp_run(C, TP_MOVED_LO + (win) * TP_WIN_N + C.bid - 128, 128, TP_MOVED_LO + ((win) + 1) * TP_WIN_N, 1 << 30, 0);
    PH(6, G_INPROJ(1, N_RET) IDLE_TP(0) SEAM(6);)
    PH(7, for (int u = C.bid; u < 768; u += C.G) chunk_state_unit<0>(C, u, Pb, nullptr, SCR1); MEMATTN(1, N_RET) SEAM(7);)
    PH(8, ret_scan(C, SCR1, SIN); SEAM(8);)
    PH(9, for (int u = C.bid; u < 768; u += C.G) chunk_out_unit<0>(C, u, Pb, nullptr, SIN, MIX); SEAM(9);)
    PH(10, G_OUTPROJ(1) SEAM(10);)
    FFN_MOE(11, 0, 1)
    PH(16, G_INPROJ(2, N_MLS) mls_gates(C); IDLE_TP(1) SEAM(16);)
    PH(17, mls_aux(C); mls_conv(C, Pb, QKC); SEAM(17);)
    PH(18, for (int u = C.bid; u < 512; u += C.G) chunk_state_unit<1>(C, u, Pb, QKC, SCR1); MEMATTN(2, N_MLS) SEAM(18);)
    PH(19, mls_scan(C, SCR1, SIN); SEAM(19);)
    PH(20, for (int u = C.bid; u < 512; u += C.G) chunk_out_unit<1>(C, u, Pb, QKC, SIN, MIX); SEAM(20);)
    PH(21, G_OUTPROJ(2) SEAM(21);)
    FFN_DENSE(22, 1)
    PH(24, G_INPROJ(3, N_SWA) IDLE_TP(2) SEAM(24);)
    PH(25, for (int u = C.bid; u < 512; u += C.G) { if (u == C.bid) TB(100); else TB(101); attn_swa_unit(C, u, Pb, N_SWA, C.in[10] + 64, C.in[11] + 64, C.in[12] + 12, 768, 1024, MIX); if (u == C.bid) TE(100); else TE(101); }
           MEMATTN(3, N_SWA) SEAM(25);)
    PH(26, G_OUTPROJ(3) SEAM(26);)
    FFN_MOE(27, 1, 3)
    if (PROF_MASK != 0ull || PROF_SEC >= 0) { const unsigned long long te_ = rt() + (unsigned long long)PROF_AMP * C.pacc; while (rt() < te_) __builtin_amdgcn_s_sleep(16); }
#undef IN
}

extern "C" void kernel_launch(void* const* d_in, const int* in_sizes, int n_in, void* d_out, int out_size, void* d_ws, size_t ws_size, hipStream_t stream) {
    static int grid = 0;
    if (grid == 0) {
        if (n_in != 27 || in_sizes[0] != M * D || out_size != M * D || ws_size < WS_END) { fprintf(stderr, "kernel_launch: unexpected shapes (n_in %d, in0 %d, out %d, ws %zu < %zu)\n", n_in, n_in > 0 ? in_sizes[0] : -1, out_size, ws_size, (size_t)WS_END); grid = -1; return; }
        int dev = 0, cus = 0, per_cu = 0;
        if (hipGetDevice(&dev) != hipSuccess || hipDeviceGetAttribute(&cus, hipDeviceAttributeMultiprocessorCount, dev) != hipSuccess) { grid = -1; return; }
        if (hipFuncSetAttribute((const void*)trunk_fwd, hipFuncAttributeMaxDynamicSharedMemorySize, LDS_BYTES) != hipSuccess) { fprintf(stderr, "kernel_launch: hipFuncSetAttribute failed\n"); grid = -1; return; }
        if (hipOccupancyMaxActiveBlocksPerMultiprocessor(&per_cu, (const void*)trunk_fwd, NWAVES * 64, LDS_BYTES) != hipSuccess || per_cu < 1) fprintf(stderr, "kernel_launch: occupancy query says %d\n", per_cu);
        (void)hipGetLastError();
        grid = cus;
    }
    if (grid < 0) return;
    if (hipMemsetAsync((char*)d_ws + WS_CTL, 0, CTL_ZERO_BYTES, stream) != hipSuccess) return;
    Args a{};
    for (int i = 0; i < 27; ++i) a.in[i] = (const float*)d_in[i];
    a.out = (float*)d_out; a.ws = (unsigned char*)d_ws;
    if (MK_SINGLE) { a.ph_lo = 0; a.ph_hi = NPHASE; hipLaunchKernelGGL(trunk_fwd, dim3(grid), dim3(NWAVES * 64), LDS_BYTES, stream, a); }
    else for (int p = 0; p < NPHASE; ++p) { a.ph_lo = p; a.ph_hi = p + 1; hipLaunchKernelGGL(trunk_fwd, dim3(grid), dim3(NWAVES * 64), LDS_BYTES, stream, a); }
}
```

```cpp
#include <hip/hip_runtime.h>
#include <cstdio>
#include <cstdint>
namespace pg8 {
#define PG8_LAS __attribute__((address_space(3)))
typedef unsigned short bf16_t;
typedef short bf16x8 __attribute__((ext_vector_type(8)));
typedef float f32x4 __attribute__((ext_vector_type(4)));
typedef unsigned u32x4 __attribute__((ext_vector_type(4)));
constexpr int BM = 256, BK = 64, HALF = 128, HTB = HALF * BK * 2  , STAGE_BYTES = 8 * HTB, NXCD = 8, WGM = 8;

__host__ __device__ __forceinline__ int lds_byte(int r, int c) { const int st = (r >> 4) * 2 + (c >> 5), rr = r & 15, cc = c & 31, ob = rr * 64 + cc * 2; return st * 1024 + (ob ^ (((ob >> 9) & 1) << 5)); }
__host__ __device__ __forceinline__ void stage_rc(int b, int& R, int& C) { const int st = b / 1024, sb = b % 1024, swz = sb ^ (((sb >> 9) & 1) << 5); R = (st >> 1) * 16 + swz / 64; C = (st & 1) * 32 + (swz % 64) / 2; }
__host__ __device__ __forceinline__ int perm32(int rho) { const int n = rho >> 4, i = rho & 15; return 8 * (i >> 2) + 4 * n + (i & 3); }

struct Unit { int pm, pn; };
struct Gemm { const bf16_t* A; const bf16_t* Bt; int M, N, K; const int* rowmap; int ld; };

struct StaticOrder {
    int nM, nN, nwg, G, c;
    __host__ __device__ void init(int M, int N, int G_, int c_) { nM = M / BM; nN = N / BM; nwg = nM * nN; G = G_; c = c_; }
    __host__ __device__ bool next(int i, Unit& u) const {
        const long L = (long)i * G + c; if (L >= nwg) return false;
        int wgid = (int)L; { const int q = nwg / NXCD, r = nwg % NXCD, xcd = wgid % NXCD, off = wgid / NXCD; wgid = (xcd < r ? xcd * (q + 1) : r * (q + 1) + (xcd - r) * q) + off; }
        const int nig = WGM * nN, gid = wgid / nig, fm = gid * WGM, gsz = (nM - fm) < WGM ? (nM - fm) : WGM;
        u.pm = fm + ((wgid % nig) % gsz); u.pn = (wgid % nig) / gsz; return true;
    }
    __device__ __forceinline__ void a_ready(const Unit&) const {}
    __device__ __forceinline__ void done(const Unit&) const {}
};

__device__ __forceinline__ unsigned cvt_pk_bf16(float lo, float hi) { unsigned r; asm volatile("v_cvt_pk_bf16_f32 %0, %1, %2" : "=v"(r) : "v"(lo), "v"(hi)); return r; }
__device__ __forceinline__ float row_rstd16(const float* SS, int row) {
    const f32x4 a = *(const f32x4*)(SS + (size_t)row * 4);
    return __builtin_amdgcn_rsqf(((a[0] + a[1]) + (a[2] + a[3])) * (1.0f / 1024.0f) + 1e-6f);
}
typedef float f32x2 __attribute__((ext_vector_type(2)));

struct EpiPlainBf16 {
    static constexpr bool PERM = true, AFTER_DRAIN = false;
    bf16_t* O; int ldc;
    __device__ __forceinline__ void operator()(const f32x4 (&acc)[2][2][4][2], const Unit& u, int wr, int wc, int fr, int fq) const {
        const int row0 = u.pm * BM + wr * 64 + fr, col0 = u.pn * BM + wc * 32 + 8 * fq;
#pragma unroll
        for (int ai = 0; ai < 2; ++ai)
#pragma unroll
            for (int m = 0; m < 4; ++m) { bf16_t* rowp = O + (size_t)(row0 + ai * HALF + m * 16) * ldc + col0;
#pragma unroll
                for (int bj = 0; bj < 2; ++bj) { const f32x4 v0 = acc[ai][bj][m][0], v1 = acc[ai][bj][m][1];
                    u32x4 w; w.x = cvt_pk_bf16(v0[0], v0[1]); w.y = cvt_pk_bf16(v0[2], v0[3]); w.z = cvt_pk_bf16(v1[0], v1[1]); w.w = cvt_pk_bf16(v1[2], v1[3]);
                    *(u32x4*)(rowp + bj * HALF) = w; } }
    }
};
struct EpiScaleBf16 {
    static constexpr bool PERM = true, AFTER_DRAIN = false;
    bf16_t* O; int ldc; const float* SS; const PG8_LAS float* rsl;
    __device__ __forceinline__ void operator()(const f32x4 (&acc)[2][2][4][2], const Unit& u, int wr, int wc, int fr, int fq) const {
        const int row0 = u.pm * BM + wr * 64 + fr, col0 = u.pn * BM + wc * 32 + 8 * fq;
#pragma unroll
        for (int ai = 0; ai < 2; ++ai)
#pragma unroll
            for (int m = 0; m < 4; ++m) { const int row = row0 + ai * HALF + m * 16; const float sc = rsl ? rsl[row & 255] : row_rstd16(SS, row); bf16_t* rowp = O + (size_t)row * ldc + col0;
#pragma unroll
                for (int bj = 0; bj < 2; ++bj) { const f32x4 v0 = acc[ai][bj][m][0] * sc, v1 = acc[ai][bj][m][1] * sc;
                    u32x4 w; w.x = cvt_pk_bf16(v0[0], v0[1]); w.y = cvt_pk_bf16(v0[2], v0[3]); w.z = cvt_pk_bf16(v1[0], v1[1]); w.w = cvt_pk_bf16(v1[2], v1[3]);
                    *(u32x4*)(rowp + bj * HALF) = w; } }
    }
};
struct EpiResid {
    static constexpr bool PERM = true, AFTER_DRAIN = false;
    bf16_t* HB; float* SS; PG8_LAS float* xs;
    __device__ __forceinline__ void operator()(const f32x4 (&acc)[2][2][4][2], const Unit& u, int wr, int wc, int fr, int fq) const {
        const int row0 = u.pm * BM + wr * 64 + fr, col0 = u.pn * BM + wc * 32 + 8 * fq;
        u32x4 hv[2][4][2];
#pragma unroll
        for (int ai = 0; ai < 2; ++ai)
#pragma unroll
            for (int m = 0; m < 4; ++m) { const bf16_t* bp = HB + (size_t)(row0 + ai * HALF + m * 16) * 1024 + col0;
                hv[ai][m][0] = *(const u32x4*)bp; hv[ai][m][1] = *(const u32x4*)(bp + HALF); }
#pragma unroll
        for (int ai = 0; ai < 2; ++ai)
#pragma unroll
            for (int m = 0; m < 4; ++m) { const int row = row0 + ai * HALF + m * 16; bf16_t* bp = HB + (size_t)row * 1024 + col0; float ss = 0.f;
#pragma unroll
                for (int bj = 0; bj < 2; ++bj) { const u32x4 hw = hv[ai][m][bj];
                    f32x4 h0 = (f32x4){__uint_as_float(hw.x << 16), __uint_as_float(hw.x & 0xffff0000u), __uint_as_float(hw.y << 16), __uint_as_float(hw.y & 0xffff0000u)};
                    f32x4 h1 = (f32x4){__uint_as_float(hw.z << 16), __uint_as_float(hw.z & 0xffff0000u), __uint_as_float(hw.w << 16), __uint_as_float(hw.w & 0xffff0000u)};
                    h0 = h0 + acc[ai][bj][m][0]; h1 = h1 + acc[ai][bj][m][1];
                    ss += ((h0[0] * h0[0] + h0[1] * h0[1]) + (h0[2] * h0[2] + h0[3] * h0[3])) + ((h1[0] * h1[0] + h1[1] * h1[1]) + (h1[2] * h1[2] + h1[3] * h1[3]));
                    u32x4 w; w.x = cvt_pk_bf16(h0[0], h0[1]); w.y = cvt_pk_bf16(h0[2], h0[3]); w.z = cvt_pk_bf16(h1[0], h1[1]); w.w = cvt_pk_bf16(h1[2], h1[3]);
                    *(u32x4*)(bp + bj * HALF) = w; }
                ss += __shfl_xor(ss, 16); ss += __shfl_xor(ss, 32);
                if (fq == 0) xs[(ai * HALF + wr * 64 + m * 16 + fr) * 4 + wc] = ss; }
        asm volatile("s_waitcnt lgkmcnt(0)" ::: "memory"); __builtin_amdgcn_s_barrier(); asm volatile("" ::: "memory");
        if (threadIdx.x < 256) { const f32x4 v = *(const PG8_LAS f32x4*)(xs + 4 * threadIdx.x); SS[(size_t)(u.pm * BM + threadIdx.x) * 4 + u.pn] = (v[0] + v[1]) + (v[2] + v[3]); }
    }
};
template <bool MOE> struct EpiSwiglu {
    static constexpr bool PERM = true, AFTER_DRAIN = false;
    bf16_t* O; const float* RS; const PG8_LAS float* rsl;
    static __device__ __forceinline__ f32x2 swi2(f32x2 g, f32x2 u, float nsc, float sc2) {
        const f32x2 t = g * nsc; f32x2 d; d.x = __builtin_amdgcn_exp2f(t.x); d.y = __builtin_amdgcn_exp2f(t.y); d = d + 1.0f;
        f32x2 r; r.x = __builtin_amdgcn_rcpf(d.x); r.y = __builtin_amdgcn_rcpf(d.y);
        return ((g * u) * sc2) * r;
    }
    __device__ __forceinline__ void operator()(const f32x4 (&acc)[2][2][4][2], const Unit& u, int wr, int wc, int fr, int fq) const {
        const int pnl = MOE ? (u.pn % 28) : u.pn;
        const int row0 = u.pm * BM + wr * 64 + fr, col0 = pnl * HALF + wc * 32 + 8 * fq;
        float scv[2][4];
#pragma unroll
        for (int ai = 0; ai < 2; ++ai)
#pragma unroll
            for (int m = 0; m < 4; ++m) { const int row = row0 + ai * HALF + m * 16; scv[ai][m] = MOE ? RS[row] : (rsl ? rsl[row & 255] : row_rstd16(RS, row)); }
#pragma unroll
        for (int ai = 0; ai < 2; ++ai)
#pragma unroll
            for (int m = 0; m < 4; ++m) { const int row = row0 + ai * HALF + m * 16; const float sc = scv[ai][m], nsc = -1.4426950408889634f * sc, sc2 = sc * sc;
                const f32x4 g0 = acc[ai][0][m][0], g1 = acc[ai][0][m][1], u0 = acc[ai][1][m][0], u1 = acc[ai][1][m][1];
                const f32x2 a = swi2((f32x2){g0[0], g0[1]}, (f32x2){u0[0], u0[1]}, nsc, sc2), b = swi2((f32x2){g0[2], g0[3]}, (f32x2){u0[2], u0[3]}, nsc, sc2);
                const f32x2 c = swi2((f32x2){g1[0], g1[1]}, (f32x2){u1[0], u1[1]}, nsc, sc2), d = swi2((f32x2){g1[2], g1[3]}, (f32x2){u1[2], u1[3]}, nsc, sc2);
                u32x4 w; w.x = cvt_pk_bf16(a.x, a.y); w.y = cvt_pk_bf16(b.x, b.y); w.z = cvt_pk_bf16(c.x, c.y); w.w = cvt_pk_bf16(d.x, d.y);
                *(u32x4*)(O + (size_t)row * 3584 + col0) = w; }
    }
};
struct EpiYBf16 {
    static constexpr bool PERM = true, AFTER_DRAIN = false;
    bf16_t* Y;
    __device__ __forceinline__ void operator()(const f32x4 (&acc)[2][2][4][2], const Unit& u, int wr, int wc, int fr, int fq) const {
        const int pnl = u.pn & 3;
        const int row0 = u.pm * BM + wr * 64 + fr, col0 = pnl * BM + wc * 32 + 8 * fq;
#pragma unroll
        for (int ai = 0; ai < 2; ++ai)
#pragma unroll
            for (int m = 0; m < 4; ++m) { bf16_t* yp = Y + (size_t)(row0 + ai * HALF + m * 16) * 1024 + col0;
#pragma unroll
                for (int bj = 0; bj < 2; ++bj) { const f32x4 v0 = acc[ai][bj][m][0], v1 = acc[ai][bj][m][1];
                    u32x4 w; w.x = cvt_pk_bf16(v0[0], v0[1]); w.y = cvt_pk_bf16(v0[2], v0[3]); w.z = cvt_pk_bf16(v1[0], v1[1]); w.w = cvt_pk_bf16(v1[2], v1[3]);
                    *(u32x4*)(yp + bj * HALF) = w; } }
    }
};
struct EpiSlab {
    static constexpr bool PERM = true, AFTER_DRAIN = false;
    float* S; int* tailidx; int tail, ks;
    __device__ __forceinline__ void operator()(const f32x4 (&acc)[2][2][4][2], const Unit& u, int wr, int wc, int fr, int fq) const {
        float* sp = S + (size_t)(tail * 7 + ks) * 65536; const int row0 = wr * 64 + fr, col0 = wc * 32 + 8 * fq;
        if (ks == 0 && threadIdx.x == 0) tailidx[u.pm * 4 + (u.pn & 3)] = tail;
#pragma unroll
        for (int ai = 0; ai < 2; ++ai)
#pragma unroll
            for (int m = 0; m < 4; ++m) { float* yp = sp + (size_t)(row0 + ai * HALF + m * 16) * 256 + col0;
#pragma unroll
                for (int bj = 0; bj < 2; ++bj) { *(f32x4*)(yp + bj * HALF) = acc[ai][bj][m][0]; *(f32x4*)(yp + bj * HALF + 4) = acc[ai][bj][m][1]; } }
    }
};
struct MoeOrder {
    StaticOrder so; const int* panel_e; int ntn, max_rounds, first_round;
    __device__ void init(const int* np_ptr, const int* panel_e_, int ntn_, int G, int c) { const int np = __builtin_amdgcn_readfirstlane(*np_ptr); so.init(np * BM, ntn_ * BM, G, c); panel_e = panel_e_; ntn = ntn_; max_rounds = 1 << 20; first_round = 0; }
    __device__ bool next(int i, Unit& u) const { i += first_round; if (i >= max_rounds || !so.next(i, u)) return false; const int e = __builtin_amdgcn_readfirstlane(panel_e[u.pm]); u.pn += e * ntn; return true; }
    __device__ __forceinline__ void a_ready(const Unit&) const {}
    __device__ __forceinline__ void done(const Unit&) const {}
};
template <class Epi, class Sched, bool ALIGN_EPI = false, bool SP2 = false, bool GATHER = false>
__device__ __forceinline__ void gemm_phase(PG8_LAS unsigned char* lds, const Gemm g, const Sched& S, const Epi& E) {
    const int tid = threadIdx.x, wid = __builtin_amdgcn_readfirstlane(tid >> 6), lane = tid & 63, wr = wid >> 2, wc = wid & 3, fr = lane & 15, fq = lane >> 4;
    const int K = g.K, nt = K / BK, LD = g.ld ? g.ld : g.K;
    unsigned voffA[2], voffB[2]; int gR[2]; unsigned gC[2];
#pragma unroll
    for (int i = 0; i < 2; ++i) { int R, C; stage_rc(tid * 16 + i * 8192, R, C); const int Rb = Epi::PERM ? ((R & ~31) + perm32(R & 31)) : R;
        voffA[i] = (unsigned)(R * LD + C) * 2u; voffB[i] = (unsigned)(Rb * LD + C) * 2u; gR[i] = R; gC[i] = (unsigned)C * 2u; }
    const size_t kstep = (size_t)(BK * 2);
    const size_t hstep = (size_t)HALF * LD * 2;
    const size_t tstep = 2 * hstep;
    const unsigned ldsw = (unsigned)wid * 1024u;
    const int aoff = lds_byte(wr * 64 + fr, fq * 8), boff = lds_byte(wc * 32 + fr, fq * 8);
#define PG8_SA(b, h) (((b) * 2 + (h)) * HTB)
#define PG8_SB(b, h) ((4 + (b) * 2 + (h)) * HTB)
#define PG8_STAGE(bufoff, gbase, voff) do { _Pragma("unroll") for (int _i = 0; _i < 2; ++_i) \
        __builtin_amdgcn_global_load_lds((const unsigned*)((const char*)(gbase) + (voff)[_i]), (PG8_LAS unsigned*)(lds + (bufoff) + ldsw + _i * 8192), 16, 0, 0); } while (0)
#define PG8_GOFF(dst, pm_) do { _Pragma("unroll") for (int _h = 0; _h < 2; ++_h) _Pragma("unroll") for (int _i = 0; _i < 2; ++_i) \
        dst[_h][_i] = (unsigned)g.rowmap[(pm_) * BM + _h * HALF + gR[_i]] * (unsigned)(LD * 2) + gC[_i]; } while (0)
#define PG8_STAGE_A(bufoff, ptr, half, nx) do { if constexpr (GATHER) { const unsigned _o0 = (nx) ? gvN[half][0] : gvC[half][0], _o1 = (nx) ? gvN[half][1] : gvC[half][1]; \
        __builtin_amdgcn_global_load_lds((const unsigned*)((const char*)(ptr) + _o0), (PG8_LAS unsigned*)(lds + (bufoff) + ldsw), 16, 0, 0); \
        __builtin_amdgcn_global_load_lds((const unsigned*)((const char*)(ptr) + _o1), (PG8_LAS unsigned*)(lds + (bufoff) + ldsw + 8192), 16, 0, 0); } \
        else { PG8_STAGE(bufoff, (ptr) + (half) * hstep, voffA); } } while (0)
#define PG8_LDA(dst, b, h) do { _Pragma("unroll") for (int m = 0; m < 4; ++m) _Pragma("unroll") for (int k = 0; k < 2; ++k) dst[m][k] = *(const PG8_LAS bf16x8*)(lds + PG8_SA(b, h) + aoff + m * 2048 + k * 1024); } while (0)
#define PG8_LDB(dst, b, h) do { _Pragma("unroll") for (int n = 0; n < 2; ++n) _Pragma("unroll") for (int k = 0; k < 2; ++k) dst[n][k] = *(const PG8_LAS bf16x8*)(lds + PG8_SB(b, h) + boff + n * 2048 + k * 1024); } while (0)
#define PG8_MMA(ai, bj, At, Bt) do { __builtin_amdgcn_s_setprio(1); _Pragma("unroll") for (int m = 0; m < 4; ++m) _Pragma("unroll") for (int n = 0; n < 2; ++n) _Pragma("unroll") for (int k = 0; k < 2; ++k) \
        acc[ai][bj][m][n] = __builtin_amdgcn_mfma_f32_16x16x32_bf16(Bt[n][k], At[m][k], acc[ai][bj][m][n], 0, 0, 0); __builtin_amdgcn_s_setprio(0); } while (0)
#define PG8_WAIT_V(n) asm volatile("s_waitcnt vmcnt(" #n ")" ::: "memory")
#define PG8_WAIT_L(n) asm volatile("s_waitcnt lgkmcnt(" #n ")" ::: "memory")
#define PG8_BAR __builtin_amdgcn_s_barrier()
#define PG8_SCHED __builtin_amdgcn_sched_barrier(0)
    Unit cur, nxt; int ui = 0;
    if (!S.next(0, cur)) return;
    f32x4 acc[2][2][4][2];
#pragma unroll
    for (int a = 0; a < 2; ++a)
#pragma unroll
        for (int b = 0; b < 2; ++b)
#pragma unroll
            for (int m = 0; m < 4; ++m)
#pragma unroll
                for (int n = 0; n < 2; ++n) acc[a][b][m][n] = (f32x4){0.f, 0.f, 0.f, 0.f};
    bf16x8 At[4][2], B0[2][2], B1[2][2];
    unsigned gvC[2][2], gvN[2][2]; if constexpr (GATHER) { PG8_GOFF(gvC, cur.pm); PG8_GOFF(gvN, cur.pm); }
    const char* cA = GATHER ? (const char*)g.A : (const char*)g.A + (size_t)cur.pm * tstep; const char* cB = (const char*)g.Bt + (size_t)cur.pn * tstep;
    S.a_ready(cur);
    if constexpr (SP2) {
        PG8_STAGE(PG8_SB(0, 0), cB, voffB); PG8_STAGE(PG8_SB(0, 1), cB + hstep, voffB); PG8_STAGE_A(PG8_SA(0, 0), cA, 0, false); PG8_STAGE_A(PG8_SA(0, 1), cA, 1, false);
        if (wr == 1) PG8_BAR;
        PG8_WAIT_V(2); PG8_BAR;
        PG8_STAGE(PG8_SB(1, 0), cB + kstep, voffB); PG8_STAGE_A(PG8_SA(1, 0), cA + kstep, 0, false); PG8_STAGE(PG8_SB(1, 1), cB + hstep + kstep, voffB);
        PG8_WAIT_V(6); PG8_BAR;
    } else {
        PG8_STAGE(PG8_SB(0, 0), cB, voffB); PG8_STAGE_A(PG8_SA(0, 0), cA, 0, false); PG8_STAGE(PG8_SB(0, 1), cB + hstep, voffB); PG8_STAGE_A(PG8_SA(0, 1), cA, 1, false);
        if (wr == 1) PG8_BAR;
        PG8_WAIT_V(4); PG8_BAR;
        PG8_STAGE(PG8_SB(1, 0), cB + kstep, voffB); PG8_STAGE_A(PG8_SA(1, 0), cA + kstep, 0, false); PG8_STAGE(PG8_SB(1, 1), cB + hstep + kstep, voffB);
        PG8_WAIT_V(6); PG8_BAR;
    }
    for (;;) {
        const bool has_next = S.next(ui + 1, nxt);
        if constexpr (GATHER) { if (has_next) { PG8_GOFF(gvN, nxt.pm); } else { _Pragma("unroll") for (int _h = 0; _h < 2; ++_h) { gvN[_h][0] = gvC[_h][0]; gvN[_h][1] = gvC[_h][1]; } } }
        const char* nA = GATHER ? (const char*)g.A : (has_next ? (const char*)g.A + (size_t)nxt.pm * tstep : cA); const char* nB = has_next ? (const char*)g.Bt + (size_t)nxt.pn * tstep : cB;
        for (int t = 0; t < nt; t += 2) {
            const bool last = (t == nt - 2);
            const char* a1 = cA + (size_t)(t + 1) * kstep;
            const char* a2 = last ? nA : cA + (size_t)(t + 2) * kstep; const char* b2 = last ? nB : cB + (size_t)(t + 2) * kstep;
            const char* a3 = a2 + kstep; const char* b3 = b2 + kstep;
            if (last && has_next) S.a_ready(nxt);
            if constexpr (SP2) {
            PG8_LDB(B0, 0, 0); PG8_LDB(B1, 0, 1); PG8_SCHED; PG8_LDA(At, 0, 0); PG8_STAGE_A(PG8_SA(1, 1), a1, 1, false);
            PG8_WAIT_V(8); PG8_WAIT_L(0); PG8_BAR; PG8_MMA(0, 0, At, B0); PG8_MMA(0, 1, At, B1); PG8_BAR; PG8_SCHED;
            PG8_LDA(At, 0, 1); PG8_STAGE(PG8_SB(0, 0), b2, voffB); PG8_STAGE(PG8_SB(0, 1), b2 + hstep, voffB); PG8_STAGE_A(PG8_SA(0, 0), a2, 0, last);
            PG8_WAIT_V(8); PG8_WAIT_L(0); PG8_BAR; PG8_MMA(1, 0, At, B0); PG8_MMA(1, 1, At, B1); PG8_BAR; PG8_SCHED;
            PG8_LDB(B0, 1, 0); PG8_LDB(B1, 1, 1); PG8_SCHED; PG8_LDA(At, 1, 0); PG8_STAGE_A(PG8_SA(0, 1), a2, 1, last);
            PG8_WAIT_V(8); PG8_WAIT_L(0); PG8_BAR; PG8_MMA(0, 0, At, B0); PG8_MMA(0, 1, At, B1); PG8_BAR; PG8_SCHED;
            PG8_LDA(At, 1, 1); PG8_STAGE(PG8_SB(1, 0), b3, voffB); PG8_STAGE(PG8_SB(1, 1), b3 + hstep, voffB); PG8_STAGE_A(PG8_SA(1, 0), a3, 0, last);
            PG8_WAIT_V(8); PG8_WAIT_L(0); PG8_BAR; PG8_MMA(1, 0, At, B0); PG8_MMA(1, 1, At, B1); PG8_BAR; PG8_SCHED;
            } else {
            PG8_LDB(B0, 0, 0); PG8_SCHED; PG8_LDA(At, 0, 0); PG8_STAGE_A(PG8_SA(1, 1), a1, 1, false);
            PG8_WAIT_L(8); PG8_BAR; PG8_WAIT_L(0); PG8_MMA(0, 0, At, B0); PG8_BAR; PG8_SCHED;
            PG8_LDB(B1, 0, 1); PG8_STAGE(PG8_SB(0, 0), b2, voffB);
            PG8_BAR; PG8_WAIT_L(0); PG8_MMA(0, 1, At, B1); PG8_BAR;
            PG8_LDA(At, 0, 1); PG8_STAGE_A(PG8_SA(0, 0), a2, 0, last);
            PG8_BAR; PG8_WAIT_L(0); PG8_MMA(1, 0, At, B0); PG8_BAR; PG8_SCHED;
            PG8_STAGE(PG8_SB(0, 1), b2 + hstep, voffB);
            PG8_WAIT_V(6); PG8_BAR; PG8_MMA(1, 1, At, B1); PG8_BAR;
            PG8_LDB(B0, 1, 0); PG8_SCHED; PG8_LDA(At, 1, 0); PG8_STAGE_A(PG8_SA(0, 1), a2, 1, last);
            PG8_WAIT_L(8); PG8_BAR; PG8_WAIT_L(0); PG8_MMA(0, 0, At, B0); PG8_BAR; PG8_SCHED;
            PG8_LDB(B1, 1, 1); PG8_STAGE(PG8_SB(1, 0), b3, voffB);
            PG8_BAR; PG8_WAIT_L(0); PG8_MMA(0, 1, At, B1); PG8_BAR;
            PG8_LDA(At, 1, 1); PG8_STAGE_A(PG8_SA(1, 0), a3, 0, last);
            PG8_BAR; PG8_WAIT_L(0); PG8_MMA(1, 0, At, B0); PG8_BAR; PG8_SCHED;
            PG8_STAGE(PG8_SB(1, 1), b3 + hstep, voffB);
            PG8_WAIT_V(6); PG8_BAR; PG8_MMA(1, 1, At, B1); PG8_BAR;
            }
        }
        if constexpr (ALIGN_EPI) { if (wr == 0) PG8_BAR; }
        if constexpr (!Epi::AFTER_DRAIN) { E(acc, cur, wr, wc, fr, fq); S.done(cur); }
        if (!has_next) break;
#pragma unroll
        for (int a = 0; a < 2; ++a)
#pragma unroll
            for (int b = 0; b < 2; ++b)
#pragma unroll
                for (int m = 0; m < 4; ++m)
#pragma unroll
                    for (int n = 0; n < 2; ++n) acc[a][b][m][n] = (f32x4){0.f, 0.f, 0.f, 0.f};
        cur = nxt; cA = nA; cB = nB; ++ui;
        if constexpr (GATHER) { _Pragma("unroll") for (int _h = 0; _h < 2; ++_h) { gvC[_h][0] = gvN[_h][0]; gvC[_h][1] = gvN[_h][1]; } }
        if constexpr (ALIGN_EPI) { if (wr == 1) PG8_BAR; }
    }
    PG8_WAIT_V(0);
    if constexpr (!ALIGN_EPI) { if (wr == 0) PG8_BAR; }
    PG8_BAR;
    if constexpr (Epi::AFTER_DRAIN) { E.fused(acc, cur, wr, wc, fr, fq, lds, wid, lane); S.done(cur); }
#undef PG8_SA
#undef PG8_SB
#undef PG8_STAGE
#undef PG8_GOFF
#undef PG8_STAGE_A
#undef PG8_LDA
#undef PG8_LDB
#undef PG8_MMA
#undef PG8_WAIT_V
#undef PG8_WAIT_L
#undef PG8_BAR
#undef PG8_SCHED
}
}
constexpr int NWAVES = 8;
constexpr int BATCH = 2, SEQ = 8192, D = 1024, M = BATCH * SEQ, FF = 3584, NE = 8, MEMT = 256, MROWS = BATCH * MEMT;
constexpr int N_SWA = 1536, N_RET = 2560, N_MLS = 2560, MLS_SRC = 2568;
constexpr int MAXSLOT = 2 * M + NE * 256;
constexpr int NPHASE = 32;
#ifndef DBL_MASK
#define DBL_MASK 0ull
#endif
#ifndef DBL_REPS
#define DBL_REPS 1
#endif
#define PROF_MASK 0ull
#define PROF_SEC -1
#define PROF_AMP 10
#define TB(id) do { if (PROF_SEC == (id)) C.pt0 = rt(); } while (0)
#define TE(id) do { if (PROF_SEC == (id)) C.pacc += rt() - C.pt0; } while (0)
#ifndef MK_SINGLE
#define MK_SINGLE 1
#endif
constexpr size_t MiB = 1u << 20, KiB = 1024;
constexpr size_t WS_CTL = 0, CTL_ZERO_BYTES = 32 * KiB;
constexpr size_t WS_SS = 1 * MiB, WS_MEMN = 2 * MiB, WS_MKV = 3 * MiB, WS_ROUTE = 5 * MiB;
constexpr size_t RT_SEL = 0, RT_RSTD = 256 * KiB, RT_CNT = 320 * KiB, RT_PANEL = 328 * KiB, RT_NP = 329 * KiB, RT_TOKSLOT = 384 * KiB, RT_ROWTOK = 512 * KiB, RT_SLOTRS = 704 * KiB, RT_TAILIDX = 896 * KiB, RT_GATES = 1 * MiB, RT_AUXG = 2304 * KiB;
constexpr size_t WS_WIN = 8 * MiB, WS_WOUT = 24 * MiB, WS_WMEM = 32 * MiB, WS_WFD = 36 * MiB, WS_WMOE = 78 * MiB;
constexpr size_t WIN_OFF[4] = {0, 3 * MiB, 8 * MiB, 13 * MiB};
constexpr size_t FD_STRIDE = 21 * MiB, FD_WD = 14 * MiB, MOE_STRIDE = 168 * MiB, MOE_WD = 112 * MiB;
constexpr size_t WS_HB = 414 * MiB, WS_BIG = 446 * MiB, WS_Y = 684 * MiB, WS_SLAB = 820 * MiB, WS_END = 876 * MiB;
constexpr size_t BIG_P = 0, BIG_MIX = 80 * MiB, BIG_SCR1 = 112 * MiB, BIG_SCR2 = 160 * MiB;
constexpr int CW_BAR = 4096;
constexpr int RING_OFF = 0, RING_BYTES = 163328;
constexpr int LDSCTL_OFF = RING_BYTES, MISC_OFF = LDSCTL_OFF + 320;
constexpr int LDS_BYTES = 163840;


#define GAS __attribute__((address_space(1)))
#define LAS __attribute__((address_space(3)))
typedef unsigned short bf16;
typedef unsigned v4u __attribute__((ext_vector_type(4)));
typedef float f32x4 __attribute__((ext_vector_type(4)));
typedef short bf16x8 __attribute__((ext_vector_type(8)));
typedef GAS unsigned gu32;
typedef GAS unsigned long long gu64;
#define RLX_AGENT __ATOMIC_RELAXED, __HIP_MEMORY_SCOPE_AGENT
#define LDS_WAIT() asm volatile("s_waitcnt lgkmcnt(0)" ::: "memory")
#define VM_WAIT() asm volatile("s_waitcnt vmcnt(0)" ::: "memory")
__device__ __forceinline__ unsigned long long rt() { return __builtin_amdgcn_s_memrealtime(); }
__device__ __forceinline__ unsigned f2bf(float f) { unsigned u = __builtin_bit_cast(unsigned, f); return (u + 0x7fffu + ((u >> 16) & 1u)) >> 16; }
__device__ __forceinline__ unsigned pk2(float lo, float hi) { return f2bf(lo) | (f2bf(hi) << 16); }

#define XB_TMO      128
#define XB_XCNT(j)  (256  + 64 * (j))
#define XB_XSUB(j)  (1280 + 64 * (j))
#define XB_XGEN(j)  (2304 + 64 * (j))
#define XB_TOP      3328
#define XB_TOPGEN   3392
#define XCD_BAR_WORDS 3456
#define XB_SPIN_CAP (1u << 18)

__device__ __forceinline__ unsigned xb_ld(unsigned* p)              { return __hip_atomic_load(p, __ATOMIC_RELAXED, __HIP_MEMORY_SCOPE_AGENT); }
__device__ __forceinline__ unsigned xb_add(unsigned* p, unsigned v) { return __hip_atomic_fetch_add(p, v, __ATOMIC_RELAXED, __HIP_MEMORY_SCOPE_AGENT); }
__device__ __forceinline__ unsigned xb_xcc_id() { return (unsigned)__builtin_amdgcn_s_getreg((3 << 11) | 20) & 0xFu; }
#define XB_SPIN(cond, bar) do { unsigned _sp = 0; while (cond) { __builtin_amdgcn_s_sleep(1); \
    if ((++_sp & 255u) == 0u) { if (xb_ld(&(bar)[XB_TMO])) break; if (_sp > XB_SPIN_CAP) { atomicAdd(&(bar)[XB_TMO], 1u); break; } } } } while (0)

struct XcdBarrier {
    unsigned* bar; unsigned x;
    volatile LAS unsigned* st;
};

__device__ __forceinline__ XcdBarrier xcd_barrier_post(unsigned* bar, volatile LAS unsigned* st) {
    XcdBarrier b; b.bar = bar; b.x = xb_xcc_id(); b.st = st;
    if (threadIdx.x == 0) (void)xb_add(&bar[XB_XCNT(b.x)], 1u);
    return b;
}
__device__ __forceinline__ void xcd_barrier_complete(unsigned* bar, unsigned x, unsigned& nloc, unsigned& nx) {
    const unsigned G = gridDim.x * gridDim.y * gridDim.z;
    unsigned sum, cnt, mine, sp = 0u;
    for (;;) {
        sum = 0u; cnt = 0u; mine = 0u;
#pragma unroll
        for (unsigned j = 0; j < 16; ++j) { const unsigned c = xb_ld(&bar[XB_XCNT(j)]); sum += c; cnt += (c > 0u) ? 1u : 0u; mine = (j == x) ? c : mine; }
        if (sum == G) break;
        __builtin_amdgcn_s_sleep(1);
        if ((++sp & 255u) == 0u) { if (xb_ld(&bar[XB_TMO])) break; if (sp > XB_SPIN_CAP) { atomicAdd(&bar[XB_TMO], 1u); break; } }
    }
    nloc = mine > 0u ? mine : 1u; nx = cnt > 0u ? cnt : 1u;
}

__device__ __forceinline__ void xcd_barrier(const XcdBarrier& b) {
    asm volatile("s_waitcnt vmcnt(0)" ::: "memory");
    __syncthreads();
    if (threadIdx.x == 0) {
        unsigned* bar = b.bar;
        __builtin_amdgcn_s_waitcnt(0);
        unsigned nloc = b.st[0], nx = b.st[1];
        if (nloc == 0u) { xcd_barrier_complete(bar, b.x, nloc, nx); b.st[0] = nloc; b.st[1] = nx; }
        const unsigned old = xb_add(&bar[XB_XSUB(b.x)], 1u);
        const unsigned gen = old / nloc;
        if (old + 1u == (gen + 1u) * nloc) {
            __builtin_amdgcn_fence(__ATOMIC_RELEASE, "agent");
            asm volatile("s_waitcnt vmcnt(0)" ::: "memory");
            const unsigned og = xb_add(&bar[XB_TOP], 1u);
            const unsigned tg = og / nx;
            if (og + 1u == (tg + 1u) * nx) xb_add(&bar[XB_TOPGEN], 1u);
            else XB_SPIN(xb_ld(&bar[XB_TOPGEN]) == tg, bar);
            __builtin_amdgcn_fence(__ATOMIC_ACQUIRE, "agent");
            xb_add(&bar[XB_XGEN(b.x)], 1u);
            asm volatile("s_waitcnt vmcnt(0)" ::: "memory");
        } else {
            XB_SPIN(xb_ld(&bar[XB_XGEN(b.x)]) == gen, bar);
            __builtin_amdgcn_fence(__ATOMIC_ACQUIRE, "agent");
            asm volatile("s_waitcnt vmcnt(0)" ::: "memory");
        }
    }
    __syncthreads();
}


typedef unsigned v2u __attribute__((ext_vector_type(2)));
__device__ __forceinline__ float bflo(unsigned w) { return __uint_as_float(w << 16); }
__device__ __forceinline__ float bfhi(unsigned w) { return __uint_as_float(w & 0xffff0000u); }
__device__ __forceinline__ float wave_sum(float v) {
#pragma unroll
    for (int o = 1; o < 64; o <<= 1) v += __shfl_xor(v, o);
    return v;
}
__device__ __forceinline__ float silu1(float x) { return x * __builtin_amdgcn_rcpf(1.0f + __expf(-x)); }
__device__ __forceinline__ float sigmoid1(float x) { return __builtin_amdgcn_rcpf(1.0f + __expf(-x)); }

struct Ctx {
    LAS unsigned char* lds;
    int tid, lane, wave, gw, NGW, G, bid;
    const float* in[27];
    float* out;
    unsigned char* ws;
    unsigned long long pacc, pt0;
};
#define WSP(T, off) ((T*)(C.ws + (off)))

__device__ __forceinline__ unsigned cvt2(float lo, float hi) { unsigned r; asm volatile("v_cvt_pk_bf16_f32 %0, %1, %2" : "=v"(r) : "v"(lo), "v"(hi)); return r; }
struct TpDesc { const float* W; bf16* WT; const float* gain; int ldw, K, csrc0, drow0, mode, kb, nb; };
__device__ __forceinline__ void tp_decode(Ctx& C, int tile, TpDesc& d) {
    constexpr int T_FFN = 54 * 224, T_IN = 512, T_OUT = 256;
    d.gain = nullptr; d.csrc0 = 0; d.drow0 = 0; d.mode = 0;
    if (tile < T_FFN) {
        const int job = tile / 224, r = tile % 224; int which;
        if (job < 6) { const int j = job / 3; which = job % 3; unsigned char* base = C.ws + WS_WFD + j * FD_STRIDE;
            if (which < 2) { d.W = (which == 0 ? C.in[20] : C.in[21]) + (size_t)j * D * FF; d.WT = (bf16*)base; d.gain = C.in[8] + (2 * j) * D; }
            else { d.W = C.in[22] + (size_t)j * FF * D; d.WT = (bf16*)(base + FD_WD); }
        } else { const int q = job - 6, j = q / 24, e = (q % 24) / 3; which = q % 3; unsigned char* base = C.ws + WS_WMOE + j * MOE_STRIDE;
            if (which < 2) { d.W = (which == 0 ? C.in[24] : C.in[25]) + (size_t)(j * NE + e) * D * FF; d.WT = (bf16*)base + (size_t)e * 7168 * D; d.gain = C.in[8] + (2 * j + 1) * D; }
            else { d.W = C.in[26] + (size_t)(j * NE + e) * FF * D; d.WT = (bf16*)(base + MOE_WD) + (size_t)e * D * FF; }
        }
        if (which < 2) { d.ldw = FF; d.K = D; d.drow0 = which ? 128 : 0; d.mode = 1; d.kb = r / 14; d.nb = r % 14; }
        else { d.ldw = D; d.K = FF; d.kb = r / 4; d.nb = r % 4; }
    } else if (tile < T_FFN + T_IN) {
        int r = tile - T_FFN; d.K = D;
        if (r < 96) { d.W = C.in[9]; d.ldw = N_SWA; d.WT = WSP(bf16, WS_WIN + WIN_OFF[0]); d.gain = C.in[2] + 0 * D; d.kb = r / 6; d.nb = r % 6; }
        else if ((r -= 96) < 160) { d.W = C.in[13]; d.ldw = N_RET; d.WT = WSP(bf16, WS_WIN + WIN_OFF[1]); d.gain = C.in[2] + 1 * D; d.kb = r / 10; d.nb = r % 10; }
        else if ((r -= 160) < 144) { d.W = C.in[14]; d.ldw = MLS_SRC; d.WT = WSP(bf16, WS_WIN + WIN_OFF[2]); d.gain = C.in[2] + 2 * D; d.kb = r / 9; d.nb = r % 9; }
        else if ((r -= 144) < 16) { d.W = C.in[14]; d.ldw = MLS_SRC; d.csrc0 = 2312; d.drow0 = 2304; d.WT = WSP(bf16, WS_WIN + WIN_OFF[2]); d.gain = C.in[2] + 2 * D; d.kb = r; d.nb = 0; }
        else { r -= 16; d.W = C.in[9] + (size_t)D * N_SWA; d.ldw = N_SWA; d.WT = WSP(bf16, WS_WIN + WIN_OFF[3]); d.gain = C.in[2] + 3 * D; d.kb = r / 6; d.nb = r % 6; }
    } else if (tile < T_FFN + T_IN + T_OUT) {
        const int r = tile - T_FFN - T_IN, l = r >> 6, q = r & 63;
        d.W = C.in[7] + (size_t)l * D * D; d.ldw = D; d.K = D; d.WT = WSP(bf16, WS_WOUT + (size_t)l * 2 * MiB); d.kb = q >> 2; d.nb = q & 3;
    } else {
        const int r = tile - T_FFN - T_IN - T_OUT, l = r >> 5, q = r & 31;
        d.W = C.in[4] + (size_t)l * D * 512; d.ldw = 512; d.K = D; d.WT = WSP(bf16, WS_WMEM); d.drow0 = 512 * l; d.gain = C.in[3] + l * D; d.kb = q >> 1; d.nb = q & 1;
    }
}
__device__ __forceinline__ void tp_load(Ctx& C, const TpDesc& d, f32x4 (&v)[8], f32x4 (&gn)[2]) {
    const int k0 = d.kb * 64 + 8 * C.wave, n = d.nb * 256 + 4 * C.lane;
    if (d.gain) { gn[0] = *(const GAS f32x4*)(d.gain + k0); gn[1] = *(const GAS f32x4*)(d.gain + k0 + 4); }
#pragma unroll
    for (int kk = 0; kk < 8; ++kk) v[kk] = __builtin_nontemporal_load((const GAS f32x4*)(d.W + (size_t)(k0 + kk) * d.ldw + d.csrc0 + n));
}
constexpr int TP_ALL = 54 * 224 + 512 + 256 + 128;
constexpr int TP_WIN_N = 768, TP_MOVED_LO = 30 * 224, TP_MOVED_N = 3 * TP_WIN_N;
__device__ __forceinline__ void tp_run(Ctx& C, int first, int stride, int count, int skip_lo, int skip_len) {
    constexpr int TP_LD = 144, TP_BUF = 256 * TP_LD;
    TpDesc da, db; f32x4 va[8], vb[8], ga[2], gb[2]; int buf = 0;
    int tile = first;
    __syncthreads();
    if (tile < count) { tp_decode(C, tile >= skip_lo ? tile + skip_len : tile, da); tp_load(C, da, va, ga); }
    if (tile + stride < count) { const int t1 = tile + stride; tp_decode(C, t1 >= skip_lo ? t1 + skip_len : t1, db); tp_load(C, db, vb, gb); }
#define TP_STEP(d, v, gn) { LAS unsigned char* Lb = C.lds + RING_OFF + buf * TP_BUF; \
        if (d.gain) { _Pragma("unroll") for (int kk = 0; kk < 8; ++kk) v[kk] = v[kk] * gn[kk >> 2][kk & 3]; } \
        _Pragma("unroll") for (int c = 0; c < 4; ++c) { v4u o; o.x = cvt2(v[0][c], v[1][c]); o.y = cvt2(v[2][c], v[3][c]); o.z = cvt2(v[4][c], v[5][c]); o.w = cvt2(v[6][c], v[7][c]); \
            *(LAS v4u*)(Lb + (4 * C.lane + c) * TP_LD + 16 * C.wave) = o; } \
        const TpDesc dc = d; const int nx = tile + 2 * stride; \
        if (nx < count) { tp_decode(C, nx >= skip_lo ? nx + skip_len : nx, d); tp_load(C, d, v, gn); } \
        __syncthreads(); \
        _Pragma("unroll") for (int q = 0; q < 4; ++q) { const int id = C.tid + 512 * q, row = id >> 3, pc = id & 7; const int n = dc.nb * 256 + row; \
            const int drow = dc.mode ? dc.drow0 + (n >> 7) * 256 + (n & 127) : dc.drow0 + n; \
            *(GAS v4u*)(dc.WT + (size_t)drow * dc.K + dc.kb * 64 + 8 * pc) = *(const LAS v4u*)(Lb + row * TP_LD + 16 * pc); } \
        tile += stride; buf ^= 1; }
    while (tile < count) { TP_STEP(da, va, ga) if (tile >= count) break; TP_STEP(db, vb, gb) }
#undef TP_STEP
    __syncthreads();
}
__device__ __forceinline__ void p_prologue(Ctx& C) {
    if (C.G == 256) tp_run(C, C.bid, C.G, TP_ALL - TP_MOVED_N, TP_MOVED_LO, TP_MOVED_N); else tp_run(C, C.bid, C.G, TP_ALL, 1 << 30, 0);
    for (int m0 = C.gw; m0 < M; m0 += 4 * C.NGW) {
        f32x4 xv[4][4];
#pragma unroll
        for (int u = 0; u < 4; ++u) { const int m = m0 + u * C.NGW; if (m < M) { const GAS f32x4* xr = (const GAS f32x4*)(C.in[0] + (size_t)m * D) + C.lane;
#pragma unroll
            for (int j = 0; j < 4; ++j) xv[u][j] = __builtin_nontemporal_load(xr + 64 * j); } }
#pragma unroll
        for (int u = 0; u < 4; ++u) { const int m = m0 + u * C.NGW; if (m < M) {
            GAS unsigned long long* o8 = (GAS unsigned long long*)(WSP(bf16, WS_HB) + (size_t)m * D) + C.lane; float s = 0.f;
#pragma unroll
            for (int j = 0; j < 4; ++j) { const f32x4 v = xv[u][j]; s += (v.x * v.x + v.y * v.y) + (v.z * v.z + v.w * v.w);
                o8[64 * j] = (unsigned long long)pk2(v.x, v.y) | ((unsigned long long)pk2(v.z, v.w) << 32); }
            s = wave_sum(s);
            if (C.lane < 4) WSP(float, WS_SS)[(size_t)m * 4 + C.lane] = C.lane == 0 ? s : 0.f; } }
    }
    for (int m = C.gw; m < MROWS; m += C.NGW) {
        const GAS f32x4* xr = (const GAS f32x4*)(C.in[1] + (size_t)m * D) + C.lane; f32x4 v[4]; float s = 0.f;
#pragma unroll
        for (int j = 0; j < 4; ++j) { v[j] = xr[64 * j]; s += (v[j].x * v[j].x + v[j].y * v[j].y) + (v[j].z * v[j].z + v[j].w * v[j].w); }
        const float rs = 1.0f / sqrtf(wave_sum(s) * (1.0f / D) + 1e-6f);
        GAS unsigned long long* o8 = (GAS unsigned long long*)(WSP(bf16, WS_MEMN) + (size_t)m * D) + C.lane;
#pragma unroll
        for (int j = 0; j < 4; ++j) o8[64 * j] = (unsigned long long)pk2(v[j].x * rs, v[j].y * rs) | ((unsigned long long)pk2(v[j].z * rs, v[j].w * rs) << 32);
    }
}

__device__ __forceinline__ void ld8(const bf16* p, float (&f)[8]) { const v4u w = *(const GAS v4u*)p; f[0] = bflo(w.x); f[1] = bfhi(w.x); f[2] = bflo(w.y); f[3] = bfhi(w.y); f[4] = bflo(w.z); f[5] = bfhi(w.z); f[6] = bflo(w.w); f[7] = bfhi(w.w); }
__device__ __forceinline__ void load_w8(const float* gain, const float* W, int ldw, int c0, int lane, float (&RW)[16][8]) {
#pragma unroll
    for (int j = 0; j < 2; ++j)
#pragma unroll
        for (int i = 0; i < 8; ++i) { const int k = 8 * lane + 512 * j + i; const float gk = gain[k]; const float* wp = W + (size_t)k * ldw + c0;
#pragma unroll
            for (int e = 0; e < 8; ++e) RW[j * 8 + i][e] = gk * wp[e]; }
}
__device__ __forceinline__ void dots8(const bf16* hrow, const float (&RW)[16][8], int lane, float (&out)[8], float& rstd) {
    float acc[8]; float ss = 0.f;
#pragma unroll
    for (int e = 0; e < 8; ++e) acc[e] = 0.f;
#pragma unroll
    for (int j = 0; j < 2; ++j) { float hv[8]; ld8(hrow + 8 * lane + 512 * j, hv);
#pragma unroll
        for (int i = 0; i < 8; ++i) { ss += hv[i] * hv[i];
#pragma unroll
            for (int e = 0; e < 8; ++e) acc[e] += hv[i] * RW[j * 8 + i][e]; } }
    rstd = 1.0f / sqrtf(wave_sum(ss) * (1.0f / D) + 1e-6f);
#pragma unroll
    for (int e = 0; e < 8; ++e) out[e] = wave_sum(acc[e]) * rstd;
}
__device__ __forceinline__ void dots8_x4(Ctx& C, int m0, const float (&RW)[16][8], float& val, float& rs) {
    const int lane = C.lane; v4u raw[4][2];
#pragma unroll
    for (int t = 0; t < 4; ++t) { const bf16* hrow = WSP(bf16, WS_HB) + (size_t)(m0 + t) * D; raw[t][0] = *(const GAS v4u*)(hrow + 8 * lane); raw[t][1] = *(const GAS v4u*)(hrow + 8 * lane + 512); }
    float acc[32], ss[4];
#pragma unroll
    for (int t = 0; t < 4; ++t) { ss[t] = 0.f;
#pragma unroll
        for (int e = 0; e < 8; ++e) acc[t * 8 + e] = 0.f;
#pragma unroll
        for (int jj = 0; jj < 2; ++jj) { const v4u w = raw[t][jj]; const float hv[8] = {bflo(w.x), bfhi(w.x), bflo(w.y), bfhi(w.y), bflo(w.z), bfhi(w.z), bflo(w.w), bfhi(w.w)};
#pragma unroll
            for (int i = 0; i < 8; ++i) { ss[t] += hv[i] * hv[i];
#pragma unroll
                for (int e = 0; e < 8; ++e) acc[t * 8 + e] += hv[i] * RW[jj * 8 + i][e]; } } }
#pragma unroll
    for (int s = 0; s < 5; ++s) { const int d = 1 << s, hn = 16 >> s; const bool up = (lane & d) != 0;
#pragma unroll
        for (int q = 0; q < hn; ++q) { const float send = up ? acc[q] : acc[q + hn], keep = up ? acc[q + hn] : acc[q]; acc[q] = keep + __shfl_xor(send, d); } }
    const float lsum = acc[0] + __shfl_xor(acc[0], 32);
    { const bool up0 = (lane & 1) != 0; const float s0 = (up0 ? ss[2] : ss[0]) + __shfl_xor(up0 ? ss[0] : ss[2], 1), s1 = (up0 ? ss[3] : ss[1]) + __shfl_xor(up0 ? ss[1] : ss[3], 1);
      const bool up1 = (lane & 2) != 0; ss[0] = (up1 ? s1 : s0) + __shfl_xor(up1 ? s0 : s1, 2); }
    float sst = ss[0];
#pragma unroll
    for (int d = 4; d < 64; d <<= 1) sst += __shfl_xor(sst, d);
    rs = 1.0f / sqrtf(sst * (1.0f / D) + 1e-6f); val = lsum * rs;
}
__device__ __forceinline__ void mls_gates(Ctx& C) {
    const bool half = (C.G == 256); if (half && C.bid < 128) return;
    const int gw = half ? (C.bid - 128) * NWAVES + C.wave : C.gw, ngw = half ? 128 * NWAVES : C.NGW;
    float* GT = WSP(float, WS_ROUTE + RT_GATES); float RW[16][8];
    load_w8(C.in[2] + 2 * D, C.in[14], MLS_SRC, 2304, C.lane, RW);
    const int tk = ((C.lane & 1) << 1) | ((C.lane >> 1) & 1), ex = (((C.lane >> 2) & 1) << 2) | (((C.lane >> 3) & 1) << 1) | ((C.lane >> 4) & 1);
    for (int m0 = 4 * gw; m0 < M; m0 += 4 * ngw) { float val, rs; dots8_x4(C, m0, RW, val, rs);
        if (C.lane < 32) GT[(size_t)(m0 + tk) * 8 + ex] = val; }
}
__device__ __forceinline__ void mls_conv(Ctx& C, const bf16* P, bf16* QKC) {
    const float* cw = C.in[15]; const float* cb = C.in[16];
    const int nthr = C.G * NWAVES * 64, gt = C.bid * NWAVES * 64 + C.tid;
    for (int e = gt; e < (M / 16) * 96; e += nthr) { const int seg = e / 96, c0 = (e % 96) * 8, m0 = seg * 16; const bool first = (m0 & (SEQ - 1)) == 0;
        v4u raw[19];
#pragma unroll
        for (int r = 0; r < 19; ++r) { if (r >= 3 || !first) raw[r] = *(const GAS v4u*)(P + (size_t)(m0 - 3 + r) * N_MLS + c0); else raw[r] = (v4u){0u, 0u, 0u, 0u}; }
        float wv[4][8], bv[8];
#pragma unroll
        for (int j = 0; j < 4; ++j) { const f32x4 a = *(const GAS f32x4*)(cw + j * 768 + c0), b2 = *(const GAS f32x4*)(cw + j * 768 + c0 + 4);
            wv[j][0] = a.x; wv[j][1] = a.y; wv[j][2] = a.z; wv[j][3] = a.w; wv[j][4] = b2.x; wv[j][5] = b2.y; wv[j][6] = b2.z; wv[j][7] = b2.w; }
        { const f32x4 a = *(const GAS f32x4*)(cb + c0), b2 = *(const GAS f32x4*)(cb + c0 + 4); bv[0] = a.x; bv[1] = a.y; bv[2] = a.z; bv[3] = a.w; bv[4] = b2.x; bv[5] = b2.y; bv[6] = b2.z; bv[7] = b2.w; }
        const float sc = c0 >= 384 ? 0.10206207261596577f : 1.0f;
#pragma unroll
        for (int r = 0; r < 16; ++r) { float acc[8];
#pragma unroll
            for (int i = 0; i < 8; ++i) acc[i] = bv[i];
#pragma unroll
            for (int j = 0; j < 4; ++j) { const v4u w = raw[r + j]; const float x[8] = {bflo(w.x), bfhi(w.x), bflo(w.y), bfhi(w.y), bflo(w.z), bfhi(w.z), bflo(w.w), bfhi(w.w)};
#pragma unroll
                for (int i = 0; i < 8; ++i) acc[i] += wv[j][i] * x[i]; }
#pragma unroll
            for (int i = 0; i < 8; ++i) acc[i] = silu1(acc[i]) * sc;
            v4u o; o.x = pk2(acc[0], acc[1]); o.y = pk2(acc[2], acc[3]); o.z = pk2(acc[4], acc[5]); o.w = pk2(acc[6], acc[7]);
            *(GAS v4u*)(QKC + (size_t)(m0 + r) * 768 + c0) = o; }
    }
}
__device__ __forceinline__ bool r1_better(float va, int ea, float vb, int eb) { return va > vb || (va == vb && ea < eb); }
__device__ __forceinline__ void moe_route1(Ctx& C, int j, int layer) {
    f32x4* SEL = WSP(f32x4, WS_ROUTE + RT_SEL); float* RSTD = WSP(float, WS_ROUTE + RT_RSTD); int* CNT = WSP(int, WS_ROUTE + RT_CNT);
    LAS int* lc = (LAS int*)(C.lds + RING_OFF); float RW[16][8]; const int lane = C.lane;
    load_w8(C.in[8] + layer * D, C.in[23] + (size_t)j * D * NE, NE, 0, lane, RW);
    for (int chunk = C.bid; chunk < M / 64; chunk += C.G) {
        __syncthreads();
        if (C.tid < 8) lc[C.tid] = 0;
        __syncthreads();
#pragma unroll 1
        for (int grp = 0; grp < 2; ++grp) {
            const int m0 = chunk * 64 + C.wave * 8 + grp * 4;
            float lval, rs; dots8_x4(C, m0, RW, lval, rs);
            const int tk = ((lane & 1) << 1) | ((lane >> 1) & 1), ex = (((lane >> 2) & 1) << 2) | (((lane >> 3) & 1) << 1) | ((lane >> 4) & 1);
            float v1 = lval, v2 = -3.0e38f; int e1 = ex, e2 = 8;
#pragma unroll
            for (int d = 4; d <= 16; d <<= 1) { const float pv1 = __shfl_xor(v1, d), pv2 = __shfl_xor(v2, d); const int pe1 = __shfl_xor(e1, d), pe2 = __shfl_xor(e2, d);
                float n1, n2; int f1, f2;
                if (r1_better(v1, e1, pv1, pe1)) { n1 = v1; f1 = e1; if (r1_better(v2, e2, pv1, pe1)) { n2 = v2; f2 = e2; } else { n2 = pv1; f2 = pe1; } }
                else { n1 = pv1; f1 = pe1; if (r1_better(v1, e1, pv2, pe2)) { n2 = v1; f2 = e1; } else { n2 = pv2; f2 = pe2; } }
                v1 = n1; e1 = f1; v2 = n2; e2 = f2; }
            if (lane < 4) { const int mm = m0 + tk; const float w1 = 1.0f / (1.0f + __expf(v2 - v1)), w2 = 1.0f - w1;
                f32x4 s; s.x = __int_as_float(e1); s.y = __int_as_float(e2); s.z = w1; s.w = w2; SEL[mm] = s; RSTD[mm] = rs; atomicAdd((int*)&lc[e1], 1); atomicAdd((int*)&lc[e2], 1); }
        }
        __syncthreads();
        if (C.tid < 8) CNT[chunk * 8 + C.tid] = lc[C.tid];
    }
}
__device__ __forceinline__ void moe_route2(Ctx& C) {
    const f32x4* SEL = WSP(f32x4, WS_ROUTE + RT_SEL); const float* RSTD = WSP(float, WS_ROUTE + RT_RSTD); const int* CNT = WSP(int, WS_ROUTE + RT_CNT);
    int* PANEL = WSP(int, WS_ROUTE + RT_PANEL); int* NP = WSP(int, WS_ROUTE + RT_NP); int* TOKSLOT = WSP(int, WS_ROUTE + RT_TOKSLOT); float* SLOTRS = WSP(float, WS_ROUTE + RT_SLOTRS); int* ROWTOK = WSP(int, WS_ROUTE + RT_ROWTOK);
    if (C.wave != 0) return;
    for (int chunk = C.bid; chunk < M / 64; chunk += C.G) {
        const int e = C.lane & 7, sub = C.lane >> 3; int tot = 0, pre = 0;
        const int mtok = chunk * 64 + C.lane; const f32x4 stok = SEL[mtok]; const float rstok = RSTD[mtok];
        int cv[32];
#pragma unroll
        for (int q = 0; q < 32; ++q) cv[q] = CNT[(sub + 8 * q) * 8 + e];
#pragma unroll
        for (int q = 0; q < 32; ++q) { tot += cv[q]; pre += (sub + 8 * q < chunk) ? cv[q] : 0; }
        tot += __shfl_xor(tot, 8); tot += __shfl_xor(tot, 16); tot += __shfl_xor(tot, 32);
        pre += __shfl_xor(pre, 8); pre += __shfl_xor(pre, 16); pre += __shfl_xor(pre, 32);
        const int np = (tot + 255) >> 8; int pstart = 0;
#pragma unroll
        for (int k = 0; k < 8; ++k) { const int v = __shfl(np, k); pstart += (k < e) ? v : 0; }
        const int mybase = pstart * 256 + pre;
        if (chunk == 0) { int* TAILIDX = WSP(int, WS_ROUTE + RT_TAILIDX); for (int q = C.lane; q < 576; q += 64) TAILIDX[q] = -1;
            if (C.lane < 8) { for (int p = 0; p < np; ++p) PANEL[pstart + p] = e; if (e == 7) NP[0] = pstart + np; }
            for (int sl = pstart * 256 + tot + sub; sl < (pstart + np) * 256; sl += 8) { ROWTOK[sl] = 0; SLOTRS[sl] = 0.f; } }
        const int m = mtok; const f32x4 s = stok; const int e1 = __float_as_int(s.x), e2 = __float_as_int(s.y);
        const unsigned long long lt = (1ull << C.lane) - 1ull; int s1 = 0, s2 = 0;
#pragma unroll
        for (int ee = 0; ee < 8; ++ee) { const unsigned long long both = __ballot(e1 == ee) | __ballot(e2 == ee); const int r = __popcll(both & lt); const int be = __shfl(mybase, ee);
            if (e1 == ee) s1 = be + r; if (e2 == ee) s2 = be + r; }
        TOKSLOT[2 * m] = s1; TOKSLOT[2 * m + 1] = s2; const float rs = rstok; SLOTRS[s1] = rs; SLOTRS[s2] = rs; ROWTOK[s1] = m; ROWTOK[s2] = m;
    }
}
struct CombRow { unsigned long long hw[4]; v2u y1[4], y2[4]; };
__device__ __forceinline__ f32x4 slab_sum(const float* SLAB, int tl, int slot, int lane) {
    const float* sp = SLAB + (size_t)tl * 7 * 65536 + (size_t)(slot & 255) * 256 + 4 * lane; f32x4 a = *(const GAS f32x4*)sp;
#pragma unroll
    for (int k = 1; k < 7; ++k) a = a + *(const GAS f32x4*)(sp + (size_t)k * 65536);
    return a;
}
template <bool FINAL>
__device__ __forceinline__ void moe_combine(Ctx& C) {
    const f32x4* SEL = WSP(f32x4, WS_ROUTE + RT_SEL); const int* TOKSLOT = WSP(int, WS_ROUTE + RT_TOKSLOT); const bf16* Y = WSP(bf16, WS_Y);
    const float* SLAB = WSP(float, WS_SLAB); const int* TAILIDX = WSP(int, WS_ROUTE + RT_TAILIDX); const int lane = C.lane;
    typedef int i32x4 __attribute__((ext_vector_type(4)));
    for (int base = C.gw; base < M; base += 8 * C.NGW) {
        const int mrow = base + (lane & 7) * C.NGW; const bool okl = mrow < M; const int mr = okl ? mrow : base;
        const f32x4 sel = SEL[mr]; const int s1l = TOKSLOT[2 * mr], s2l = TOKSLOT[2 * mr + 1];
        const i32x4 t1l = *(const GAS i32x4*)(TAILIDX + (s1l >> 8) * 4), t2l = *(const GAS i32x4*)(TAILIDX + (s2l >> 8) * 4);
#pragma unroll
        for (int k0 = 0; k0 < 8; k0 += 2) {
            CombRow R[2]; int mm[2], s1[2], s2[2], tl1[2][4], tl2[2][4]; float w1[2], w2[2]; bool ok[2];
#pragma unroll
            for (int u = 0; u < 2; ++u) { const int k = k0 + u; mm[u] = base + k * C.NGW; ok[u] = mm[u] < M;
                s1[u] = __shfl(s1l, k); s2[u] = __shfl(s2l, k); w1[u] = __shfl(sel.z, k); w2[u] = __shfl(sel.w, k);
#pragma unroll
                for (int jj = 0; jj < 4; ++jj) { tl1[u][jj] = __shfl(t1l[jj], k); tl2[u][jj] = __shfl(t2l[jj], k); }
                if (ok[u]) { const GAS unsigned long long* o8 = (const GAS unsigned long long*)(WSP(bf16, WS_HB) + (size_t)mm[u] * D) + lane;
#pragma unroll
                    for (int jj = 0; jj < 4; ++jj) { R[u].hw[jj] = o8[64 * jj];
                        R[u].y1[jj] = tl1[u][jj] < 0 ? *(const GAS v2u*)(Y + (size_t)s1[u] * D + 256 * jj + 4 * lane) : (v2u){0u, 0u};
                        R[u].y2[jj] = tl2[u][jj] < 0 ? *(const GAS v2u*)(Y + (size_t)s2[u] * D + 256 * jj + 4 * lane) : (v2u){0u, 0u}; } } }
#pragma unroll
            for (int u = 0; u < 2; ++u) if (ok[u]) {
                GAS unsigned long long* o8 = (GAS unsigned long long*)(WSP(bf16, WS_HB) + (size_t)mm[u] * D) + lane; float ss = 0.f;
#pragma unroll
                for (int jj = 0; jj < 4; ++jj) { const unsigned lo = (unsigned)R[u].hw[jj], hi = (unsigned)(R[u].hw[jj] >> 32);
                    f32x4 v = (f32x4){bflo(lo), bfhi(lo), bflo(hi), bfhi(hi)};
                    f32x4 a = (f32x4){bflo(R[u].y1[jj].x), bfhi(R[u].y1[jj].x), bflo(R[u].y1[jj].y), bfhi(R[u].y1[jj].y)}; if (tl1[u][jj] >= 0) a = slab_sum(SLAB, tl1[u][jj], s1[u], lane);
                    f32x4 b2 = (f32x4){bflo(R[u].y2[jj].x), bfhi(R[u].y2[jj].x), bflo(R[u].y2[jj].y), bfhi(R[u].y2[jj].y)}; if (tl2[u][jj] >= 0) b2 = slab_sum(SLAB, tl2[u][jj], s2[u], lane);
                    v = v + (a * w1[u] + b2 * w2[u]);
                    if (FINAL) { ((GAS f32x4*)(C.out + (size_t)mm[u] * D) + lane)[64 * jj] = v; }
                    else { ss += (v.x * v.x + v.y * v.y) + (v.z * v.z + v.w * v.w); o8[64 * jj] = (unsigned long long)pk2(v.x, v.y) | ((unsigned long long)pk2(v.z, v.w) << 32); } }
                if (!FINAL) { ss = wave_sum(ss); if (lane < 4) WSP(float, WS_SS)[(size_t)mm[u] * 4 + lane] = lane == 0 ? ss : 0.f; } }
        }
    }
}

template <class Sched> __device__ __forceinline__ const LAS float* rstd_table(Ctx& C, const Sched& S, const float* SS) {
    LAS float* tab = (LAS float*)(C.lds + 131072 + 4096);
    pg8::Unit u0, u; bool one = S.next(0, u0);
    for (int i = 1; one && S.next(i, u); ++i) one = (u.pm == u0.pm);
    __syncthreads();
    if (one && C.tid < 256) tab[C.tid] = pg8::row_rstd16(SS, u0.pm * 256 + C.tid);
    __syncthreads();
    return one ? tab : nullptr;
}
typedef short v4i16_t __attribute__((ext_vector_type(4)));
typedef const LAS unsigned char* ldsc;
__device__ __forceinline__ bf16x8 frag_rows(ldsc base, int ld, int row0, int kbyte0, int i, int g) { return *(const LAS bf16x8*)(base + (row0 + i) * ld + kbyte0 + 16 * g); }
__device__ __forceinline__ bf16x8 frag_tr(ldsc base, int ld, int k0, int nbyte0, int i, int g, bool perm) {
    const int q = i >> 2, p = i & 3;
    ldsc p1 = base + (k0 + (perm ? 4 * g : 8 * g) + q) * ld + nbyte0 + 8 * p; ldsc p2 = p1 + (perm ? 16 : 4) * ld;
    const v4i16_t a = __builtin_amdgcn_ds_read_tr16_b64_v4i16((LAS v4i16_t*)p1), b = __builtin_amdgcn_ds_read_tr16_b64_v4i16((LAS v4i16_t*)p2);
    return (bf16x8){a[0], a[1], a[2], a[3], b[0], b[1], b[2], b[3]};
}
__device__ __forceinline__ unsigned cvtpk(float lo, float hi) { unsigned r; asm volatile("v_cvt_pk_bf16_f32 %0, %1, %2" : "=v"(r) : "v"(lo), "v"(hi)); return r; }
__device__ __forceinline__ bf16x8 pack_acc2(const f32x4& t0, const f32x4& t1) {
    v4u w; w.x = cvtpk(t0[0], t0[1]); w.y = cvtpk(t0[2], t0[3]); w.z = cvtpk(t1[0], t1[1]); w.w = cvtpk(t1[2], t1[3]); return __builtin_bit_cast(bf16x8, w);
}
#define MFMA16(a, b, c) __builtin_amdgcn_mfma_f32_16x16x32_bf16(a, b, c, 0, 0, 0)
__device__ __forceinline__ void st8_lds(LAS unsigned char* p, const float (&f)[8]) { v4u w; w.x = cvtpk(f[0], f[1]); w.y = cvtpk(f[2], f[3]); w.z = cvtpk(f[4], f[5]); w.w = cvtpk(f[6], f[7]); *(LAS v4u*)p = w; }

constexpr int AT_LD = 144, AT_K = 0, AT_V = 256 * AT_LD, AT_Q = 2 * 256 * AT_LD;
struct AttnKV { v4u k[4], v[4]; };
template <int QIT> struct AttnQ { v4u q[QIT][4]; };
__device__ __forceinline__ void attn_ld_kv(AttnKV& R, const bf16* Kb, long krow0, int ldk, int kcol, int vcol, bool ok, int t) {
    const int row = t >> 1, half = t & 1;
#pragma unroll
    for (int c = 0; c < 4; ++c) { if (ok) { R.k[c] = *(const GAS v4u*)(Kb + (size_t)(krow0 + row) * ldk + kcol + half * 32 + c * 8); R.v[c] = *(const GAS v4u*)(Kb + (size_t)(krow0 + row) * ldk + vcol + half * 32 + c * 8); }
        else { R.k[c] = (v4u){0u, 0u, 0u, 0u}; R.v[c] = (v4u){0u, 0u, 0u, 0u}; } }
}
template <int NQH, bool SWA>
__device__ __forceinline__ void attn_ld_q(AttnQ<(NQH * 256 + 511) / 512>& R, const bf16* P, int ldp, long tok0, int qcol, int hh, int t) {
    constexpr int QIT = (NQH * 256 + 511) / 512;
#pragma unroll
    for (int it = 0; it < QIT; ++it) { const int hr = t + 512 * it; if (hr < NQH * 256) { const int qrow = hr >> 1, qhalf = hr & 1, qh = qrow >> 7, r = qrow & 127; const int hq = SWA ? hh * 3 + qh : hh;
#pragma unroll
        for (int c = 0; c < 4; ++c) R.q[it][c] = *(const GAS v4u*)(P + (size_t)(tok0 + r) * ldp + qcol + hq * 64 + qhalf * 32 + c * 8); } }
}
__device__ __forceinline__ void attn_st_kv(const AttnKV& R, LAS unsigned char* L, const float (&kg)[32], int t) {
    const int row = t >> 1, half = t & 1; float ss = 0.f; float kf[4][8];
#pragma unroll
    for (int c = 0; c < 4; ++c) { const v4u w4 = R.k[c]; kf[c][0] = bflo(w4.x); kf[c][1] = bfhi(w4.x); kf[c][2] = bflo(w4.y); kf[c][3] = bfhi(w4.y); kf[c][4] = bflo(w4.z); kf[c][5] = bfhi(w4.z); kf[c][6] = bflo(w4.w); kf[c][7] = bfhi(w4.w);
#pragma unroll
        for (int j = 0; j < 8; ++j) ss += kf[c][j] * kf[c][j]; }
    ss += __shfl_xor(ss, 1);
    const float rs = __builtin_amdgcn_rsqf(ss * (1.0f / 64.0f) + 1e-6f);
#pragma unroll
    for (int c = 0; c < 4; ++c) {
#pragma unroll
        for (int j = 0; j < 8; ++j) kf[c][j] = kf[c][j] * rs * kg[c * 8 + j];
        st8_lds(L + AT_K + row * AT_LD + half * 64 + c * 16, kf[c]); *(LAS v4u*)(L + AT_V + row * AT_LD + half * 64 + c * 16) = R.v[c]; }
}
template <int NQH>
__device__ __forceinline__ void attn_st_q(const AttnQ<(NQH * 256 + 511) / 512>& R, LAS unsigned char* L, const float (&qg)[32], int t) {
    constexpr int QIT = (NQH * 256 + 511) / 512;
#pragma unroll
    for (int it = 0; it < QIT; ++it) { const int hr = t + 512 * it; if (hr < NQH * 256) { const int qrow = hr >> 1, qhalf = hr & 1;
        float ss = 0.f; float qf[4][8];
#pragma unroll
        for (int c = 0; c < 4; ++c) { const v4u w4 = R.q[it][c]; qf[c][0] = bflo(w4.x); qf[c][1] = bfhi(w4.x); qf[c][2] = bflo(w4.y); qf[c][3] = bfhi(w4.y); qf[c][4] = bflo(w4.z); qf[c][5] = bfhi(w4.z); qf[c][6] = bflo(w4.w); qf[c][7] = bfhi(w4.w);
#pragma unroll
            for (int j = 0; j < 8; ++j) ss += qf[c][j] * qf[c][j]; }
        ss += __shfl_xor(ss, 1);
        const float rs = 0.18033688011112042f * __builtin_amdgcn_rsqf(ss * (1.0f / 64.0f) + 1e-6f);
#pragma unroll
        for (int c = 0; c < 4; ++c) {
#pragma unroll
            for (int j = 0; j < 8; ++j) qf[c][j] = qf[c][j] * rs * qg[c * 8 + j];
            st8_lds(L + AT_Q + qrow * AT_LD + qhalf * 64 + c * 16, qf[c]); } } }
}
template <bool SWA>
__device__ __forceinline__ void attn_compute(Ctx& C, int hh, long tok0, bool prev_valid, const float* sink, bf16* MIX) {
    LAS unsigned char* L = C.lds + RING_OFF;
    const int lane = C.lane, w = C.wave, i = lane & 15, g = lane >> 4;
    constexpr int NQH = SWA ? 3 : 1, NT = SWA ? 10 : 16;
    const int t0 = SWA ? w : 0;
#pragma unroll 1
    for (int qh = 0; qh < NQH; ++qh) {
        const int hq = SWA ? hh * 3 + qh : hh;
        const bf16x8 q0 = frag_rows(L + AT_Q, AT_LD, qh * 128 + 16 * w, 0, i, g), q1 = frag_rows(L + AT_Q, AT_LD, qh * 128 + 16 * w, 64, i, g);
        const float slope = SWA ? exp2f(-8.0f * (float)(hq + 1) / 12.0f) * 1.4426950408889634f : 0.f;
        const float sg = slope * (float)(4 * g);
        f32x4 s[NT];
#pragma unroll
        for (int tt = 0; tt < NT; ++tt) { const int kt = (t0 + tt) > 15 ? 15 : (t0 + tt);
            s[tt] = (f32x4){0.f, 0.f, 0.f, 0.f};
            if (SWA && tt == NT - 1) continue;
            s[tt] = MFMA16(frag_rows(L + AT_K, AT_LD, 16 * kt, 0, i, g), q0, ((f32x4){sg, sg, sg, sg}));
            s[tt] = MFMA16(frag_rows(L + AT_K, AT_LD, 16 * kt, 64, i, g), q1, s[tt]); }
        const int dq = i - 4 * g;
        const float sk = SWA ? fmaf(slope, (float)(128 + i), sink[hq] * 1.4426950408889634f) : 0.f;
        float mx = SWA ? sk : -1e30f;
        constexpr int NTV = SWA ? NT - 1 : NT;
        if (SWA) {
#pragma unroll
            for (int tt = 0; tt < NTV; ++tt)
#pragma unroll
                for (int r = 0; r < 4; ++r) { const float b = fmaf(slope, (float)(16 * tt + r), s[tt][r]);
                    s[tt][r] = (tt == 0) ? (r > dq ? b : -1e30f) : (tt == NTV - 1) ? (r <= dq ? b : -1e30f) : b; }
            if (!prev_valid) {
#pragma unroll
                for (int tt = 0; tt < NTV; ++tt)
#pragma unroll
                    for (int r = 0; r < 4; ++r) { if (16 * (t0 + tt) + 4 * g + r < 128) s[tt][r] = -1e30f; } }
        }
#pragma unroll
        for (int tt = 0; tt < NTV; ++tt) mx = fmaxf(mx, fmaxf(fmaxf(s[tt][0], s[tt][1]), fmaxf(s[tt][2], s[tt][3])));
        mx = fmaxf(mx, __shfl_xor(mx, 16)); mx = fmaxf(mx, __shfl_xor(mx, 32));
        typedef float f32x2_t __attribute__((ext_vector_type(2)));
        f32x2_t l2 = (f32x2_t){0.f, 0.f};
#pragma unroll
        for (int tt = 0; tt < NTV; ++tt) {
#pragma unroll
            for (int r = 0; r < 4; ++r) s[tt][r] = __builtin_amdgcn_exp2f(s[tt][r] - mx);
            l2 += (f32x2_t){s[tt][0], s[tt][1]}; l2 += (f32x2_t){s[tt][2], s[tt][3]}; }
        float l = l2.x + l2.y;
        l += __shfl_xor(l, 16); l += __shfl_xor(l, 32);
        if (SWA) l += __builtin_amdgcn_exp2f(sk - mx);
        const float inv = __builtin_amdgcn_rcpf(l);
        f32x4 o[4];
#pragma unroll
        for (int dv = 0; dv < 4; ++dv) o[dv] = (f32x4){0.f, 0.f, 0.f, 0.f};
#pragma unroll
        for (int pr = 0; pr < NT / 2; ++pr) {
            const bf16x8 pb = pack_acc2(s[2 * pr], s[2 * pr + 1]);
            const int k0 = 16 * (t0 + 2 * pr);
#pragma unroll
            for (int dv = 0; dv < 4; ++dv) o[dv] = MFMA16(frag_tr(L + AT_V, AT_LD, k0, 32 * dv, i, g, true), pb, o[dv]);
        }
        bf16* op = MIX + (size_t)(tok0 + 16 * w + i) * D + (SWA ? hq * 64 : 768 + hq * 64) + 4 * g;
#pragma unroll
        for (int dv = 0; dv < 4; ++dv) { v2u wv; wv.x = cvtpk(o[dv][0] * inv, o[dv][1] * inv); wv.y = cvtpk(o[dv][2] * inv, o[dv][3] * inv); *(GAS v2u*)(op + 16 * dv) = wv; }
    }
}

__device__ __forceinline__ void attn_swa_unit(Ctx& C, int unit, const bf16* P, int ldp, const float* qgain, const float* kgain, const float* sink, int kcol0, int vcol0, bf16* MIX) {
    LAS unsigned char* L = C.lds + RING_OFF; const int t = C.tid;
    const int hh = unit & 3, blk = (unit >> 2) & 63, b = unit >> 8; const long krow0 = (long)b * SEQ + (long)blk * 128 - 128, tok0 = (long)b * SEQ + (long)blk * 128; const bool prev_valid = blk > 0;
    AttnKV rkv; AttnQ<2> rq; float kg[32], qg[32];
#pragma unroll
    for (int q = 0; q < 32; ++q) { kg[q] = kgain[(t & 1) * 32 + q]; qg[q] = qgain[(t & 1) * 32 + q]; }
    attn_ld_kv(rkv, P, krow0, ldp, kcol0 + hh * 64, vcol0 + hh * 64, prev_valid || (t >> 1) >= 128, t);
    attn_ld_q<3, true>(rq, P, ldp, tok0, 0, hh, t);
    __syncthreads();
    attn_st_kv(rkv, L, kg, t); attn_st_q<3>(rq, L, qg, t);
    __syncthreads();
    attn_compute<true>(C, hh, tok0, prev_valid, sink, MIX);
}
__device__ __forceinline__ void attn_mem_pair(Ctx& C, int pair, const bf16* P, int ldp, const float* qgain, const float* kgain, int layer, bf16* MIX) {
    LAS unsigned char* L = C.lds + RING_OFF; const int t = C.tid;
    const int hh = pair & 3, bp = (pair >> 2) & 31, b = pair >> 7; const long tok0 = (long)b * SEQ + (long)bp * 256; const int qcol = ldp - 256;
    AttnKV rkv; AttnQ<1> rq; float kg[32], qg[32];
#pragma unroll
    for (int q = 0; q < 32; ++q) { kg[q] = kgain[(t & 1) * 32 + q]; qg[q] = qgain[(t & 1) * 32 + q]; }
    attn_ld_kv(rkv, WSP(bf16, WS_MKV), (long)b * MEMT, 2048, layer * 512 + hh * 64, layer * 512 + 256 + hh * 64, true, t);
    attn_ld_q<1, false>(rq, P, ldp, tok0, qcol, hh, t);
    __syncthreads();
    attn_st_kv(rkv, L, kg, t); attn_st_q<1>(rq, L, qg, t);
    __syncthreads();
    attn_ld_q<1, false>(rq, P, ldp, tok0 + 128, qcol, hh, t);
    attn_compute<false>(C, hh, tok0, true, nullptr, MIX);
    __syncthreads();
    attn_st_q<1>(rq, L, qg, t);
    __syncthreads();
    attn_compute<false>(C, hh, tok0 + 128, true, nullptr, MIX);
}

template <int MODE> struct CMT;
template <> struct CMT<0> { static constexpr int DK = 64, DV = 128, NH = 6, LDP = N_RET; };
template <> struct CMT<1> { static constexpr int DK = 96, DV = 192, NH = 4, LDP = N_MLS; };
template <int MODE> struct CML {
    static constexpr int DK = CMT<MODE>::DK, DV = CMT<MODE>::DV, LDQK = DK * 2 + 16, LDV = DV * 2 + 16;
    static constexpr int Q = 0, K = 128 * LDQK, V = 2 * 128 * LDQK, S = V + 128 * LDV, AUX = S + DK * LDV;
    static_assert(AUX + 832 * 4 <= RING_BYTES, "chunk mixer LDS");
};
constexpr size_t RT_NLOC = 1536 * KiB, RT_NIN = 1792 * KiB, RT_CHG = 2048 * KiB, RT_CHA = 2052 * KiB, RT_MIN = 2056 * KiB;
constexpr size_t SCR2_STATE = 24 * MiB;

template <int NROWS, int NCOLS> struct StageRegs { static constexpr int CPR = NCOLS / 8, TOTAL = NROWS * CPR, ITER = (TOTAL + 511) / 512; v4u r[ITER]; };
template <int NROWS, int NCOLS>
__device__ __forceinline__ void stage_ld(StageRegs<NROWS, NCOLS>& R, const bf16* src, size_t lds_src, int t) {
    typedef StageRegs<NROWS, NCOLS> SR;
#pragma unroll
    for (int it = 0; it < SR::ITER; ++it) { const int e = t + 512 * it; if (e < SR::TOTAL) { const int row = e / SR::CPR, c = e % SR::CPR; R.r[it] = *(const GAS v4u*)(src + (size_t)row * lds_src + c * 8); } }
}
template <int NROWS, int NCOLS, bool SCALE>
__device__ __forceinline__ void stage_st(const StageRegs<NROWS, NCOLS>& R, LAS unsigned char* dst, int ldd, const LAS float* rsc, float cs, int t) {
    typedef StageRegs<NROWS, NCOLS> SR;
#pragma unroll
    for (int it = 0; it < SR::ITER; ++it) { const int e = t + 512 * it; if (e < SR::TOTAL) { const int row = e / SR::CPR, c = e % SR::CPR;
        if (!SCALE) { *(LAS v4u*)(dst + row * ldd + c * 16) = R.r[it]; }
        else { const v4u w = R.r[it]; float f[8] = {bflo(w.x), bfhi(w.x), bflo(w.y), bfhi(w.y), bflo(w.z), bfhi(w.z), bflo(w.w), bfhi(w.w)}; const float sc = cs * (rsc ? rsc[row] : 1.0f);
#pragma unroll
            for (int j = 0; j < 8; ++j) f[j] *= sc;
            st8_lds(dst + row * ldd + c * 16, f); } } }
}
__device__ __forceinline__ void mls_chunk_scans(Ctx& C, float* aux, size_t row0, int h, float& btot, float& cmax) {
    const float* GT = WSP(float, WS_ROUTE + RT_GATES); const float ib = C.in[17][h], fb = C.in[18][h]; const int l = C.lane;
    float li0 = GT[(row0 + 2 * l) * 8 + h] + ib, li1 = GT[(row0 + 2 * l + 1) * 8 + h] + ib;
    float x0 = GT[(row0 + 2 * l) * 8 + 4 + h] + fb, x1 = GT[(row0 + 2 * l + 1) * 8 + 4 + h] + fb;
    x0 = fminf(x0, 0.f) - log1pf(__expf(-fabsf(x0))); x1 = fminf(x1, 0.f) - log1pf(__expf(-fabsf(x1)));
    const float s = x0 + x1; float inc = s;
#pragma unroll
    for (int d = 1; d < 64; d <<= 1) { const float v = __shfl_up(inc, d); if (l >= d) inc += v; }
    const float b0 = inc - s + x0, b1 = inc; const float c0 = li0 - b0, c1 = li1 - b1;
    float pm = fmaxf(c0, c1);
#pragma unroll
    for (int d = 1; d < 64; d <<= 1) { const float v = __shfl_up(pm, d); if (l >= d) pm = fmaxf(pm, v); }
    const float pmprev = __shfl_up(pm, 1); const float m0 = (l == 0) ? c0 : fmaxf(pmprev, c0);
    aux[2 * l] = b0; aux[2 * l + 1] = b1; aux[128 + 2 * l] = c0; aux[128 + 2 * l + 1] = c1; aux[256 + 2 * l] = m0; aux[256 + 2 * l + 1] = pm;
    const float cm = __shfl(pm, 63); aux[384 + 2 * l] = __expf(c0 - cm); aux[384 + 2 * l + 1] = __expf(c1 - cm);
    btot = __shfl(b1, 63); cmax = cm;
}
__device__ __forceinline__ void mls_aux(Ctx& C) {
    float* AUXG = WSP(float, WS_ROUTE + RT_AUXG);
    for (int unit = C.gw; unit < 512; unit += C.NGW) { const int bh = unit >> 6, c = unit & 63, b = bh >> 2, h = bh & 3; const size_t row0 = (size_t)b * SEQ + (size_t)c * 128;
        float* aux = AUXG + (size_t)unit * 512; float b127, cm; mls_chunk_scans(C, aux, row0, h, b127, cm);
        if (C.lane == 63) { WSP(float, WS_ROUTE + RT_CHG)[unit] = b127; WSP(float, WS_ROUTE + RT_CHA)[unit] = b127 + cm; } }
}
template <int MODE>
__device__ __forceinline__ void chunk_state_unit(Ctx& C, int unit, const bf16* P, const bf16* QKC, float* U) {
    typedef CML<MODE> Lm; constexpr int DK = Lm::DK, DV = Lm::DV, NH = CMT<MODE>::NH, LDP = CMT<MODE>::LDP, ND = DK / 16, NV = DV / 16, TPW = ND * NV / 8;
    LAS unsigned char* L = C.lds + RING_OFF; LAS float* aux = (LAS float*)(L + Lm::AUX);
    const int bh = unit >> 6, c = unit & 63, b = bh / NH, h = bh % NH, t = C.tid, i = C.lane & 15, g = C.lane >> 4, w = C.wave;
    const size_t row0 = (size_t)b * SEQ + (size_t)c * 128;
    StageRegs<128, DK> rK; StageRegs<128, DV> rV;
    stage_ld<128, DK>(rK, MODE == 0 ? P + row0 * LDP + 384 + h * 64 : QKC + row0 * 768 + 384 + h * 96, MODE == 0 ? LDP : 768, t);
    stage_ld<128, DV>(rV, P + row0 * LDP + 768 + h * DV, LDP, t);
    float wsc = 0.f; if (MODE == 1 && t < 128) wsc = WSP(float, WS_ROUTE + RT_AUXG)[(size_t)unit * 512 + 384 + t];
    __syncthreads();
    if (MODE == 0) { if (t < 128) { const float l2g = log2f(1.0f - exp2f(-5.0f - (float)h)); aux[384 + t] = 0.125f * exp2f((float)(127 - t) * l2g); } }
    else { if (t < 128) aux[384 + t] = wsc; }
    __syncthreads();
    stage_st<128, DK, true>(rK, L + Lm::K, Lm::LDQK, aux + 384, 1.0f, t);
    stage_st<128, DV, false>(rV, L + Lm::V, Lm::LDV, nullptr, 1.0f, t);
    __syncthreads();
#pragma unroll 1
    for (int n = 0; n < TPW; ++n) { const int id = w * TPW + n, dt = id / NV, vt = id % NV;
        f32x4 acc = (f32x4){0.f, 0.f, 0.f, 0.f};
#pragma unroll
        for (int ks = 0; ks < 4; ++ks) acc = MFMA16(frag_tr(L + Lm::K, Lm::LDQK, 32 * ks, 32 * dt, i, g, false), frag_tr(L + Lm::V, Lm::LDV, 32 * ks, 32 * vt, i, g, false), acc);
        float* up = U + (size_t)unit * DK * DV + (size_t)(16 * dt + 4 * g) * DV + 16 * vt + i;
#pragma unroll
        for (int r = 0; r < 4; ++r) up[r * DV] = acc[r]; }
    if (MODE == 1 && t < 4 * DK) { const int dcol = t >> 2, part = t & 3; float s0 = 0.f, s1 = 0.f;
#pragma unroll 8
        for (int j = 0; j < 32; j += 2) { s0 += bflo((unsigned)*(const LAS unsigned short*)(L + Lm::K + (part * 32 + j) * Lm::LDQK + 2 * dcol)); s1 += bflo((unsigned)*(const LAS unsigned short*)(L + Lm::K + (part * 32 + j + 1) * Lm::LDQK + 2 * dcol)); }
        float s = s0 + s1; s += __shfl_xor(s, 1); s += __shfl_xor(s, 2);
        if (part == 0) WSP(float, WS_ROUTE + RT_NLOC)[(size_t)unit * 96 + dcol] = s; }
}
__device__ __forceinline__ void ret_scan(Ctx& C, const float* U, bf16* SIN) {
    const int gt = C.bid * 512 + C.tid, nthr = C.G * 512;
    for (int e = gt; e < 12 * 8192; e += nthr) { const int bh = e >> 13, idx = e & 8191, h = bh % 6;
        const float gL = exp2f(128.0f * log2f(1.0f - exp2f(-5.0f - (float)h))); float S = 0.f;
        const float* up = U + (size_t)bh * 64 * 8192 + idx; bf16* sp = SIN + (size_t)bh * 64 * 8192 + idx;
        float u[64];
#pragma unroll
        for (int c = 0; c < 64; ++c) u[c] = up[(size_t)c * 8192];
#pragma unroll
        for (int c = 0; c < 64; ++c) { sp[(size_t)c * 8192] = (bf16)f2bf(S); S = gL * S + u[c]; } }
}
__device__ __forceinline__ void mls_scan(Ctx& C, const float* U, bf16* CIN) {
    constexpr int NC = 96 * 192, SEG = NC / 1024;
    typedef float f32x2 __attribute__((ext_vector_type(2)));
    const float* CHG = WSP(float, WS_ROUTE + RT_CHG); const float* CHA = WSP(float, WS_ROUTE + RT_CHA); float* MIN_ = WSP(float, WS_ROUTE + RT_MIN);
    const float* NLOC = WSP(float, WS_ROUTE + RT_NLOC); float* NIN = WSP(float, WS_ROUTE + RT_NIN);
    LAS float* sc = (LAS float*)(C.lds + RING_OFF);
    for (int task = C.bid; task < 8 * (SEG + 1); task += C.G) { const int bh = task / (SEG + 1), seg = task % (SEG + 1);
        __syncthreads();
        if (C.wave == 0) { const float gg = CHG[bh * 64 + C.lane], aa = CHA[bh * 64 + C.lane]; float m = 0.f, dmine = 0.f, wmine = 0.f, mmine = 0.f;
            for (int c = 0; c < 64; ++c) { const float g1 = __shfl(gg, c), a1 = __shfl(aa, c); const float mn = fmaxf(g1 + m, a1); const float dd = __expf(g1 + m - mn), ww = __expf(a1 - mn);
                if (C.lane == c) { dmine = dd; wmine = ww; mmine = m; } m = mn; }
            sc[C.lane] = dmine; sc[64 + C.lane] = wmine; if (seg == SEG) MIN_[bh * 64 + C.lane] = mmine; }
        __syncthreads();
        if (seg < SEG) { const int idx = seg * 1024 + 2 * C.tid; const float* src = U + (size_t)bh * 64 * NC + idx; bf16* dst = CIN + (size_t)bh * 64 * NC + idx;
            f32x2 u[64];
#pragma unroll
            for (int c = 0; c < 64; ++c) u[c] = *(const GAS f32x2*)(src + (size_t)c * NC);
            float v0 = 0.f, v1 = 0.f;
#pragma unroll
            for (int c = 0; c < 64; ++c) { *(GAS unsigned*)(dst + (size_t)c * NC) = pk2(v0, v1); const float dd = sc[c], ww = sc[64 + c]; v0 = dd * v0 + ww * u[c].x; v1 = dd * v1 + ww * u[c].y; } }
        else if (C.tid < 96) { const float* src = NLOC + (size_t)bh * 64 * 96 + C.tid; float u[64];
#pragma unroll
            for (int c = 0; c < 64; ++c) u[c] = src[(size_t)c * 96];
            float val = 0.f;
#pragma unroll
            for (int c = 0; c < 64; ++c) { NIN[(size_t)(bh * 64 + c) * 96 + C.tid] = val; val = sc[c] * val + sc[64 + c] * u[c]; } }
    }
}
template <int MODE>
__device__ __forceinline__ void chunk_out_unit(Ctx& C, int unit, const bf16* P, const bf16* QKC, const bf16* SIN, bf16* MIX) {
    typedef CML<MODE> Lm; constexpr int DK = Lm::DK, DV = Lm::DV, NH = CMT<MODE>::NH, LDP = CMT<MODE>::LDP, NV = DV / 16, NKS = DK / 32;
    LAS unsigned char* L = C.lds + RING_OFF; LAS float* aux = (LAS float*)(L + Lm::AUX);
    const int bh = unit >> 6, c = unit & 63, b = bh / NH, h = bh % NH, t = C.tid, i = C.lane & 15, g = C.lane >> 4, w = C.wave;
    const size_t row0 = (size_t)b * SEQ + (size_t)c * 128;
    StageRegs<128, DK> rQ, rK; StageRegs<128, DV> rV; StageRegs<DK, DV> rS;
    stage_ld<128, DK>(rQ, MODE == 0 ? P + row0 * LDP + h * 64 : QKC + row0 * 768 + h * 96, MODE == 0 ? LDP : 768, t);
    stage_ld<128, DK>(rK, MODE == 0 ? P + row0 * LDP + 384 + h * 64 : QKC + row0 * 768 + 384 + h * 96, MODE == 0 ? LDP : 768, t);
    stage_ld<128, DV>(rV, P + row0 * LDP + 768 + h * DV, LDP, t);
    stage_ld<DK, DV>(rS, SIN + (size_t)unit * DK * DV, DV, t);
    float auxv = 0.f; if (MODE == 1) { if (t < 384) auxv = WSP(float, WS_ROUTE + RT_AUXG)[(size_t)unit * 512 + t]; else if (t < 384 + 96) auxv = WSP(float, WS_ROUTE + RT_NIN)[(size_t)unit * 96 + t - 384]; }
    f32x4 gnv = (f32x4){0.f, 0.f, 0.f, 0.f}; if (MODE == 1 && t < 48) gnv = *(const GAS f32x4*)(C.in[19] + h * DV + 4 * t);
    __syncthreads();
    if (MODE == 1) { if (t < 384) aux[t] = auxv; else if (t < 384 + 96) aux[512 + t - 384] = auxv; if (t < 48) *(LAS f32x4*)(aux + 640 + 4 * t) = gnv; }
    stage_st<128, DK, false>(rQ, L + Lm::Q, Lm::LDQK, nullptr, 1.0f, t);
    if (MODE == 0) stage_st<128, DK, true>(rK, L + Lm::K, Lm::LDQK, nullptr, 0.125f, t); else stage_st<128, DK, false>(rK, L + Lm::K, Lm::LDQK, nullptr, 1.0f, t);
    stage_st<128, DV, false>(rV, L + Lm::V, Lm::LDV, nullptr, 1.0f, t);
    stage_st<DK, DV, false>(rS, L + Lm::S, Lm::LDV, nullptr, 1.0f, t);
    __syncthreads();
    const int qt = w < 4 ? w : 11 - w;
    const int iq = 16 * qt + i;
    v2u gwv[NV];
    { const bf16* gp0 = P + (row0 + iq) * LDP + 1536 + h * DV + 4 * g;
#pragma unroll
      for (int vt = 0; vt < NV; ++vt) gwv[vt] = *(const GAS v2u*)(gp0 + 16 * vt); }
    float m_in_early = 0.f; if (MODE == 1) m_in_early = WSP(float, WS_ROUTE + RT_MIN)[unit];
    bf16x8 qf[NKS];
#pragma unroll
    for (int s = 0; s < NKS; ++s) qf[s] = frag_rows(L + Lm::Q, Lm::LDQK, 16 * qt, 64 * s, i, g);
    f32x4 o[NV];
#pragma unroll
    for (int vt = 0; vt < NV; ++vt) { o[vt] = (f32x4){0.f, 0.f, 0.f, 0.f};
#pragma unroll
        for (int s = 0; s < NKS; ++s) o[vt] = MFMA16(frag_tr(L + Lm::S, Lm::LDV, 32 * s, 32 * vt, i, g, false), qf[s], o[vt]); }
    float colscale, ri = 0.f, emi = 1.f, den = 0.f;
    const float l2g = MODE == 0 ? log2f(1.0f - exp2f(-5.0f - (float)h)) : 0.f;
    if (MODE == 0) colscale = exp2f((float)(iq + 1) * l2g);
    else { const float m_in = m_in_early; const float bi = aux[iq], mxc = fmaxf(m_in, aux[256 + iq]);
        ri = -mxc; colscale = __expf(m_in - mxc); emi = __expf(-(bi + mxc));
        float nq = 0.f;
#pragma unroll
        for (int s = 0; s < NKS; ++s) { const v4u qw = __builtin_bit_cast(v4u, qf[s]); const f32x4 n0 = *(const LAS f32x4*)(aux + 512 + 32 * s + 8 * g), n1 = *(const LAS f32x4*)(aux + 512 + 32 * s + 8 * g + 4);
            nq += bflo(qw.x) * n0[0] + bfhi(qw.x) * n0[1] + bflo(qw.y) * n0[2] + bfhi(qw.y) * n0[3] + bflo(qw.z) * n1[0] + bfhi(qw.z) * n1[1] + bflo(qw.w) * n1[2] + bfhi(qw.w) * n1[3]; }
        nq += __shfl_xor(nq, 16); nq += __shfl_xor(nq, 32);
        den = colscale * nq; }
#pragma unroll
    for (int vt = 0; vt < NV; ++vt) o[vt] = o[vt] * colscale;
    float dsum = 0.f;
#pragma unroll
    for (int pr = 0; pr < 4; ++pr) {
        if (2 * pr <= qt) {
            f32x4 st[2];
#pragma unroll
            for (int u = 0; u < 2; ++u) { const int tt = 2 * pr + u; st[u] = (f32x4){0.f, 0.f, 0.f, 0.f};
#pragma unroll
                for (int s = 0; s < NKS; ++s) st[u] = MFMA16(frag_rows(L + Lm::K, Lm::LDQK, 16 * tt, 64 * s, i, g), qf[s], st[u]);
                f32x4 cj; if (MODE == 1) cj = *(const LAS f32x4*)(aux + 128 + 16 * tt + 4 * g);
#pragma unroll
                for (int r = 0; r < 4; ++r) { const int j = 16 * tt + 4 * g + r; const bool valid = j <= iq;
                    const float wgt = MODE == 0 ? __builtin_amdgcn_exp2f((float)(iq - j) * l2g) : __expf(fminf(ri + cj[r], 0.f));
                    st[u][r] = valid ? st[u][r] * wgt : 0.f; dsum += st[u][r]; } }
            const bf16x8 pb = pack_acc2(st[0], st[1]);
#pragma unroll
            for (int vt = 0; vt < NV; ++vt) o[vt] = MFMA16(frag_tr(L + Lm::V, Lm::LDV, 32 * pr, 32 * vt, i, g, true), pb, o[vt]);
        }
    }
    const size_t tok = row0 + iq; float ss = 0.f;
    if (MODE == 1) { dsum += __shfl_xor(dsum, 16); dsum += __shfl_xor(dsum, 32); den += dsum; const float inv = __builtin_amdgcn_rcpf(fmaxf(fabsf(den), emi));
#pragma unroll
        for (int vt = 0; vt < NV; ++vt) o[vt] = o[vt] * inv; }
#pragma unroll
    for (int vt = 0; vt < NV; ++vt) ss += (o[vt][0] * o[vt][0] + o[vt][1] * o[vt][1]) + (o[vt][2] * o[vt][2] + o[vt][3] * o[vt][3]);
    ss += __shfl_xor(ss, 16); ss += __shfl_xor(ss, 32);
    const float rs = __builtin_amdgcn_rsqf(ss * (1.0f / DV) + 1e-6f);
    bf16* op = MIX + tok * D + h * DV + 4 * g;
#pragma unroll
    for (int vt = 0; vt < NV; ++vt) { const v2u gw = gwv[vt]; float gv[4] = {bflo(gw.x), bfhi(gw.x), bflo(gw.y), bfhi(gw.y)}; float r4[4];
        if (MODE == 0) {
#pragma unroll
            for (int r = 0; r < 4; ++r) r4[r] = silu1(gv[r]) * o[vt][r] * rs; }
        else { const f32x4 gn = *(const LAS f32x4*)(aux + 640 + 16 * vt + 4 * g);
#pragma unroll
            for (int r = 0; r < 4; ++r) r4[r] = sigmoid1(gv[r]) * o[vt][r] * rs * gn[r]; }
        v2u wv; wv.x = cvtpk(r4[0], r4[1]); wv.y = cvtpk(r4[2], r4[3]); *(GAS v2u*)(op + 16 * vt) = wv; }
}

struct Args { const float* in[27]; float* out; unsigned char* ws; int ph_lo, ph_hi; };
static_assert(sizeof(Args) == 27 * 8 + 8 + 8 + 8, "Args has no padding");

#define GEMM_CALL(EpiT, SchedT, g, S, E) pg8::gemm_phase<EpiT, SchedT, true, true>(C.lds + RING_OFF, g, S, E)

__global__ void __launch_bounds__(NWAVES * 64, 2) trunk_fwd(Args args) {
    extern __shared__ __attribute__((aligned(16))) unsigned char lds_raw[];
    Ctx C;
    C.lds = (LAS unsigned char*)lds_raw;
    C.tid = threadIdx.x; C.lane = C.tid & 63; C.wave = __builtin_amdgcn_readfirstlane(C.tid >> 6);
    C.G = gridDim.x; C.bid = blockIdx.x; C.gw = C.bid * NWAVES + C.wave; C.NGW = C.G * NWAVES;
#pragma unroll
    for (int i = 0; i < 27; ++i) C.in[i] = args.in[i];
    C.out = args.out; C.ws = args.ws; C.pacc = 0ull; C.pt0 = 0ull;
    volatile LAS unsigned* MISC = (volatile LAS unsigned*)(C.lds + MISC_OFF);
    for (int u = C.tid; u < (LDS_BYTES - LDSCTL_OFF) / 4; u += NWAVES * 64) ((LAS unsigned*)(C.lds + LDSCTL_OFF))[u] = 0u;
    __syncthreads();
    XcdBarrier bar; bar.bar = (unsigned*)(C.ws + WS_CTL) + CW_BAR; bar.x = 0; bar.st = nullptr;
    if (MK_SINGLE) bar = xcd_barrier_post((unsigned*)(C.ws + WS_CTL) + CW_BAR, MISC + 8);
    const int lo = args.ph_lo, hi = args.ph_hi;
#define IN(k) (lo <= (k) && (k) < hi)
#define DBL(k) (((DBL_MASK >> (k)) & 1ull) != 0ull)
#define SEAM(k) do { if (MK_SINGLE && IN((k) + 1)) xcd_barrier(bar); } while (0)
#define PH(k, ...) if (IN(k)) { if ((PROF_MASK >> (k)) & 1ull) C.pt0 = rt(); __VA_ARGS__ if (DBL(k)) { for (int rep_ = 0; rep_ < DBL_REPS; ++rep_) { if (MK_SINGLE) xcd_barrier(bar); __VA_ARGS__ } } if ((PROF_MASK >> (k)) & 1ull) C.pacc += rt() - C.pt0; }

    bf16* HB = WSP(bf16, WS_HB); float* SS = WSP(float, WS_SS); bf16* Pb = WSP(bf16, WS_BIG + BIG_P); bf16* MIX = WSP(bf16, WS_BIG + BIG_MIX);
    float* SCR1 = WSP(float, WS_BIG + BIG_SCR1); bf16* QKC = WSP(bf16, WS_BIG + BIG_SCR2); bf16* SIN = WSP(bf16, WS_BIG + BIG_SCR2 + SCR2_STATE); bf16* HID = WSP(bf16, WS_BIG);
    const int* PANEL = WSP(int, WS_ROUTE + RT_PANEL); const int* NPp = WSP(int, WS_ROUTE + RT_NP); const float* SLOTRS = WSP(float, WS_ROUTE + RT_SLOTRS);

#define G_INPROJ(layer, NN) { pg8::Gemm g{HB, WSP(bf16, WS_WIN + WIN_OFF[layer]), M, NN, D}; pg8::StaticOrder S; S.init(M, NN, C.G, C.bid); \
        pg8::EpiScaleBf16 E{Pb, NN, SS, rstd_table(C, S, SS)}; GEMM_CALL(pg8::EpiScaleBf16, pg8::StaticOrder, g, S, E); }
#define G_OUTPROJ(layer) { pg8::Gemm g{MIX, WSP(bf16, WS_WOUT + (size_t)(layer) * 2 * MiB), M, D, D}; pg8::StaticOrder S; S.init(M, D, C.G, C.bid); \
        pg8::EpiResid E{HB, SS, (PG8_LAS float*)(C.lds + 131072)}; GEMM_CALL(pg8::EpiResid, pg8::StaticOrder, g, S, E); }
#define G_GATEUP_DENSE(j) { pg8::Gemm g{HB, WSP(bf16, WS_WFD + (j) * FD_STRIDE), M, 2 * FF, D}; pg8::StaticOrder S; S.init(M, 2 * FF, C.G, C.bid); \
        pg8::EpiSwiglu<false> E{HID, SS, rstd_table(C, S, SS)}; GEMM_CALL(pg8::EpiSwiglu<false>, pg8::StaticOrder, g, S, E); }
#define G_DOWN_DENSE(j) { pg8::Gemm g{HID, WSP(bf16, WS_WFD + (j) * FD_STRIDE + FD_WD), M, D, FF}; pg8::StaticOrder S; S.init(M, D, C.G, C.bid); \
        pg8::EpiResid E{HB, SS, (PG8_LAS float*)(C.lds + 131072)}; GEMM_CALL(pg8::EpiResid, pg8::StaticOrder, g, S, E); }
#define G_GATEUP_MOE(j) { pg8::Gemm g{HB, WSP(bf16, WS_WMOE + (j) * MOE_STRIDE), MAXSLOT, NE * 2 * FF, D, WSP(int, WS_ROUTE + RT_ROWTOK)}; pg8::MoeOrder S; S.init(NPp, PANEL, 28, C.G, C.bid); \
        pg8::EpiSwiglu<true> E{HID, SLOTRS, nullptr}; pg8::gemm_phase<pg8::EpiSwiglu<true>, pg8::MoeOrder, true, true, true>(C.lds + RING_OFF, g, S, E); }
#define G_DOWN_MOE(j) { pg8::Gemm g{HID, WSP(bf16, WS_WMOE + (j) * MOE_STRIDE + MOE_WD), MAXSLOT, NE * D, FF}; pg8::MoeOrder S; S.init(NPp, PANEL, 4, C.G, C.bid); \
        if (C.G == 256) S.max_rounds = 2; pg8::EpiYBf16 E{WSP(bf16, WS_Y)}; GEMM_CALL(pg8::EpiYBf16, pg8::MoeOrder, g, S, E); } \
    if (C.G == 256) { const int tail = C.bid / 7, ks = C.bid % 7; \
        pg8::Gemm g{HID + ks * 512, WSP(bf16, WS_WMOE + (j) * MOE_STRIDE + MOE_WD) + ks * 512, MAXSLOT, NE * D, 512, nullptr, FF}; \
        pg8::MoeOrder S; S.init(NPp, PANEL, 4, C.G, tail); S.first_round = 2; S.max_rounds = (C.bid < 224) ? 3 : 0; \
        pg8::EpiSlab E{WSP(float, WS_SLAB), WSP(int, WS_ROUTE + RT_TAILIDX), tail, ks}; GEMM_CALL(pg8::EpiSlab, pg8::MoeOrder, g, S, E); }
#define G_MEMKV() { pg8::Gemm g{WSP(bf16, WS_MEMN), WSP(bf16, WS_WMEM), MROWS, 2048, D}; pg8::StaticOrder S; S.init(MROWS, 2048, C.G, (C.bid + 16) % C.G); \
        pg8::EpiPlainBf16 E{WSP(bf16, WS_MKV), 2048}; GEMM_CALL(pg8::EpiPlainBf16, pg8::StaticOrder, g, S, E); }
#define MEMATTN(layer, NN) { TB(102); for (int u = C.bid; u < 256; u += C.G) attn_mem_pair(C, u, Pb, NN, C.in[5] + (layer) * 64, C.in[6] + (layer) * 64, layer, MIX); TE(102); }
#define FFN_DENSE(k, j) PH(k, G_GATEUP_DENSE(j) SEAM(k);) PH((k) + 1, G_DOWN_DENSE(j) SEAM((k) + 1);)
#define FFN_MOE(k, j, layer) PH(k, moe_route1(C, j, layer); SEAM(k);) PH((k) + 1, moe_route2(C); SEAM((k) + 1);) PH((k) + 2, G_GATEUP_MOE(j) SEAM((k) + 2);) \
        PH((k) + 3, G_DOWN_MOE(j) SEAM((k) + 3);) PH((k) + 4, moe_combine<(layer) == 3>(C); SEAM((k) + 4);)

    PH(0, p_prologue(C); SEAM(0);)
    PH(1, G_MEMKV() G_INPROJ(0, N_SWA) SEAM(1);)
    PH(2, for (int u = C.bid; u < 512; u += C.G) { if (u == C.bid) TB(100); else TB(101); attn_swa_unit(C, u, Pb, N_SWA, C.in[10], C.in[11], C.in[12], 768, 1024, MIX); if (u == C.bid) TE(100); else TE(101); }
          MEMATTN(0, N_SWA) SEAM(2);)
    PH(3, G_OUTPROJ(0) SEAM(3);)
    FFN_DENSE(4, 0)
#define IDLE_TP(win) if (C.G == 256 && C.bid >= 128) tp_run(C, TP_MOVED_LO + (win) * TP_WIN_N + C.bid - 128, 128, TP_MOVED_LO + ((win) + 1) * TP_WIN_N, 1 << 30, 0);
    PH(6, G_INPROJ(1, N_RET) IDLE_TP(0) SEAM(6);)
    PH(7, for (int u = C.bid; u < 768; u += C.G) chunk_state_unit<0>(C, u, Pb, nullptr, SCR1); MEMATTN(1, N_RET) SEAM(7);)
    PH(8, ret_scan(C, SCR1, SIN); SEAM(8);)
    PH(9, for (int u = C.bid; u < 768; u += C.G) { TB(121); chunk_out_unit<0>(C, u, Pb, nullptr, SIN, MIX); TE(121); } SEAM(9);)
    PH(10, G_OUTPROJ(1) SEAM(10);)
    FFN_MOE(11, 0, 1)
    PH(16, G_INPROJ(2, N_MLS) mls_gates(C); IDLE_TP(1) SEAM(16);)
    PH(17, mls_aux(C); mls_conv(C, Pb, QKC); SEAM(17);)
    PH(18, for (int u = C.bid; u < 512; u += C.G) chunk_state_unit<1>(C, u, Pb, QKC, SCR1); MEMATTN(2, N_MLS) SEAM(18);)
    PH(19, mls_scan(C, SCR1, SIN); SEAM(19);)
    PH(20, for (int u = C.bid; u < 512; u += C.G) { TB(120); chunk_out_unit<1>(C, u, Pb, QKC, SIN, MIX); TE(120); } SEAM(20);)
    PH(21, G_OUTPROJ(2) SEAM(21);)
    FFN_DENSE(22, 1)
    PH(24, G_INPROJ(3, N_SWA) IDLE_TP(2) SEAM(24);)
    PH(25, for (int u = C.bid; u < 512; u += C.G) { if (u == C.bid) TB(100); else TB(101); attn_swa_unit(C, u, Pb, N_SWA, C.in[10] + 64, C.in[11] + 64, C.in[12] + 12, 768, 1024, MIX); if (u == C.bid) TE(100); else TE(101); }
           MEMATTN(3, N_SWA) SEAM(25);)
    PH(26, G_OUTPROJ(3) SEAM(26);)
    FFN_MOE(27, 1, 3)
    if (PROF_MASK != 0ull || PROF_SEC >= 0) { const unsigned long long te_ = rt() + (unsigned long long)PROF_AMP * C.pacc; while (rt() < te_) __builtin_amdgcn_s_sleep(16); }
#undef IN
}

extern "C" void kernel_launch(void* const* d_in, const int* in_sizes, int n_in, void* d_out, int out_size, void* d_ws, size_t ws_size, hipStream_t stream) {
    static int grid = 0;
    if (grid == 0) {
        if (n_in != 27 || in_sizes[0] != M * D || out_size != M * D || ws_size < WS_END) { fprintf(stderr, "kernel_launch: unexpected shapes (n_in %d, in0 %d, out %d, ws %zu < %zu)\n", n_in, n_in > 0 ? in_sizes[0] : -1, out_size, ws_size, (size_t)WS_END); grid = -1; return; }
        int dev = 0, cus = 0, per_cu = 0;
        if (hipGetDevice(&dev) != hipSuccess || hipDeviceGetAttribute(&cus, hipDeviceAttributeMultiprocessorCount, dev) != hipSuccess) { grid = -1; return; }
        if (hipFuncSetAttribute((const void*)trunk_fwd, hipFuncAttributeMaxDynamicSharedMemorySize, LDS_BYTES) != hipSuccess) { fprintf(stderr, "kernel_launch: hipFuncSetAttribute failed\n"); grid = -1; return; }
        if (hipOccupancyMaxActiveBlocksPerMultiprocessor(&per_cu, (const void*)trunk_fwd, NWAVES * 64, LDS_BYTES) != hipSuccess || per_cu < 1) fprintf(stderr, "kernel_launch: occupancy query says %d\n", per_cu);
        (void)hipGetLastError();
        grid = cus;
    }
    if (grid < 0) return;
    if (hipMemsetAsync((char*)d_ws + WS_CTL, 0, CTL_ZERO_BYTES, stream) != hipSuccess) return;
    Args a{};
    for (int i = 0; i < 27; ++i) a.in[i] = (const float*)d_in[i];
    a.out = (float*)d_out; a.ws = (unsigned char*)d_ws;
    if (MK_SINGLE) { a.ph_lo = 0; a.ph_hi = NPHASE; hipLaunchKernelGGL(trunk_fwd, dim3(grid), dim3(NWAVES * 64), LDS_BYTES, stream, a); }
    else for (int p = 0; p < NPHASE; ++p) { a.ph_lo = p; a.ph_hi = p + 1; hipLaunchKernelGGL(trunk_fwd, dim3(grid), dim3(NWAVES * 64), LDS_BYTES, stream, a); }
}
```

```cpp
#include <hip/hip_runtime.h>
#include <cstdio>
#include <cstdint>
namespace pg8 {
#define PG8_LAS __attribute__((address_space(3)))
typedef unsigned short bf16_t;
typedef short bf16x8 __attribute__((ext_vector_type(8)));
typedef float f32x4 __attribute__((ext_vector_type(4)));
typedef unsigned u32x4 __attribute__((ext_vector_type(4)));
constexpr int BM = 256, BK = 64, HALF = 128, HTB = HALF * BK * 2  , STAGE_BYTES = 8 * HTB, NXCD = 8, WGM = 8;

__host__ __device__ __forceinline__ int lds_byte(int r, int c) { const int st = (r >> 4) * 2 + (c >> 5), rr = r & 15, cc = c & 31, ob = rr * 64 + cc * 2; return st * 1024 + (ob ^ (((ob >> 9) & 1) << 5)); }
__host__ __device__ __forceinline__ void stage_rc(int b, int& R, int& C) { const int st = b / 1024, sb = b % 1024, swz = sb ^ (((sb >> 9) & 1) << 5); R = (st >> 1) * 16 + swz / 64; C = (st & 1) * 32 + (swz % 64) / 2; }
__host__ __device__ __forceinline__ int perm32(int rho) { const int n = rho >> 4, i = rho & 15; return 8 * (i >> 2) + 4 * n + (i & 3); }

struct Unit { int pm, pn; };
struct Gemm { const bf16_t* A; const bf16_t* Bt; int M, N, K; const int* rowmap; int ld; };

struct StaticOrder {
    int nM, nN, nwg, G, c;
    __host__ __device__ void init(int M, int N, int G_, int c_) { nM = M / BM; nN = N / BM; nwg = nM * nN; G = G_; c = c_; }
    __host__ __device__ bool next(int i, Unit& u) const {
        const long L = (long)i * G + c; if (L >= nwg) return false;
        int wgid = (int)L; { const int q = nwg / NXCD, r = nwg % NXCD, xcd = wgid % NXCD, off = wgid / NXCD; wgid = (xcd < r ? xcd * (q + 1) : r * (q + 1) + (xcd - r) * q) + off; }
        const int nig = WGM * nN, gid = wgid / nig, fm = gid * WGM, gsz = (nM - fm) < WGM ? (nM - fm) : WGM;
        u.pm = fm + ((wgid % nig) % gsz); u.pn = (wgid % nig) / gsz; return true;
    }
    static constexpr bool LATE = false;
    __device__ __forceinline__ void a_ready(const Unit&) const {}
    __device__ __forceinline__ void done(const Unit&) const {}
};

__device__ __forceinline__ unsigned cvt_pk_bf16(float lo, float hi) { unsigned r; asm volatile("v_cvt_pk_bf16_f32 %0, %1, %2" : "=v"(r) : "v"(lo), "v"(hi)); return r; }
__device__ __forceinline__ float row_rstd16(const float* SS, int row) {
    const f32x4 a = *(const f32x4*)(SS + (size_t)row * 4);
    return __builtin_amdgcn_rsqf(((a[0] + a[1]) + (a[2] + a[3])) * (1.0f / 1024.0f) + 1e-6f);
}
typedef float f32x2 __attribute__((ext_vector_type(2)));

struct EpiPlainBf16 {
    static constexpr bool PERM = true, AFTER_DRAIN = false, PREFETCH = false;
    bf16_t* O; int ldc;
    __device__ __forceinline__ void operator()(const f32x4 (&acc)[2][2][4][2], const Unit& u, int wr, int wc, int fr, int fq) const {
        const int row0 = u.pm * BM + wr * 64 + fr, col0 = u.pn * BM + wc * 32 + 8 * fq;
#pragma unroll
        for (int ai = 0; ai < 2; ++ai)
#pragma unroll
            for (int m = 0; m < 4; ++m) { bf16_t* rowp = O + (size_t)(row0 + ai * HALF + m * 16) * ldc + col0;
#pragma unroll
                for (int bj = 0; bj < 2; ++bj) { const f32x4 v0 = acc[ai][bj][m][0], v1 = acc[ai][bj][m][1];
                    u32x4 w; w.x = cvt_pk_bf16(v0[0], v0[1]); w.y = cvt_pk_bf16(v0[2], v0[3]); w.z = cvt_pk_bf16(v1[0], v1[1]); w.w = cvt_pk_bf16(v1[2], v1[3]);
                    *(u32x4*)(rowp + bj * HALF) = w; } }
    }
};
struct EpiScaleBf16 {
    static constexpr bool PERM = true, AFTER_DRAIN = false, PREFETCH = true;
    __device__ __forceinline__ void prefetch(const Unit& u) const { const int wq = __builtin_amdgcn_readfirstlane((int)(threadIdx.x >> 6) & 3);
        __builtin_amdgcn_global_load_lds((const unsigned*)(SS + ((size_t)u.pm * BM + (threadIdx.x & 255)) * 4), (PG8_LAS unsigned*)(rsl + wq * 256), 16, 0, 0); }
    static __device__ __forceinline__ float rstd_l(const PG8_LAS float* p) { const f32x4 a = *(const PG8_LAS f32x4*)p; return __builtin_amdgcn_rsqf(((a[0] + a[1]) + (a[2] + a[3])) * (1.0f / 1024.0f) + 1e-6f); }
    bf16_t* O; int ldc; const float* SS; const PG8_LAS float* rsl;
    __device__ __forceinline__ void operator()(const f32x4 (&acc)[2][2][4][2], const Unit& u, int wr, int wc, int fr, int fq) const {
        const int row0 = u.pm * BM + wr * 64 + fr, col0 = u.pn * BM + wc * 32 + 8 * fq;
#pragma unroll
        for (int ai = 0; ai < 2; ++ai)
#pragma unroll
            for (int m = 0; m < 4; ++m) { const int row = row0 + ai * HALF + m * 16; const float sc = rstd_l(rsl + (row & 255) * 4); bf16_t* rowp = O + (size_t)row * ldc + col0;
#pragma unroll
                for (int bj = 0; bj < 2; ++bj) { const f32x4 v0 = acc[ai][bj][m][0] * sc, v1 = acc[ai][bj][m][1] * sc;
                    u32x4 w; w.x = cvt_pk_bf16(v0[0], v0[1]); w.y = cvt_pk_bf16(v0[2], v0[3]); w.z = cvt_pk_bf16(v1[0], v1[1]); w.w = cvt_pk_bf16(v1[2], v1[3]);
                    *(u32x4*)(rowp + bj * HALF) = w; } }
    }
};
struct EpiResid {
    static constexpr bool PERM = true, AFTER_DRAIN = false, PREFETCH = false;
    bf16_t* HB; float* SS; PG8_LAS float* xs;
    __device__ __forceinline__ void operator()(const f32x4 (&acc)[2][2][4][2], const Unit& u, int wr, int wc, int fr, int fq) const {
        const int row0 = u.pm * BM + wr * 64 + fr, col0 = u.pn * BM + wc * 32 + 8 * fq;
        u32x4 hv[2][4][2];
#pragma unroll
        for (int ai = 0; ai < 2; ++ai)
#pragma unroll
            for (int m = 0; m < 4; ++m) { const bf16_t* bp = HB + (size_t)(row0 + ai * HALF + m * 16) * 1024 + col0;
                hv[ai][m][0] = *(const u32x4*)bp; hv[ai][m][1] = *(const u32x4*)(bp + HALF); }
#pragma unroll
        for (int ai = 0; ai < 2; ++ai)
#pragma unroll
            for (int m = 0; m < 4; ++m) { const int row = row0 + ai * HALF + m * 16; bf16_t* bp = HB + (size_t)row * 1024 + col0; float ss = 0.f;
#pragma unroll
                for (int bj = 0; bj < 2; ++bj) { const u32x4 hw = hv[ai][m][bj];
                    f32x4 h0 = (f32x4){__uint_as_float(hw.x << 16), __uint_as_float(hw.x & 0xffff0000u), __uint_as_float(hw.y << 16), __uint_as_float(hw.y & 0xffff0000u)};
                    f32x4 h1 = (f32x4){__uint_as_float(hw.z << 16), __uint_as_float(hw.z & 0xffff0000u), __uint_as_float(hw.w << 16), __uint_as_float(hw.w & 0xffff0000u)};
                    h0 = h0 + acc[ai][bj][m][0]; h1 = h1 + acc[ai][bj][m][1];
                    ss += ((h0[0] * h0[0] + h0[1] * h0[1]) + (h0[2] * h0[2] + h0[3] * h0[3])) + ((h1[0] * h1[0] + h1[1] * h1[1]) + (h1[2] * h1[2] + h1[3] * h1[3]));
                    u32x4 w; w.x = cvt_pk_bf16(h0[0], h0[1]); w.y = cvt_pk_bf16(h0[2], h0[3]); w.z = cvt_pk_bf16(h1[0], h1[1]); w.w = cvt_pk_bf16(h1[2], h1[3]);
                    *(u32x4*)(bp + bj * HALF) = w; }
                ss += __shfl_xor(ss, 16); ss += __shfl_xor(ss, 32);
                if (fq == 0) xs[(ai * HALF + wr * 64 + m * 16 + fr) * 4 + wc] = ss; }
        asm volatile("s_waitcnt lgkmcnt(0)" ::: "memory"); __builtin_amdgcn_s_barrier(); asm volatile("" ::: "memory");
        if (threadIdx.x < 256) { const f32x4 v = *(const PG8_LAS f32x4*)(xs + 4 * threadIdx.x); SS[(size_t)(u.pm * BM + threadIdx.x) * 4 + u.pn] = (v[0] + v[1]) + (v[2] + v[3]); }
    }
};
template <bool MOE> struct EpiSwiglu {
    static constexpr bool PERM = true, AFTER_DRAIN = false, PREFETCH = true;
    bf16_t* O; const float* RS; const PG8_LAS float* rsl;
    __device__ __forceinline__ void prefetch(const Unit& u) const {
        const int wq = __builtin_amdgcn_readfirstlane((int)(threadIdx.x >> 6) & 3);
        if (MOE) __builtin_amdgcn_global_load_lds((const unsigned*)(RS + (size_t)u.pm * BM + (threadIdx.x & 255)), (PG8_LAS unsigned*)(rsl + wq * 64), 4, 0, 0);
        else __builtin_amdgcn_global_load_lds((const unsigned*)(RS + ((size_t)u.pm * BM + (threadIdx.x & 255)) * 4), (PG8_LAS unsigned*)(rsl + wq * 256), 16, 0, 0);
    }
    static __device__ __forceinline__ f32x2 swi2(f32x2 g, f32x2 u, float nsc, float sc2) {
        const f32x2 t = g * nsc; f32x2 d; d.x = __builtin_amdgcn_exp2f(t.x); d.y = __builtin_amdgcn_exp2f(t.y); d = d + 1.0f;
        f32x2 r; r.x = __builtin_amdgcn_rcpf(d.x); r.y = __builtin_amdgcn_rcpf(d.y);
        return ((g * u) * sc2) * r;
    }
    __device__ __forceinline__ void operator()(const f32x4 (&acc)[2][2][4][2], const Unit& u, int wr, int wc, int fr, int fq) const {
        const int pnl = MOE ? (u.pn % 28) : u.pn;
        const int row0 = u.pm * BM + wr * 64 + fr, col0 = pnl * HALF + wc * 32 + 8 * fq;
        float scv[2][4];
#pragma unroll
        for (int ai = 0; ai < 2; ++ai)
#pragma unroll
            for (int m = 0; m < 4; ++m) { const int row = row0 + ai * HALF + m * 16; if (MOE) scv[ai][m] = rsl[row & 255]; else { const f32x4 a = *(const PG8_LAS f32x4*)(rsl + (row & 255) * 4); scv[ai][m] = __builtin_amdgcn_rsqf(((a[0] + a[1]) + (a[2] + a[3])) * (1.0f / 1024.0f) + 1e-6f); } }
#pragma unroll
        for (int ai = 0; ai < 2; ++ai)
#pragma unroll
            for (int m = 0; m < 4; ++m) { const int row = row0 + ai * HALF + m * 16; const float sc = scv[ai][m], nsc = -1.4426950408889634f * sc, sc2 = sc * sc;
                const f32x4 g0 = acc[ai][0][m][0], g1 = acc[ai][0][m][1], u0 = acc[ai][1][m][0], u1 = acc[ai][1][m][1];
                const f32x2 a = swi2((f32x2){g0[0], g0[1]}, (f32x2){u0[0], u0[1]}, nsc, sc2), b = swi2((f32x2){g0[2], g0[3]}, (f32x2){u0[2], u0[3]}, nsc, sc2);
                const f32x2 c = swi2((f32x2){g1[0], g1[1]}, (f32x2){u1[0], u1[1]}, nsc, sc2), d = swi2((f32x2){g1[2], g1[3]}, (f32x2){u1[2], u1[3]}, nsc, sc2);
                u32x4 w; w.x = cvt_pk_bf16(a.x, a.y); w.y = cvt_pk_bf16(b.x, b.y); w.z = cvt_pk_bf16(c.x, c.y); w.w = cvt_pk_bf16(d.x, d.y);
                *(u32x4*)(O + (size_t)row * 3584 + col0) = w; }
    }
};
struct EpiYBf16 {
    static constexpr bool PERM = true, AFTER_DRAIN = false, PREFETCH = false;
    bf16_t* Y;
    __device__ __forceinline__ void operator()(const f32x4 (&acc)[2][2][4][2], const Unit& u, int wr, int wc, int fr, int fq) const {
        const int pnl = u.pn & 3;
        const int row0 = u.pm * BM + wr * 64 + fr, col0 = pnl * BM + wc * 32 + 8 * fq;
#pragma unroll
        for (int ai = 0; ai < 2; ++ai)
#pragma unroll
            for (int m = 0; m < 4; ++m) { bf16_t* yp = Y + (size_t)(row0 + ai * HALF + m * 16) * 1024 + col0;
#pragma unroll
                for (int bj = 0; bj < 2; ++bj) { const f32x4 v0 = acc[ai][bj][m][0], v1 = acc[ai][bj][m][1];
                    u32x4 w; w.x = cvt_pk_bf16(v0[0], v0[1]); w.y = cvt_pk_bf16(v0[2], v0[3]); w.z = cvt_pk_bf16(v1[0], v1[1]); w.w = cvt_pk_bf16(v1[2], v1[3]);
                    *(u32x4*)(yp + bj * HALF) = w; } }
    }
};
struct EpiSlab {
    static constexpr bool PERM = true, AFTER_DRAIN = false, PREFETCH = false;
    float* S; int* tailidx; int tail, ks;
    __device__ __forceinline__ void operator()(const f32x4 (&acc)[2][2][4][2], const Unit& u, int wr, int wc, int fr, int fq) const {
        float* sp = S + (size_t)(tail * 7 + ks) * 65536; const int row0 = wr * 64 + fr, col0 = wc * 32 + 8 * fq;
        if (ks == 0 && threadIdx.x == 0) tailidx[u.pm * 4 + (u.pn & 3)] = tail;
#pragma unroll
        for (int ai = 0; ai < 2; ++ai)
#pragma unroll
            for (int m = 0; m < 4; ++m) { float* yp = sp + (size_t)(row0 + ai * HALF + m * 16) * 256 + col0;
#pragma unroll
                for (int bj = 0; bj < 2; ++bj) { *(f32x4*)(yp + bj * HALF) = acc[ai][bj][m][0]; *(f32x4*)(yp + bj * HALF + 4) = acc[ai][bj][m][1]; } }
    }
};
struct MoeOrder {
    StaticOrder so; const int* panel_e; int ntn, max_rounds, first_round;
    __device__ void init(const int* np_ptr, const int* panel_e_, int ntn_, int G, int c) { const int np = __builtin_amdgcn_readfirstlane(*np_ptr); so.init(np * BM, ntn_ * BM, G, c); panel_e = panel_e_; ntn = ntn_; max_rounds = 1 << 20; first_round = 0; }
    __device__ bool next(int i, Unit& u) const { i += first_round; if (i >= max_rounds || !so.next(i, u)) return false; const int e = __builtin_amdgcn_readfirstlane(panel_e[u.pm]); u.pn += e * ntn; return true; }
    static constexpr bool LATE = true;
    __device__ bool next_local(int i, Unit& u) const { i += first_round; return i < max_rounds && so.next(i, u); }
    __device__ __forceinline__ void late_issue(const Unit& u, PG8_LAS unsigned char* slot) const { __builtin_amdgcn_global_load_lds((const unsigned*)(panel_e + u.pm), (PG8_LAS unsigned*)slot, 4, 0, 0); }
    __device__ __forceinline__ void late_apply(Unit& u, const PG8_LAS unsigned char* slot) const { const int e = __builtin_amdgcn_readfirstlane(*(const PG8_LAS int*)slot); u.pn += e * ntn; }
    __device__ __forceinline__ void a_ready(const Unit&) const {}
    __device__ __forceinline__ void done(const Unit&) const {}
};
template <class Epi, class Sched, bool ALIGN_EPI = false, bool SP2 = false, bool GATHER = false>
__device__ __forceinline__ void gemm_phase(PG8_LAS unsigned char* lds, const Gemm g, const Sched& S, const Epi& E) {
    const int tid = threadIdx.x, wid = __builtin_amdgcn_readfirstlane(tid >> 6), lane = tid & 63, wr = wid >> 2, wc = wid & 3, fr = lane & 15, fq = lane >> 4;
    const int K = g.K, nt = K / BK, LD = g.ld ? g.ld : g.K;
    unsigned voffA[2], voffB[2]; int gR[2]; unsigned gC[2];
#pragma unroll
    for (int i = 0; i < 2; ++i) { int R, C; stage_rc(tid * 16 + i * 8192, R, C); const int Rb = Epi::PERM ? ((R & ~31) + perm32(R & 31)) : R;
        voffA[i] = (unsigned)(R * LD + C) * 2u; voffB[i] = (unsigned)(Rb * LD + C) * 2u; gR[i] = R; gC[i] = (unsigned)C * 2u; }
    const size_t kstep = (size_t)(BK * 2);
    const size_t hstep = (size_t)HALF * LD * 2;
    const size_t tstep = 2 * hstep;
    const unsigned ldsw = (unsigned)wid * 1024u;
    const int aoff = lds_byte(wr * 64 + fr, fq * 8), boff = lds_byte(wc * 32 + fr, fq * 8);
#define PG8_SA(b, h) (((b) * 2 + (h)) * HTB)
#define PG8_SB(b, h) ((4 + (b) * 2 + (h)) * HTB)
#define PG8_STAGE(bufoff, gbase, voff) do { _Pragma("unroll") for (int _i = 0; _i < 2; ++_i) \
        __builtin_amdgcn_global_load_lds((const unsigned*)((const char*)(gbase) + (voff)[_i]), (PG8_LAS unsigned*)(lds + (bufoff) + ldsw + _i * 8192), 16, 0, 0); } while (0)
#define PG8_GOFF(dst, pm_) do { const int* rb_ = g.rowmap + (size_t)(pm_) * BM; int r_[2][2]; \
        _Pragma("unroll") for (int _h = 0; _h < 2; ++_h) _Pragma("unroll") for (int _i = 0; _i < 2; ++_i) r_[_h][_i] = rb_[_h * HALF + gR[_i]]; \
        asm volatile("" :: "v"(r_[0][0]), "v"(r_[0][1]), "v"(r_[1][0]), "v"(r_[1][1]));        \
        _Pragma("unroll") for (int _h = 0; _h < 2; ++_h) _Pragma("unroll") for (int _i = 0; _i < 2; ++_i) dst[_h][_i] = (unsigned)r_[_h][_i] * (unsigned)(LD * 2) + gC[_i]; } while (0)
#define PG8_STAGE_A(bufoff, ptr, half, nx) do { if constexpr (GATHER) { const unsigned _o0 = (nx) ? gvN[half][0] : gvC[half][0], _o1 = (nx) ? gvN[half][1] : gvC[half][1]; \
        __builtin_amdgcn_global_load_lds((const unsigned*)((const char*)(ptr) + _o0), (PG8_LAS unsigned*)(lds + (bufoff) + ldsw), 16, 0, 0); \
        __builtin_amdgcn_global_load_lds((const unsigned*)((const char*)(ptr) + _o1), (PG8_LAS unsigned*)(lds + (bufoff) + ldsw + 8192), 16, 0, 0); } \
        else { PG8_STAGE(bufoff, (ptr) + (half) * hstep, voffA); } } while (0)
#define PG8_LDA(dst, b, h) do { _Pragma("unroll") for (int m = 0; m < 4; ++m) _Pragma("unroll") for (int k = 0; k < 2; ++k) dst[m][k] = *(const PG8_LAS bf16x8*)(lds + PG8_SA(b, h) + aoff + m * 2048 + k * 1024); } while (0)
#define PG8_LDB(dst, b, h) do { _Pragma("unroll") for (int n = 0; n < 2; ++n) _Pragma("unroll") for (int k = 0; k < 2; ++k) dst[n][k] = *(const PG8_LAS bf16x8*)(lds + PG8_SB(b, h) + boff + n * 2048 + k * 1024); } while (0)
#define PG8_MMA(ai, bj, At, Bt) do { __builtin_amdgcn_s_setprio(1); _Pragma("unroll") for (int m = 0; m < 4; ++m) _Pragma("unroll") for (int n = 0; n < 2; ++n) _Pragma("unroll") for (int k = 0; k < 2; ++k) \
        acc[ai][bj][m][n] = __builtin_amdgcn_mfma_f32_16x16x32_bf16(Bt[n][k], At[m][k], acc[ai][bj][m][n], 0, 0, 0); __builtin_amdgcn_s_setprio(0); } while (0)
#define PG8_WAIT_V(n) asm volatile("s_waitcnt vmcnt(" #n ")" ::: "memory")
#define PG8_WAIT_L(n) asm volatile("s_waitcnt lgkmcnt(" #n ")" ::: "memory")
#define PG8_BAR __builtin_amdgcn_s_barrier()
#define PG8_SCHED __builtin_amdgcn_sched_barrier(0)
    Unit cur, nxt; int ui = 0;
    if (!S.next(0, cur)) return;
    f32x4 acc[2][2][4][2];
#pragma unroll
    for (int a = 0; a < 2; ++a)
#pragma unroll
        for (int b = 0; b < 2; ++b)
#pragma unroll
            for (int m = 0; m < 4; ++m)
#pragma unroll
                for (int n = 0; n < 2; ++n) acc[a][b][m][n] = (f32x4){0.f, 0.f, 0.f, 0.f};
    bf16x8 At[4][2], B0[2][2], B1[2][2];
    unsigned gvC[2][2], gvN[2][2]; if constexpr (GATHER) { PG8_GOFF(gvC, cur.pm); PG8_GOFF(gvN, cur.pm); }
    const char* cA = GATHER ? (const char*)g.A : (const char*)g.A + (size_t)cur.pm * tstep; const char* cB = (const char*)g.Bt + (size_t)cur.pn * tstep;
    S.a_ready(cur);
    if constexpr (SP2) {
        PG8_STAGE(PG8_SB(0, 0), cB, voffB); PG8_STAGE(PG8_SB(0, 1), cB + hstep, voffB); PG8_STAGE_A(PG8_SA(0, 0), cA, 0, false); PG8_STAGE_A(PG8_SA(0, 1), cA, 1, false);
        if (wr == 1) PG8_BAR;
        PG8_WAIT_V(2); PG8_BAR;
        PG8_STAGE(PG8_SB(1, 0), cB + kstep, voffB); PG8_STAGE_A(PG8_SA(1, 0), cA + kstep, 0, false); PG8_STAGE(PG8_SB(1, 1), cB + hstep + kstep, voffB);
        PG8_WAIT_V(6); PG8_BAR;
    } else {
        PG8_STAGE(PG8_SB(0, 0), cB, voffB); PG8_STAGE_A(PG8_SA(0, 0), cA, 0, false); PG8_STAGE(PG8_SB(0, 1), cB + hstep, voffB); PG8_STAGE_A(PG8_SA(0, 1), cA, 1, false);
        if (wr == 1) PG8_BAR;
        PG8_WAIT_V(4); PG8_BAR;
        PG8_STAGE(PG8_SB(1, 0), cB + kstep, voffB); PG8_STAGE_A(PG8_SA(1, 0), cA + kstep, 0, false); PG8_STAGE(PG8_SB(1, 1), cB + hstep + kstep, voffB);
        PG8_WAIT_V(6); PG8_BAR;
    }
    for (;;) {
        bool has_next;
        PG8_LAS unsigned char* lslot = lds + 137216 + __builtin_amdgcn_readfirstlane((int)(threadIdx.x >> 6)) * 256;
        if constexpr (Sched::LATE) { has_next = S.next_local(ui + 1, nxt); if (has_next) S.late_issue(nxt, lslot); } else has_next = S.next(ui + 1, nxt);
        if constexpr (GATHER) { if (has_next) { PG8_GOFF(gvN, nxt.pm); } else { _Pragma("unroll") for (int _h = 0; _h < 2; ++_h) { gvN[_h][0] = gvC[_h][0]; gvN[_h][1] = gvC[_h][1]; } } }
        const char* nA = GATHER ? (const char*)g.A : (has_next ? (const char*)g.A + (size_t)nxt.pm * tstep : cA); const char* nB = has_next ? (const char*)g.Bt + (size_t)nxt.pn * tstep : cB;
        for (int t = 0; t < nt; t += 2) {
            const bool last = (t == nt - 2);
            if constexpr (Sched::LATE) { if (last && has_next) { S.late_apply(nxt, lslot); nB = (const char*)g.Bt + (size_t)nxt.pn * tstep; } }
            const char* a1 = cA + (size_t)(t + 1) * kstep;
            const char* a2 = last ? nA : cA + (size_t)(t + 2) * kstep; const char* b2 = last ? nB : cB + (size_t)(t + 2) * kstep;
            const char* a3 = a2 + kstep; const char* b3 = b2 + kstep;
            if (last && has_next) S.a_ready(nxt);
            if constexpr (Epi::PREFETCH) { if (last) E.prefetch(cur); }
            if constexpr (SP2) {
            PG8_LDB(B0, 0, 0); PG8_LDB(B1, 0, 1); PG8_SCHED; PG8_LDA(At, 0, 0); PG8_STAGE_A(PG8_SA(1, 1), a1, 1, false);
            PG8_WAIT_V(8); PG8_WAIT_L(0); PG8_BAR; PG8_MMA(0, 0, At, B0); PG8_MMA(0, 1, At, B1); PG8_BAR; PG8_SCHED;
            PG8_LDA(At, 0, 1); PG8_STAGE(PG8_SB(0, 0), b2, voffB); PG8_STAGE(PG8_SB(0, 1), b2 + hstep, voffB); PG8_STAGE_A(PG8_SA(0, 0), a2, 0, last);
            PG8_WAIT_V(8); PG8_WAIT_L(0); PG8_BAR; PG8_MMA(1, 0, At, B0); PG8_MMA(1, 1, At, B1); PG8_BAR; PG8_SCHED;
            PG8_LDB(B0, 1, 0); PG8_LDB(B1, 1, 1); PG8_SCHED; PG8_LDA(At, 1, 0); PG8_STAGE_A(PG8_SA(0, 1), a2, 1, last);
            PG8_WAIT_V(8); PG8_WAIT_L(0); PG8_BAR; PG8_MMA(0, 0, At, B0); PG8_MMA(0, 1, At, B1); PG8_BAR; PG8_SCHED;
            PG8_LDA(At, 1, 1); PG8_STAGE(PG8_SB(1, 0), b3, voffB); PG8_STAGE(PG8_SB(1, 1), b3 + hstep, voffB); PG8_STAGE_A(PG8_SA(1, 0), a3, 0, last);
            PG8_WAIT_V(8); PG8_WAIT_L(0); PG8_BAR; PG8_MMA(1, 0, At, B0); PG8_MMA(1, 1, At, B1); PG8_BAR; PG8_SCHED;
            } else {
            PG8_LDB(B0, 0, 0); PG8_SCHED; PG8_LDA(At, 0, 0); PG8_STAGE_A(PG8_SA(1, 1), a1, 1, false);
            PG8_WAIT_L(8); PG8_BAR; PG8_WAIT_L(0); PG8_MMA(0, 0, At, B0); PG8_BAR; PG8_SCHED;
            PG8_LDB(B1, 0, 1); PG8_STAGE(PG8_SB(0, 0), b2, voffB);
            PG8_BAR; PG8_WAIT_L(0); PG8_MMA(0, 1, At, B1); PG8_BAR;
            PG8_LDA(At, 0, 1); PG8_STAGE_A(PG8_SA(0, 0), a2, 0, last);
            PG8_BAR; PG8_WAIT_L(0); PG8_MMA(1, 0, At, B0); PG8_BAR; PG8_SCHED;
            PG8_STAGE(PG8_SB(0, 1), b2 + hstep, voffB);
            PG8_WAIT_V(6); PG8_BAR; PG8_MMA(1, 1, At, B1); PG8_BAR;
            PG8_LDB(B0, 1, 0); PG8_SCHED; PG8_LDA(At, 1, 0); PG8_STAGE_A(PG8_SA(0, 1), a2, 1, last);
            PG8_WAIT_L(8); PG8_BAR; PG8_WAIT_L(0); PG8_MMA(0, 0, At, B0); PG8_BAR; PG8_SCHED;
            PG8_LDB(B1, 1, 1); PG8_STAGE(PG8_SB(1, 0), b3, voffB);
            PG8_BAR; PG8_WAIT_L(0); PG8_MMA(0, 1, At, B1); PG8_BAR;
            PG8_LDA(At, 1, 1); PG8_STAGE_A(PG8_SA(1, 0), a3, 0, last);
            PG8_BAR; PG8_WAIT_L(0); PG8_MMA(1, 0, At, B0); PG8_BAR; PG8_SCHED;
            PG8_STAGE(PG8_SB(1, 1), b3 + hstep, voffB);
            PG8_WAIT_V(6); PG8_BAR; PG8_MMA(1, 1, At, B1); PG8_BAR;
            }
        }
        if constexpr (ALIGN_EPI) { if (wr == 0) PG8_BAR; }
        if constexpr (!Epi::AFTER_DRAIN) { E(acc, cur, wr, wc, fr, fq); S.done(cur); }
        if (!has_next) break;
#pragma unroll
        for (int a = 0; a < 2; ++a)
#pragma unroll
            for (int b = 0; b < 2; ++b)
#pragma unroll
                for (int m = 0; m < 4; ++m)
#pragma unroll
                    for (int n = 0; n < 2; ++n) acc[a][b][m][n] = (f32x4){0.f, 0.f, 0.f, 0.f};
        cur = nxt; cA = nA; cB = nB; ++ui;
        if constexpr (GATHER) { _Pragma("unroll") for (int _h = 0; _h < 2; ++_h) { gvC[_h][0] = gvN[_h][0]; gvC[_h][1] = gvN[_h][1]; } }
        if constexpr (ALIGN_EPI) { if (wr == 1) PG8_BAR; }
    }
    PG8_WAIT_V(0);
    if constexpr (!ALIGN_EPI) { if (wr == 0) PG8_BAR; }
    PG8_BAR;
    if constexpr (Epi::AFTER_DRAIN) { E.fused(acc, cur, wr, wc, fr, fq, lds, wid, lane); S.done(cur); }
#undef PG8_SA
#undef PG8_SB
#undef PG8_STAGE
#undef PG8_GOFF
#undef PG8_STAGE_A
#undef PG8_LDA
#undef PG8_LDB
#undef PG8_MMA
#undef PG8_WAIT_V
#undef PG8_WAIT_L
#undef PG8_BAR
#undef PG8_SCHED
}
}
constexpr int NWAVES = 8;
constexpr int BATCH = 2, SEQ = 8192, D = 1024, M = BATCH * SEQ, FF = 3584, NE = 8, MEMT = 256, MROWS = BATCH * MEMT;
constexpr int N_SWA = 1536, N_RET = 2560, N_MLS = 2560, MLS_SRC = 2568;
constexpr int MAXSLOT = 2 * M + NE * 256;
constexpr int NPHASE = 32;
#ifndef DBL_MASK
#define DBL_MASK 0ull
#endif
#ifndef DBL_REPS
#define DBL_REPS 1
#endif
#define PROF_MASK 0ull
#define PROF_SEC -1
#define PROF_AMP 10
#define TB(id) do { if (PROF_SEC == (id)) C.pt0 = rt(); } while (0)
#define TE(id) do { if (PROF_SEC == (id)) C.pacc += rt() - C.pt0; } while (0)
#ifndef MK_SINGLE
#define MK_SINGLE 1
#endif
constexpr size_t MiB = 1u << 20, KiB = 1024;
constexpr size_t WS_CTL = 0, CTL_ZERO_BYTES = 32 * KiB;
constexpr size_t WS_SS = 1 * MiB, WS_MEMN = 2 * MiB, WS_MKV = 3 * MiB, WS_ROUTE = 5 * MiB;
constexpr size_t RT_SEL = 0, RT_RSTD = 256 * KiB, RT_CNT = 320 * KiB, RT_PANEL = 328 * KiB, RT_NP = 329 * KiB, RT_TOKSLOT = 384 * KiB, RT_ROWTOK = 512 * KiB, RT_SLOTRS = 704 * KiB, RT_TAILIDX = 896 * KiB, RT_GATES = 1 * MiB, RT_AUXG = 2304 * KiB;
constexpr size_t WS_WIN = 8 * MiB, WS_WOUT = 24 * MiB, WS_WMEM = 32 * MiB, WS_WFD = 36 * MiB, WS_WMOE = 78 * MiB;
constexpr size_t WIN_OFF[4] = {0, 3 * MiB, 8 * MiB, 13 * MiB};
constexpr size_t FD_STRIDE = 21 * MiB, FD_WD = 14 * MiB, MOE_STRIDE = 168 * MiB, MOE_WD = 112 * MiB;
constexpr size_t WS_HB = 414 * MiB, WS_BIG = 446 * MiB, WS_Y = 684 * MiB, WS_SLAB = 820 * MiB, WS_END = 876 * MiB;
constexpr size_t BIG_P = 0, BIG_MIX = 80 * MiB, BIG_SCR1 = 112 * MiB, BIG_SCR2 = 160 * MiB;
constexpr int CW_BAR = 4096;
constexpr int RING_OFF = 0, RING_BYTES = 163328;
constexpr int LDSCTL_OFF = RING_BYTES, MISC_OFF = LDSCTL_OFF + 320;
constexpr int LDS_BYTES = 163840;


#define GAS __attribute__((address_space(1)))
#define LAS __attribute__((address_space(3)))
typedef unsigned short bf16;
typedef unsigned v4u __attribute__((ext_vector_type(4)));
typedef float f32x4 __attribute__((ext_vector_type(4)));
typedef short bf16x8 __attribute__((ext_vector_type(8)));
typedef GAS unsigned gu32;
typedef GAS unsigned long long gu64;
#define RLX_AGENT __ATOMIC_RELAXED, __HIP_MEMORY_SCOPE_AGENT
#define LDS_WAIT() asm volatile("s_waitcnt lgkmcnt(0)" ::: "memory")
#define VM_WAIT() asm volatile("s_waitcnt vmcnt(0)" ::: "memory")
__device__ __forceinline__ unsigned long long rt() { return __builtin_amdgcn_s_memrealtime(); }
__device__ __forceinline__ unsigned f2bf(float f) { unsigned u = __builtin_bit_cast(unsigned, f); return (u + 0x7fffu + ((u >> 16) & 1u)) >> 16; }
__device__ __forceinline__ unsigned pk2(float lo, float hi) { return f2bf(lo) | (f2bf(hi) << 16); }

#define XB_TMO      128
#define XB_XCNT(j)  (256  + 64 * (j))
#define XB_XSUB(j)  (1280 + 64 * (j))
#define XB_XGEN(j)  (2304 + 64 * (j))
#define XB_TOP      3328
#define XB_TOPGEN   3392
#define XCD_BAR_WORDS 3456
#define XB_SPIN_CAP (1u << 18)

__device__ __forceinline__ unsigned xb_ld(unsigned* p)              { return __hip_atomic_load(p, __ATOMIC_RELAXED, __HIP_MEMORY_SCOPE_AGENT); }
__device__ __forceinline__ unsigned xb_add(unsigned* p, unsigned v) { return __hip_atomic_fetch_add(p, v, __ATOMIC_RELAXED, __HIP_MEMORY_SCOPE_AGENT); }
__device__ __forceinline__ unsigned xb_xcc_id() { return (unsigned)__builtin_amdgcn_s_getreg((3 << 11) | 20) & 0xFu; }
#define XB_SPIN(cond, bar) do { unsigned _sp = 0; while (cond) { __builtin_amdgcn_s_sleep(1); \
    if ((++_sp & 255u) == 0u) { if (xb_ld(&(bar)[XB_TMO])) break; if (_sp > XB_SPIN_CAP) { atomicAdd(&(bar)[XB_TMO], 1u); break; } } } } while (0)

struct XcdBarrier {
    unsigned* bar; unsigned x;
    volatile LAS unsigned* st;
};

__device__ __forceinline__ XcdBarrier xcd_barrier_post(unsigned* bar, volatile LAS unsigned* st) {
    XcdBarrier b; b.bar = bar; b.x = xb_xcc_id(); b.st = st;
    if (threadIdx.x == 0) (void)xb_add(&bar[XB_XCNT(b.x)], 1u);
    return b;
}
__device__ __forceinline__ void xcd_barrier_complete(unsigned* bar, unsigned x, unsigned& nloc, unsigned& nx) {
    const unsigned G = gridDim.x * gridDim.y * gridDim.z;
    unsigned sum, cnt, mine, sp = 0u;
    for (;;) {
        sum = 0u; cnt = 0u; mine = 0u;
#pragma unroll
        for (unsigned j = 0; j < 16; ++j) { const unsigned c = xb_ld(&bar[XB_XCNT(j)]); sum += c; cnt += (c > 0u) ? 1u : 0u; mine = (j == x) ? c : mine; }
        if (sum == G) break;
        __builtin_amdgcn_s_sleep(1);
        if ((++sp & 255u) == 0u) { if (xb_ld(&bar[XB_TMO])) break; if (sp > XB_SPIN_CAP) { atomicAdd(&bar[XB_TMO], 1u); break; } }
    }
    nloc = mine > 0u ? mine : 1u; nx = cnt > 0u ? cnt : 1u;
}

__device__ __forceinline__ void xcd_barrier(const XcdBarrier& b) {
    asm volatile("s_waitcnt vmcnt(0)" ::: "memory");
    __syncthreads();
    if (threadIdx.x == 0) {
        unsigned* bar = b.bar;
        __builtin_amdgcn_s_waitcnt(0);
        unsigned nloc = b.st[0], nx = b.st[1];
        if (nloc == 0u) { xcd_barrier_complete(bar, b.x, nloc, nx); b.st[0] = nloc; b.st[1] = nx; }
        const unsigned old = xb_add(&bar[XB_XSUB(b.x)], 1u);
        const unsigned gen = old / nloc;
        if (old + 1u == (gen + 1u) * nloc) {
            __builtin_amdgcn_fence(__ATOMIC_RELEASE, "agent");
            asm volatile("s_waitcnt vmcnt(0)" ::: "memory");
            const unsigned og = xb_add(&bar[XB_TOP], 1u);
            const unsigned tg = og / nx;
            if (og + 1u == (tg + 1u) * nx) xb_add(&bar[XB_TOPGEN], 1u);
            else XB_SPIN(xb_ld(&bar[XB_TOPGEN]) == tg, bar);
            __builtin_amdgcn_fence(__ATOMIC_ACQUIRE, "agent");
            xb_add(&bar[XB_XGEN(b.x)], 1u);
            asm volatile("s_waitcnt vmcnt(0)" ::: "memory");
        } else {
            XB_SPIN(xb_ld(&bar[XB_XGEN(b.x)]) == gen, bar);
            __builtin_amdgcn_fence(__ATOMIC_ACQUIRE, "agent");
            asm volatile("s_waitcnt vmcnt(0)" ::: "memory");
        }
    }
    __syncthreads();
}


typedef unsigned v2u __attribute__((ext_vector_type(2)));
__device__ __forceinline__ float bflo(unsigned w) { return __uint_as_float(w << 16); }
__device__ __forceinline__ float bfhi(unsigned w) { return __uint_as_float(w & 0xffff0000u); }
__device__ __forceinline__ float wave_sum(float v) {
#pragma unroll
    for (int o = 1; o < 64; o <<= 1) v += __shfl_xor(v, o);
    return v;
}
__device__ __forceinline__ float silu1(float x) { return x * __builtin_amdgcn_rcpf(1.0f + __expf(-x)); }
__device__ __forceinline__ float sigmoid1(float x) { return __builtin_amdgcn_rcpf(1.0f + __expf(-x)); }

struct Ctx {
    LAS unsigned char* lds;
    int tid, lane, wave, gw, NGW, G, bid;
    const float* in[27];
    float* out;
    unsigned char* ws;
    unsigned long long pacc, pt0;
};
#define WSP(T, off) ((T*)(C.ws + (off)))

__device__ __forceinline__ unsigned cvt2(float lo, float hi) { unsigned r; asm volatile("v_cvt_pk_bf16_f32 %0, %1, %2" : "=v"(r) : "v"(lo), "v"(hi)); return r; }
struct TpDesc { const float* W; bf16* WT; const float* gain; int ldw, K, csrc0, drow0, mode, kb, nb; };
__device__ __forceinline__ void tp_decode(Ctx& C, int tile, TpDesc& d) {
    constexpr int T_FFN = 54 * 224, T_IN = 512, T_OUT = 256;
    d.gain = nullptr; d.csrc0 = 0; d.drow0 = 0; d.mode = 0;
    if (tile < T_FFN) {
        const int job = tile / 224, r = tile % 224; int which;
        if (job < 6) { const int j = job / 3; which = job % 3; unsigned char* base = C.ws + WS_WFD + j * FD_STRIDE;
            if (which < 2) { d.W = (which == 0 ? C.in[20] : C.in[21]) + (size_t)j * D * FF; d.WT = (bf16*)base; d.gain = C.in[8] + (2 * j) * D; }
            else { d.W = C.in[22] + (size_t)j * FF * D; d.WT = (bf16*)(base + FD_WD); }
        } else { const int q = job - 6, j = q / 24, e = (q % 24) / 3; which = q % 3; unsigned char* base = C.ws + WS_WMOE + j * MOE_STRIDE;
            if (which < 2) { d.W = (which == 0 ? C.in[24] : C.in[25]) + (size_t)(j * NE + e) * D * FF; d.WT = (bf16*)base + (size_t)e * 7168 * D; d.gain = C.in[8] + (2 * j + 1) * D; }
            else { d.W = C.in[26] + (size_t)(j * NE + e) * FF * D; d.WT = (bf16*)(base + MOE_WD) + (size_t)e * D * FF; }
        }
        if (which < 2) { d.ldw = FF; d.K = D; d.drow0 = which ? 128 : 0; d.mode = 1; d.kb = r / 14; d.nb = r % 14; }
        else { d.ldw = D; d.K = FF; d.kb = r / 4; d.nb = r % 4; }
    } else if (tile < T_FFN + T_IN) {
        int r = tile - T_FFN; d.K = D;
        if (r < 96) { d.W = C.in[9]; d.ldw = N_SWA; d.WT = WSP(bf16, WS_WIN + WIN_OFF[0]); d.gain = C.in[2] + 0 * D; d.kb = r / 6; d.nb = r % 6; }
        else if ((r -= 96) < 160) { d.W = C.in[13]; d.ldw = N_RET; d.WT = WSP(bf16, WS_WIN + WIN_OFF[1]); d.gain = C.in[2] + 1 * D; d.kb = r / 10; d.nb = r % 10; }
        else if ((r -= 160) < 144) { d.W = C.in[14]; d.ldw = MLS_SRC; d.WT = WSP(bf16, WS_WIN + WIN_OFF[2]); d.gain = C.in[2] + 2 * D; d.kb = r / 9; d.nb = r % 9; }
        else if ((r -= 144) < 16) { d.W = C.in[14]; d.ldw = MLS_SRC; d.csrc0 = 2312; d.drow0 = 2304; d.WT = WSP(bf16, WS_WIN + WIN_OFF[2]); d.gain = C.in[2] + 2 * D; d.kb = r; d.nb = 0; }
        else { r -= 16; d.W = C.in[9] + (size_t)D * N_SWA; d.ldw = N_SWA; d.WT = WSP(bf16, WS_WIN + WIN_OFF[3]); d.gain = C.in[2] + 3 * D; d.kb = r / 6; d.nb = r % 6; }
    } else if (tile < T_FFN + T_IN + T_OUT) {
        const int r = tile - T_FFN - T_IN, l = r >> 6, q = r & 63;
        d.W = C.in[7] + (size_t)l * D * D; d.ldw = D; d.K = D; d.WT = WSP(bf16, WS_WOUT + (size_t)l * 2 * MiB); d.kb = q >> 2; d.nb = q & 3;
    } else {
        const int r = tile - T_FFN - T_IN - T_OUT, l = r >> 5, q = r & 31;
        d.W = C.in[4] + (size_t)l * D * 512; d.ldw = 512; d.K = D; d.WT = WSP(bf16, WS_WMEM); d.drow0 = 512 * l; d.gain = C.in[3] + l * D; d.kb = q >> 1; d.nb = q & 1;
    }
}
__device__ __forceinline__ void tp_load(Ctx& C, const TpDesc& d, f32x4 (&v)[8], f32x4 (&gn)[2]) {
    const int k0 = d.kb * 64 + 8 * C.wave, n = d.nb * 256 + 4 * C.lane;
    if (d.gain) { gn[0] = *(const GAS f32x4*)(d.gain + k0); gn[1] = *(const GAS f32x4*)(d.gain + k0 + 4); }
#pragma unroll
    for (int kk = 0; kk < 8; ++kk) v[kk] = __builtin_nontemporal_load((const GAS f32x4*)(d.W + (size_t)(k0 + kk) * d.ldw + d.csrc0 + n));
}
constexpr int TP_ALL = 54 * 224 + 512 + 256 + 128;
constexpr int TP_WIN_N = 896, TP_MOVED_LO = 30 * 224, TP_MOVED_N = 3 * TP_WIN_N;
__device__ __forceinline__ void tp_run(Ctx& C, int first, int stride, int count, int skip_lo, int skip_len) {
    constexpr int TP_LD = 144, TP_BUF = 256 * TP_LD;
    TpDesc da, db; f32x4 va[8], vb[8], ga[2], gb[2]; int buf = 0;
    int tile = first;
    __syncthreads();
    if (tile < count) { tp_decode(C, tile >= skip_lo ? tile + skip_len : tile, da); tp_load(C, da, va, ga); }
    if (tile + stride < count) { const int t1 = tile + stride; tp_decode(C, t1 >= skip_lo ? t1 + skip_len : t1, db); tp_load(C, db, vb, gb); }
#define TP_STEP(d, v, gn) { LAS unsigned char* Lb = C.lds + RING_OFF + buf * TP_BUF; \
        if (d.gain) { _Pragma("unroll") for (int kk = 0; kk < 8; ++kk) v[kk] = v[kk] * gn[kk >> 2][kk & 3]; } \
        _Pragma("unroll") for (int c = 0; c < 4; ++c) { v4u o; o.x = cvt2(v[0][c], v[1][c]); o.y = cvt2(v[2][c], v[3][c]); o.z = cvt2(v[4][c], v[5][c]); o.w = cvt2(v[6][c], v[7][c]); \
            *(LAS v4u*)(Lb + (4 * C.lane + c) * TP_LD + 16 * C.wave) = o; } \
        const TpDesc dc = d; const int nx = tile + 2 * stride; \
        if (nx < count) { tp_decode(C, nx >= skip_lo ? nx + skip_len : nx, d); tp_load(C, d, v, gn); } \
        __syncthreads(); \
        _Pragma("unroll") for (int q = 0; q < 4; ++q) { const int id = C.tid + 512 * q, row = id >> 3, pc = id & 7; const int n = dc.nb * 256 + row; \
            const int drow = dc.mode ? dc.drow0 + (n >> 7) * 256 + (n & 127) : dc.drow0 + n; \
            __builtin_nontemporal_store(*(const LAS v4u*)(Lb + row * TP_LD + 16 * pc), (GAS v4u*)(dc.WT + (size_t)drow * dc.K + dc.kb * 64 + 8 * pc)); } \
        tile += stride; buf ^= 1; }
    while (tile < count) { TP_STEP(da, va, ga) if (tile >= count) break; TP_STEP(db, vb, gb) }
#undef TP_STEP
    __syncthreads();
}
__device__ __forceinline__ void p_prologue(Ctx& C) {
    if (C.G == 256) tp_run(C, C.bid, C.G, TP_ALL - TP_MOVED_N, TP_MOVED_LO, TP_MOVED_N); else tp_run(C, C.bid, C.G, TP_ALL, 1 << 30, 0);
    for (int m0 = C.gw; m0 < M; m0 += 4 * C.NGW) {
        f32x4 xv[4][4];
#pragma unroll
        for (int u = 0; u < 4; ++u) { const int m = m0 + u * C.NGW; if (m < M) { const GAS f32x4* xr = (const GAS f32x4*)(C.in[0] + (size_t)m * D) + C.lane;
#pragma unroll
            for (int j = 0; j < 4; ++j) xv[u][j] = __builtin_nontemporal_load(xr + 64 * j); } }
#pragma unroll
        for (int u = 0; u < 4; ++u) { const int m = m0 + u * C.NGW; if (m < M) {
            GAS unsigned long long* o8 = (GAS unsigned long long*)(WSP(bf16, WS_HB) + (size_t)m * D) + C.lane; float s = 0.f;
#pragma unroll
            for (int j = 0; j < 4; ++j) { const f32x4 v = xv[u][j]; s += (v.x * v.x + v.y * v.y) + (v.z * v.z + v.w * v.w);
                o8[64 * j] = (unsigned long long)pk2(v.x, v.y) | ((unsigned long long)pk2(v.z, v.w) << 32); }
            s = wave_sum(s);
            if (C.lane < 4) WSP(float, WS_SS)[(size_t)m * 4 + C.lane] = C.lane == 0 ? s : 0.f; } }
    }
    for (int m = C.gw; m < MROWS; m += C.NGW) {
        const GAS f32x4* xr = (const GAS f32x4*)(C.in[1] + (size_t)m * D) + C.lane; f32x4 v[4]; float s = 0.f;
#pragma unroll
        for (int j = 0; j < 4; ++j) { v[j] = xr[64 * j]; s += (v[j].x * v[j].x + v[j].y * v[j].y) + (v[j].z * v[j].z + v[j].w * v[j].w); }
        const float rs = 1.0f / sqrtf(wave_sum(s) * (1.0f / D) + 1e-6f);
        GAS unsigned long long* o8 = (GAS unsigned long long*)(WSP(bf16, WS_MEMN) + (size_t)m * D) + C.lane;
#pragma unroll
        for (int j = 0; j < 4; ++j) o8[64 * j] = (unsigned long long)pk2(v[j].x * rs, v[j].y * rs) | ((unsigned long long)pk2(v[j].z * rs, v[j].w * rs) << 32);
    }
}

__device__ __forceinline__ void ld8(const bf16* p, float (&f)[8]) { const v4u w = *(const GAS v4u*)p; f[0] = bflo(w.x); f[1] = bfhi(w.x); f[2] = bflo(w.y); f[3] = bfhi(w.y); f[4] = bflo(w.z); f[5] = bfhi(w.z); f[6] = bflo(w.w); f[7] = bfhi(w.w); }
__device__ __forceinline__ void load_w8(const float* gain, const float* W, int ldw, int c0, int lane, float (&RW)[16][8]) {
#pragma unroll
    for (int j = 0; j < 2; ++j)
#pragma unroll
        for (int i = 0; i < 8; ++i) { const int k = 8 * lane + 512 * j + i; const float gk = gain[k]; const float* wp = W + (size_t)k * ldw + c0;
#pragma unroll
            for (int e = 0; e < 8; ++e) RW[j * 8 + i][e] = gk * wp[e]; }
}
__device__ __forceinline__ void dots8(const bf16* hrow, const float (&RW)[16][8], int lane, float (&out)[8], float& rstd) {
    float acc[8]; float ss = 0.f;
#pragma unroll
    for (int e = 0; e < 8; ++e) acc[e] = 0.f;
#pragma unroll
    for (int j = 0; j < 2; ++j) { float hv[8]; ld8(hrow + 8 * lane + 512 * j, hv);
#pragma unroll
        for (int i = 0; i < 8; ++i) { ss += hv[i] * hv[i];
#pragma unroll
            for (int e = 0; e < 8; ++e) acc[e] += hv[i] * RW[j * 8 + i][e]; } }
    rstd = 1.0f / sqrtf(wave_sum(ss) * (1.0f / D) + 1e-6f);
#pragma unroll
    for (int e = 0; e < 8; ++e) out[e] = wave_sum(acc[e]) * rstd;
}
__device__ __forceinline__ void dots8_x4(Ctx& C, int m0, const float (&RW)[16][8], float& val, float& rs) {
    const int lane = C.lane; v4u raw[4][2];
#pragma unroll
    for (int t = 0; t < 4; ++t) { const bf16* hrow = WSP(bf16, WS_HB) + (size_t)(m0 + t) * D; raw[t][0] = *(const GAS v4u*)(hrow + 8 * lane); raw[t][1] = *(const GAS v4u*)(hrow + 8 * lane + 512); }
    float acc[32], ss[4];
#pragma unroll
    for (int t = 0; t < 4; ++t) { ss[t] = 0.f;
#pragma unroll
        for (int e = 0; e < 8; ++e) acc[t * 8 + e] = 0.f;
#pragma unroll
        for (int jj = 0; jj < 2; ++jj) { const v4u w = raw[t][jj]; const float hv[8] = {bflo(w.x), bfhi(w.x), bflo(w.y), bfhi(w.y), bflo(w.z), bfhi(w.z), bflo(w.w), bfhi(w.w)};
#pragma unroll
            for (int i = 0; i < 8; ++i) { ss[t] += hv[i] * hv[i];
#pragma unroll
                for (int e = 0; e < 8; ++e) acc[t * 8 + e] += hv[i] * RW[jj * 8 + i][e]; } } }
#pragma unroll
    for (int s = 0; s < 5; ++s) { const int d = 1 << s, hn = 16 >> s; const bool up = (lane & d) != 0;
#pragma unroll
        for (int q = 0; q < hn; ++q) { const float send = up ? acc[q] : acc[q + hn], keep = up ? acc[q + hn] : acc[q]; acc[q] = keep + __shfl_xor(send, d); } }
    const float lsum = acc[0] + __shfl_xor(acc[0], 32);
    { const bool up0 = (lane & 1) != 0; const float s0 = (up0 ? ss[2] : ss[0]) + __shfl_xor(up0 ? ss[0] : ss[2], 1), s1 = (up0 ? ss[3] : ss[1]) + __shfl_xor(up0 ? ss[1] : ss[3], 1);
      const bool up1 = (lane & 2) != 0; ss[0] = (up1 ? s1 : s0) + __shfl_xor(up1 ? s0 : s1, 2); }
    float sst = ss[0];
#pragma unroll
    for (int d = 4; d < 64; d <<= 1) sst += __shfl_xor(sst, d);
    rs = 1.0f / sqrtf(sst * (1.0f / D) + 1e-6f); val = lsum * rs;
}
__device__ __forceinline__ void mls_gates(Ctx& C) {
    const bool half = (C.G == 256); if (half && C.bid < 128) return;
    const int gw = half ? (C.bid - 128) * NWAVES + C.wave : C.gw, ngw = half ? 128 * NWAVES : C.NGW;
    float* GT = WSP(float, WS_ROUTE + RT_GATES); float RW[16][8];
    load_w8(C.in[2] + 2 * D, C.in[14], MLS_SRC, 2304, C.lane, RW);
    const int tk = ((C.lane & 1) << 1) | ((C.lane >> 1) & 1), ex = (((C.lane >> 2) & 1) << 2) | (((C.lane >> 3) & 1) << 1) | ((C.lane >> 4) & 1);
    for (int m0 = 4 * gw; m0 < M; m0 += 4 * ngw) { float val, rs; dots8_x4(C, m0, RW, val, rs);
        if (C.lane < 32) GT[(size_t)(m0 + tk) * 8 + ex] = val; }
}
__device__ __forceinline__ void mls_conv(Ctx& C, const bf16* P, bf16* QKC) {
    const float* cw = C.in[15]; const float* cb = C.in[16];
    const int nthr = C.G * NWAVES * 64, gt = C.bid * NWAVES * 64 + C.tid;
    for (int e = gt; e < (M / 16) * 96; e += nthr) { const int seg = e / 96, c0 = (e % 96) * 8, m0 = seg * 16; const bool first = (m0 & (SEQ - 1)) == 0;
        v4u raw[19];
#pragma unroll
        for (int r = 0; r < 19; ++r) { if (r >= 3 || !first) raw[r] = *(const GAS v4u*)(P + (size_t)(m0 - 3 + r) * N_MLS + c0); else raw[r] = (v4u){0u, 0u, 0u, 0u}; }
        float wv[4][8], bv[8];
#pragma unroll
        for (int j = 0; j < 4; ++j) { const f32x4 a = *(const GAS f32x4*)(cw + j * 768 + c0), b2 = *(const GAS f32x4*)(cw + j * 768 + c0 + 4);
            wv[j][0] = a.x; wv[j][1] = a.y; wv[j][2] = a.z; wv[j][3] = a.w; wv[j][4] = b2.x; wv[j][5] = b2.y; wv[j][6] = b2.z; wv[j][7] = b2.w; }
        { const f32x4 a = *(const GAS f32x4*)(cb + c0), b2 = *(const GAS f32x4*)(cb + c0 + 4); bv[0] = a.x; bv[1] = a.y; bv[2] = a.z; bv[3] = a.w; bv[4] = b2.x; bv[5] = b2.y; bv[6] = b2.z; bv[7] = b2.w; }
        const float sc = c0 >= 384 ? 0.10206207261596577f : 1.0f;
#pragma unroll
        for (int r = 0; r < 16; ++r) { float acc[8];
#pragma unroll
            for (int i = 0; i < 8; ++i) acc[i] = bv[i];
#pragma unroll
            for (int j = 0; j < 4; ++j) { const v4u w = raw[r + j]; const float x[8] = {bflo(w.x), bfhi(w.x), bflo(w.y), bfhi(w.y), bflo(w.z), bfhi(w.z), bflo(w.w), bfhi(w.w)};
#pragma unroll
                for (int i = 0; i < 8; ++i) acc[i] += wv[j][i] * x[i]; }
#pragma unroll
            for (int i = 0; i < 8; ++i) acc[i] = silu1(acc[i]) * sc;
            v4u o; o.x = pk2(acc[0], acc[1]); o.y = pk2(acc[2], acc[3]); o.z = pk2(acc[4], acc[5]); o.w = pk2(acc[6], acc[7]);
            *(GAS v4u*)(QKC + (size_t)(m0 + r) * 768 + c0) = o; }
    }
}
__device__ __forceinline__ bool r1_better(float va, int ea, float vb, int eb) { return va > vb || (va == vb && ea < eb); }
__device__ __forceinline__ void moe_route1(Ctx& C, int j, int layer) {
    f32x4* SEL = WSP(f32x4, WS_ROUTE + RT_SEL); float* RSTD = WSP(float, WS_ROUTE + RT_RSTD); int* CNT = WSP(int, WS_ROUTE + RT_CNT);
    LAS int* lc = (LAS int*)(C.lds + RING_OFF); float RW[16][8]; const int lane = C.lane;
    load_w8(C.in[8] + layer * D, C.in[23] + (size_t)j * D * NE, NE, 0, lane, RW);
    for (int chunk = C.bid; chunk < M / 64; chunk += C.G) {
        __syncthreads();
        if (C.tid < 8) lc[C.tid] = 0;
        __syncthreads();
#pragma unroll 1
        for (int grp = 0; grp < 2; ++grp) {
            const int m0 = chunk * 64 + C.wave * 8 + grp * 4;
            float lval, rs; dots8_x4(C, m0, RW, lval, rs);
            const int tk = ((lane & 1) << 1) | ((lane >> 1) & 1), ex = (((lane >> 2) & 1) << 2) | (((lane >> 3) & 1) << 1) | ((lane >> 4) & 1);
            float v1 = lval, v2 = -3.0e38f; int e1 = ex, e2 = 8;
#pragma unroll
            for (int d = 4; d <= 16; d <<= 1) { const float pv1 = __shfl_xor(v1, d), pv2 = __shfl_xor(v2, d); const int pe1 = __shfl_xor(e1, d), pe2 = __shfl_xor(e2, d);
                float n1, n2; int f1, f2;
                if (r1_better(v1, e1, pv1, pe1)) { n1 = v1; f1 = e1; if (r1_better(v2, e2, pv1, pe1)) { n2 = v2; f2 = e2; } else { n2 = pv1; f2 = pe1; } }
                else { n1 = pv1; f1 = pe1; if (r1_better(v1, e1, pv2, pe2)) { n2 = v1; f2 = e1; } else { n2 = pv2; f2 = pe2; } }
                v1 = n1; e1 = f1; v2 = n2; e2 = f2; }
            if (lane < 4) { const int mm = m0 + tk; const float w1 = 1.0f / (1.0f + __expf(v2 - v1)), w2 = 1.0f - w1;
                f32x4 s; s.x = __int_as_float(e1); s.y = __int_as_float(e2); s.z = w1; s.w = w2; SEL[mm] = s; RSTD[mm] = rs; atomicAdd((int*)&lc[e1], 1); atomicAdd((int*)&lc[e2], 1); }
        }
        __syncthreads();
        if (C.tid < 8) CNT[chunk * 8 + C.tid] = lc[C.tid];
    }
}
__device__ __forceinline__ void moe_route2(Ctx& C) {
    const f32x4* SEL = WSP(f32x4, WS_ROUTE + RT_SEL); const float* RSTD = WSP(float, WS_ROUTE + RT_RSTD); const int* CNT = WSP(int, WS_ROUTE + RT_CNT);
    int* PANEL = WSP(int, WS_ROUTE + RT_PANEL); int* NP = WSP(int, WS_ROUTE + RT_NP); int* TOKSLOT = WSP(int, WS_ROUTE + RT_TOKSLOT); float* SLOTRS = WSP(float, WS_ROUTE + RT_SLOTRS); int* ROWTOK = WSP(int, WS_ROUTE + RT_ROWTOK);
    if (C.wave != 0) return;
    for (int chunk = C.bid; chunk < M / 64; chunk += C.G) {
        const int e = C.lane & 7, sub = C.lane >> 3; int tot = 0, pre = 0;
        const int mtok = chunk * 64 + C.lane; const f32x4 stok = SEL[mtok]; const float rstok = RSTD[mtok];
        int cv[32];
#pragma unroll
        for (int q = 0; q < 32; ++q) cv[q] = CNT[(sub + 8 * q) * 8 + e];
#pragma unroll
        for (int q = 0; q < 32; ++q) { tot += cv[q]; pre += (sub + 8 * q < chunk) ? cv[q] : 0; }
        tot += __shfl_xor(tot, 8); tot += __shfl_xor(tot, 16); tot += __shfl_xor(tot, 32);
        pre += __shfl_xor(pre, 8); pre += __shfl_xor(pre, 16); pre += __shfl_xor(pre, 32);
        const int np = (tot + 255) >> 8; int pstart = 0;
#pragma unroll
        for (int k = 0; k < 8; ++k) { const int v = __shfl(np, k); pstart += (k < e) ? v : 0; }
        const int mybase = pstart * 256 + pre;
        if (chunk == 0) { int* TAILIDX = WSP(int, WS_ROUTE + RT_TAILIDX); for (int q = C.lane; q < 576; q += 64) TAILIDX[q] = -1;
            if (C.lane < 8) { for (int p = 0; p < np; ++p) PANEL[pstart + p] = e; if (e == 7) NP[0] = pstart + np; }
            for (int sl = pstart * 256 + tot + sub; sl < (pstart + np) * 256; sl += 8) { ROWTOK[sl] = 0; SLOTRS[sl] = 0.f; } }
        const int m = mtok; const f32x4 s = stok; const int e1 = __float_as_int(s.x), e2 = __float_as_int(s.y);
        const unsigned long long lt = (1ull << C.lane) - 1ull; int s1 = 0, s2 = 0;
#pragma unroll
        for (int ee = 0; ee < 8; ++ee) { const unsigned long long both = __ballot(e1 == ee) | __ballot(e2 == ee); const int r = __popcll(both & lt); const int be = __shfl(mybase, ee);
            if (e1 == ee) s1 = be + r; if (e2 == ee) s2 = be + r; }
        TOKSLOT[2 * m] = s1; TOKSLOT[2 * m + 1] = s2; const float rs = rstok; SLOTRS[s1] = rs; SLOTRS[s2] = rs; ROWTOK[s1] = m; ROWTOK[s2] = m;
    }
}
struct CombRow { unsigned long long hw[4]; v2u y1[4], y2[4]; };
__device__ __forceinline__ f32x4 slab_sum(const float* SLAB, int tl, int slot, int lane) {
    const float* sp = SLAB + (size_t)tl * 7 * 65536 + (size_t)(slot & 255) * 256 + 4 * lane; f32x4 a = *(const GAS f32x4*)sp;
#pragma unroll
    for (int k = 1; k < 7; ++k) a = a + *(const GAS f32x4*)(sp + (size_t)k * 65536);
    return a;
}
template <bool FINAL>
__device__ __forceinline__ void moe_combine(Ctx& C) {
    const f32x4* SEL = WSP(f32x4, WS_ROUTE + RT_SEL); const int* TOKSLOT = WSP(int, WS_ROUTE + RT_TOKSLOT); const bf16* Y = WSP(bf16, WS_Y);
    const float* SLAB = WSP(float, WS_SLAB); const int* TAILIDX = WSP(int, WS_ROUTE + RT_TAILIDX); const int lane = C.lane;
    typedef int i32x4 __attribute__((ext_vector_type(4)));
    for (int base = C.gw; base < M; base += 8 * C.NGW) {
        const int mrow = base + (lane & 7) * C.NGW; const bool okl = mrow < M; const int mr = okl ? mrow : base;
        const f32x4 sel = SEL[mr]; const int s1l = TOKSLOT[2 * mr], s2l = TOKSLOT[2 * mr + 1];
        const i32x4 t1l = *(const GAS i32x4*)(TAILIDX + (s1l >> 8) * 4), t2l = *(const GAS i32x4*)(TAILIDX + (s2l >> 8) * 4);
#pragma unroll
        for (int k0 = 0; k0 < 8; k0 += 2) {
            CombRow R[2]; int mm[2], s1[2], s2[2], tl1[2][4], tl2[2][4]; float w1[2], w2[2]; bool ok[2];
#pragma unroll
            for (int u = 0; u < 2; ++u) { const int k = k0 + u; mm[u] = base + k * C.NGW; ok[u] = mm[u] < M;
                s1[u] = __shfl(s1l, k); s2[u] = __shfl(s2l, k); w1[u] = __shfl(sel.z, k); w2[u] = __shfl(sel.w, k);
#pragma unroll
                for (int jj = 0; jj < 4; ++jj) { tl1[u][jj] = __shfl(t1l[jj], k); tl2[u][jj] = __shfl(t2l[jj], k); }
                if (ok[u]) { const GAS unsigned long long* o8 = (const GAS unsigned long long*)(WSP(bf16, WS_HB) + (size_t)mm[u] * D) + lane;
#pragma unroll
                    for (int jj = 0; jj < 4; ++jj) { R[u].hw[jj] = o8[64 * jj];
                        R[u].y1[jj] = tl1[u][jj] < 0 ? __builtin_nontemporal_load((const GAS v2u*)(Y + (size_t)s1[u] * D + 256 * jj + 4 * lane)) : (v2u){0u, 0u};
                        R[u].y2[jj] = tl2[u][jj] < 0 ? __builtin_nontemporal_load((const GAS v2u*)(Y + (size_t)s2[u] * D + 256 * jj + 4 * lane)) : (v2u){0u, 0u}; } } }
#pragma unroll
            for (int u = 0; u < 2; ++u) if (ok[u]) {
                GAS unsigned long long* o8 = (GAS unsigned long long*)(WSP(bf16, WS_HB) + (size_t)mm[u] * D) + lane; float ss = 0.f;
#pragma unroll
                for (int jj = 0; jj < 4; ++jj) { const unsigned lo = (unsigned)R[u].hw[jj], hi = (unsigned)(R[u].hw[jj] >> 32);
                    f32x4 v = (f32x4){bflo(lo), bfhi(lo), bflo(hi), bfhi(hi)};
                    f32x4 a = (f32x4){bflo(R[u].y1[jj].x), bfhi(R[u].y1[jj].x), bflo(R[u].y1[jj].y), bfhi(R[u].y1[jj].y)}; if (tl1[u][jj] >= 0) a = slab_sum(SLAB, tl1[u][jj], s1[u], lane);
                    f32x4 b2 = (f32x4){bflo(R[u].y2[jj].x), bfhi(R[u].y2[jj].x), bflo(R[u].y2[jj].y), bfhi(R[u].y2[jj].y)}; if (tl2[u][jj] >= 0) b2 = slab_sum(SLAB, tl2[u][jj], s2[u], lane);
                    v = v + (a * w1[u] + b2 * w2[u]);
                    if (FINAL) { ((GAS f32x4*)(C.out + (size_t)mm[u] * D) + lane)[64 * jj] = v; }
                    else { ss += (v.x * v.x + v.y * v.y) + (v.z * v.z + v.w * v.w); o8[64 * jj] = (unsigned long long)pk2(v.x, v.y) | ((unsigned long long)pk2(v.z, v.w) << 32); } }
                if (!FINAL) { ss = wave_sum(ss); if (lane < 4) WSP(float, WS_SS)[(size_t)mm[u] * 4 + lane] = lane == 0 ? ss : 0.f; } }
        }
    }
}

template <class Sched> __device__ __forceinline__ const LAS float* rstd_table(Ctx& C, const Sched& S, const float* SS) {
    LAS float* tab = (LAS float*)(C.lds + 131072 + 4096);
    pg8::Unit u0, u; bool one = S.next(0, u0);
    for (int i = 1; one && S.next(i, u); ++i) one = (u.pm == u0.pm);
    __syncthreads();
    if (one && C.tid < 256) tab[C.tid] = pg8::row_rstd16(SS, u0.pm * 256 + C.tid);
    __syncthreads();
    return one ? tab : nullptr;
}
typedef short v4i16_t __attribute__((ext_vector_type(4)));
typedef const LAS unsigned char* ldsc;
__device__ __forceinline__ bf16x8 frag_rows(ldsc base, int ld, int row0, int kbyte0, int i, int g) { return *(const LAS bf16x8*)(base + (row0 + i) * ld + kbyte0 + 16 * g); }
__device__ __forceinline__ bf16x8 frag_tr(ldsc base, int ld, int k0, int nbyte0, int i, int g, bool perm) {
    const int q = i >> 2, p = i & 3;
    ldsc p1 = base + (k0 + (perm ? 4 * g : 8 * g) + q) * ld + nbyte0 + 8 * p; ldsc p2 = p1 + (perm ? 16 : 4) * ld;
    const v4i16_t a = __builtin_amdgcn_ds_read_tr16_b64_v4i16((LAS v4i16_t*)p1), b = __builtin_amdgcn_ds_read_tr16_b64_v4i16((LAS v4i16_t*)p2);
    return (bf16x8){a[0], a[1], a[2], a[3], b[0], b[1], b[2], b[3]};
}
__device__ __forceinline__ unsigned cvtpk(float lo, float hi) { unsigned r; asm volatile("v_cvt_pk_bf16_f32 %0, %1, %2" : "=v"(r) : "v"(lo), "v"(hi)); return r; }
__device__ __forceinline__ bf16x8 pack_acc2(const f32x4& t0, const f32x4& t1) {
    v4u w; w.x = cvtpk(t0[0], t0[1]); w.y = cvtpk(t0[2], t0[3]); w.z = cvtpk(t1[0], t1[1]); w.w = cvtpk(t1[2], t1[3]); return __builtin_bit_cast(bf16x8, w);
}
#define MFMA16(a, b, c) __builtin_amdgcn_mfma_f32_16x16x32_bf16(a, b, c, 0, 0, 0)
__device__ __forceinline__ void st8_lds(LAS unsigned char* p, const float (&f)[8]) { v4u w; w.x = cvtpk(f[0], f[1]); w.y = cvtpk(f[2], f[3]); w.z = cvtpk(f[4], f[5]); w.w = cvtpk(f[6], f[7]); *(LAS v4u*)p = w; }

constexpr int AT_LD = 144, AT_K = 0, AT_V = 256 * AT_LD, AT_Q = 2 * 256 * AT_LD;
struct AttnKV { v4u k[4], v[4]; };
template <int QIT> struct AttnQ { v4u q[QIT][4]; };
__device__ __forceinline__ void attn_ld_kv(AttnKV& R, const bf16* Kb, long krow0, int ldk, int kcol, int vcol, bool ok, int t) {
    const int row = t >> 1, half = t & 1;
#pragma unroll
    for (int c = 0; c < 4; ++c) { if (ok) { R.k[c] = *(const GAS v4u*)(Kb + (size_t)(krow0 + row) * ldk + kcol + half * 32 + c * 8); R.v[c] = *(const GAS v4u*)(Kb + (size_t)(krow0 + row) * ldk + vcol + half * 32 + c * 8); }
        else { R.k[c] = (v4u){0u, 0u, 0u, 0u}; R.v[c] = (v4u){0u, 0u, 0u, 0u}; } }
}
template <int NQH, bool SWA>
__device__ __forceinline__ void attn_ld_q(AttnQ<(NQH * 256 + 511) / 512>& R, const bf16* P, int ldp, long tok0, int qcol, int hh, int t) {
    constexpr int QIT = (NQH * 256 + 511) / 512;
#pragma unroll
    for (int it = 0; it < QIT; ++it) { const int hr = t + 512 * it; if (hr < NQH * 256) { const int qrow = hr >> 1, qhalf = hr & 1, qh = qrow >> 7, r = qrow & 127; const int hq = SWA ? hh * 3 + qh : hh;
#pragma unroll
        for (int c = 0; c < 4; ++c) R.q[it][c] = *(const GAS v4u*)(P + (size_t)(tok0 + r) * ldp + qcol + hq * 64 + qhalf * 32 + c * 8); } }
}
__device__ __forceinline__ void attn_st_kv(const AttnKV& R, LAS unsigned char* L, const float (&kg)[32], int t) {
    const int row = t >> 1, half = t & 1; float ss = 0.f; float kf[4][8];
#pragma unroll
    for (int c = 0; c < 4; ++c) { const v4u w4 = R.k[c]; kf[c][0] = bflo(w4.x); kf[c][1] = bfhi(w4.x); kf[c][2] = bflo(w4.y); kf[c][3] = bfhi(w4.y); kf[c][4] = bflo(w4.z); kf[c][5] = bfhi(w4.z); kf[c][6] = bflo(w4.w); kf[c][7] = bfhi(w4.w);
#pragma unroll
        for (int j = 0; j < 8; ++j) ss += kf[c][j] * kf[c][j]; }
    ss += __shfl_xor(ss, 1);
    const float rs = __builtin_amdgcn_rsqf(ss * (1.0f / 64.0f) + 1e-6f);
#pragma unroll
    for (int c = 0; c < 4; ++c) {
#pragma unroll
        for (int j = 0; j < 8; ++j) kf[c][j] = kf[c][j] * rs * kg[c * 8 + j];
        st8_lds(L + AT_K + row * AT_LD + half * 64 + c * 16, kf[c]); *(LAS v4u*)(L + AT_V + row * AT_LD + half * 64 + c * 16) = R.v[c]; }
}
template <int NQH>
__device__ __forceinline__ void attn_st_q(const AttnQ<(NQH * 256 + 511) / 512>& R, LAS unsigned char* L, const float (&qg)[32], int t) {
    constexpr int QIT = (NQH * 256 + 511) / 512;
#pragma unroll
    for (int it = 0; it < QIT; ++it) { const int hr = t + 512 * it; if (hr < NQH * 256) { const int qrow = hr >> 1, qhalf = hr & 1;
        float ss = 0.f; float qf[4][8];
#pragma unroll
        for (int c = 0; c < 4; ++c) { const v4u w4 = R.q[it][c]; qf[c][0] = bflo(w4.x); qf[c][1] = bfhi(w4.x); qf[c][2] = bflo(w4.y); qf[c][3] = bfhi(w4.y); qf[c][4] = bflo(w4.z); qf[c][5] = bfhi(w4.z); qf[c][6] = bflo(w4.w); qf[c][7] = bfhi(w4.w);
#pragma unroll
            for (int j = 0; j < 8; ++j) ss += qf[c][j] * qf[c][j]; }
        ss += __shfl_xor(ss, 1);
        const float rs = 0.18033688011112042f * __builtin_amdgcn_rsqf(ss * (1.0f / 64.0f) + 1e-6f);
#pragma unroll
        for (int c = 0; c < 4; ++c) {
#pragma unroll
            for (int j = 0; j < 8; ++j) qf[c][j] = qf[c][j] * rs * qg[c * 8 + j];
            st8_lds(L + AT_Q + qrow * AT_LD + qhalf * 64 + c * 16, qf[c]); } } }
}
template <bool SWA>
__device__ __forceinline__ void attn_compute(Ctx& C, int hh, long tok0, bool prev_valid, const float* sink, bf16* MIX) {
    LAS unsigned char* L = C.lds + RING_OFF;
    const int lane = C.lane, w = C.wave, i = lane & 15, g = lane >> 4;
    constexpr int NQH = SWA ? 3 : 1, NT = SWA ? 10 : 16;
    const int t0 = SWA ? w : 0;
#pragma unroll 1
    for (int qh = 0; qh < NQH; ++qh) {
        const int hq = SWA ? hh * 3 + qh : hh;
        const bf16x8 q0 = frag_rows(L + AT_Q, AT_LD, qh * 128 + 16 * w, 0, i, g), q1 = frag_rows(L + AT_Q, AT_LD, qh * 128 + 16 * w, 64, i, g);
        const float slope = SWA ? exp2f(-8.0f * (float)(hq + 1) / 12.0f) * 1.4426950408889634f : 0.f;
        const float sg = slope * (float)(4 * g);
        f32x4 s[NT];
#pragma unroll
        for (int tt = 0; tt < NT; ++tt) { const int kt = (t0 + tt) > 15 ? 15 : (t0 + tt);
            s[tt] = (f32x4){0.f, 0.f, 0.f, 0.f};
            if (SWA && tt == NT - 1) continue;
            s[tt] = MFMA16(frag_rows(L + AT_K, AT_LD, 16 * kt, 0, i, g), q0, ((f32x4){sg, sg, sg, sg}));
            s[tt] = MFMA16(frag_rows(L + AT_K, AT_LD, 16 * kt, 64, i, g), q1, s[tt]); }
        const int dq = i - 4 * g;
        const float sk = SWA ? fmaf(slope, (float)(128 + i), sink[hq] * 1.4426950408889634f) : 0.f;
        float mx = SWA ? sk : -1e30f;
        constexpr int NTV = SWA ? NT - 1 : NT;
        if (SWA) {
#pragma unroll
            for (int tt = 0; tt < NTV; ++tt)
#pragma unroll
                for (int r = 0; r < 4; ++r) { const float b = fmaf(slope, (float)(16 * tt + r), s[tt][r]);
                    s[tt][r] = (tt == 0) ? (r > dq ? b : -1e30f) : (tt == NTV - 1) ? (r <= dq ? b : -1e30f) : b; }
            if (!prev_valid) {
#pragma unroll
                for (int tt = 0; tt < NTV; ++tt)
#pragma unroll
                    for (int r = 0; r < 4; ++r) { if (16 * (t0 + tt) + 4 * g + r < 128) s[tt][r] = -1e30f; } }
        }
#pragma unroll
        for (int tt = 0; tt < NTV; ++tt) mx = fmaxf(mx, fmaxf(fmaxf(s[tt][0], s[tt][1]), fmaxf(s[tt][2], s[tt][3])));
        mx = fmaxf(mx, __shfl_xor(mx, 16)); mx = fmaxf(mx, __shfl_xor(mx, 32));
        typedef float f32x2_t __attribute__((ext_vector_type(2)));
        f32x2_t l2 = (f32x2_t){0.f, 0.f};
#pragma unroll
        for (int tt = 0; tt < NTV; ++tt) {
#pragma unroll
            for (int r = 0; r < 4; ++r) s[tt][r] = __builtin_amdgcn_exp2f(s[tt][r] - mx);
            l2 += (f32x2_t){s[tt][0], s[tt][1]}; l2 += (f32x2_t){s[tt][2], s[tt][3]}; }
        float l = l2.x + l2.y;
        l += __shfl_xor(l, 16); l += __shfl_xor(l, 32);
        if (SWA) l += __builtin_amdgcn_exp2f(sk - mx);
        const float inv = __builtin_amdgcn_rcpf(l);
        f32x4 o[4];
#pragma unroll
        for (int dv = 0; dv < 4; ++dv) o[dv] = (f32x4){0.f, 0.f, 0.f, 0.f};
#pragma unroll
        for (int pr = 0; pr < NT / 2; ++pr) {
            const bf16x8 pb = pack_acc2(s[2 * pr], s[2 * pr + 1]);
            const int k0 = 16 * (t0 + 2 * pr);
#pragma unroll
            for (int dv = 0; dv < 4; ++dv) o[dv] = MFMA16(frag_tr(L + AT_V, AT_LD, k0, 32 * dv, i, g, true), pb, o[dv]);
        }
        bf16* op = MIX + (size_t)(tok0 + 16 * w + i) * D + (SWA ? hq * 64 : 768 + hq * 64) + 4 * g;
#pragma unroll
        for (int dv = 0; dv < 4; ++dv) { v2u wv; wv.x = cvtpk(o[dv][0] * inv, o[dv][1] * inv); wv.y = cvtpk(o[dv][2] * inv, o[dv][3] * inv); *(GAS v2u*)(op + 16 * dv) = wv; }
    }
}

__device__ __forceinline__ void attn_swa_unit(Ctx& C, int unit, const bf16* P, int ldp, const float* qgain, const float* kgain, const float* sink, int kcol0, int vcol0, bf16* MIX) {
    LAS unsigned char* L = C.lds + RING_OFF; const int t = C.tid;
    const int hh = unit & 3, blk = (unit >> 2) & 63, b = unit >> 8; const long krow0 = (long)b * SEQ + (long)blk * 128 - 128, tok0 = (long)b * SEQ + (long)blk * 128; const bool prev_valid = blk > 0;
    AttnKV rkv; AttnQ<2> rq; float kg[32], qg[32];
#pragma unroll
    for (int q = 0; q < 32; ++q) { kg[q] = kgain[(t & 1) * 32 + q]; qg[q] = qgain[(t & 1) * 32 + q]; }
    attn_ld_kv(rkv, P, krow0, ldp, kcol0 + hh * 64, vcol0 + hh * 64, prev_valid || (t >> 1) >= 128, t);
    attn_ld_q<3, true>(rq, P, ldp, tok0, 0, hh, t);
    __syncthreads();
    attn_st_kv(rkv, L, kg, t); attn_st_q<3>(rq, L, qg, t);
    __syncthreads();
    attn_compute<true>(C, hh, tok0, prev_valid, sink, MIX);
}
__device__ __forceinline__ void attn_mem_pair(Ctx& C, int pair, const bf16* P, int ldp, const float* qgain, const float* kgain, int layer, bf16* MIX) {
    LAS unsigned char* L = C.lds + RING_OFF; const int t = C.tid;
    const int hh = pair & 3, bp = (pair >> 2) & 31, b = pair >> 7; const long tok0 = (long)b * SEQ + (long)bp * 256; const int qcol = ldp - 256;
    AttnKV rkv; AttnQ<1> rq; float kg[32], qg[32];
#pragma unroll
    for (int q = 0; q < 32; ++q) { kg[q] = kgain[(t & 1) * 32 + q]; qg[q] = qgain[(t & 1) * 32 + q]; }
    attn_ld_kv(rkv, WSP(bf16, WS_MKV), (long)b * MEMT, 2048, layer * 512 + hh * 64, layer * 512 + 256 + hh * 64, true, t);
    attn_ld_q<1, false>(rq, P, ldp, tok0, qcol, hh, t);
    __syncthreads();
    attn_st_kv(rkv, L, kg, t); attn_st_q<1>(rq, L, qg, t);
    __syncthreads();
    attn_ld_q<1, false>(rq, P, ldp, tok0 + 128, qcol, hh, t);
    attn_compute<false>(C, hh, tok0, true, nullptr, MIX);
    __syncthreads();
    attn_st_q<1>(rq, L, qg, t);
    __syncthreads();
    attn_compute<false>(C, hh, tok0 + 128, true, nullptr, MIX);
}

template <int MODE> struct CMT;
template <> struct CMT<0> { static constexpr int DK = 64, DV = 128, NH = 6, LDP = N_RET; };
template <> struct CMT<1> { static constexpr int DK = 96, DV = 192, NH = 4, LDP = N_MLS; };
template <int MODE> struct CML {
    static constexpr int DK = CMT<MODE>::DK, DV = CMT<MODE>::DV, LDQK = DK * 2 + 16, LDV = DV * 2 + 16;
    static constexpr int Q = 0, K = 128 * LDQK, V = 2 * 128 * LDQK, S = V + 128 * LDV, AUX = S + DK * LDV;
    static_assert(AUX + 832 * 4 <= RING_BYTES, "chunk mixer LDS");
};
constexpr size_t RT_NLOC = 1536 * KiB, RT_NIN = 1792 * KiB, RT_CHG = 2048 * KiB, RT_CHA = 2052 * KiB, RT_MIN = 2056 * KiB;
constexpr size_t SCR2_STATE = 24 * MiB;

template <int NROWS, int NCOLS> struct StageRegs { static constexpr int CPR = NCOLS / 8, TOTAL = NROWS * CPR, ITER = (TOTAL + 511) / 512; v4u r[ITER]; };
template <int NROWS, int NCOLS>
__device__ __forceinline__ void stage_ld(StageRegs<NROWS, NCOLS>& R, const bf16* src, size_t lds_src, int t) {
    typedef StageRegs<NROWS, NCOLS> SR;
#pragma unroll
    for (int it = 0; it < SR::ITER; ++it) { const int e = t + 512 * it; if (e < SR::TOTAL) { const int row = e / SR::CPR, c = e % SR::CPR; R.r[it] = *(const GAS v4u*)(src + (size_t)row * lds_src + c * 8); } }
}
template <int NROWS, int NCOLS, bool SCALE>
__device__ __forceinline__ void stage_st(const StageRegs<NROWS, NCOLS>& R, LAS unsigned char* dst, int ldd, const LAS float* rsc, float cs, int t) {
    typedef StageRegs<NROWS, NCOLS> SR;
#pragma unroll
    for (int it = 0; it < SR::ITER; ++it) { const int e = t + 512 * it; if (e < SR::TOTAL) { const int row = e / SR::CPR, c = e % SR::CPR;
        if (!SCALE) { *(LAS v4u*)(dst + row * ldd + c * 16) = R.r[it]; }
        else { const v4u w = R.r[it]; float f[8] = {bflo(w.x), bfhi(w.x), bflo(w.y), bfhi(w.y), bflo(w.z), bfhi(w.z), bflo(w.w), bfhi(w.w)}; const float sc = cs * (rsc ? rsc[row] : 1.0f);
#pragma unroll
            for (int j = 0; j < 8; ++j) f[j] *= sc;
            st8_lds(dst + row * ldd + c * 16, f); } } }
}
__device__ __forceinline__ void mls_chunk_scans(Ctx& C, float* aux, size_t row0, int h, float& btot, float& cmax) {
    const float* GT = WSP(float, WS_ROUTE + RT_GATES); const float ib = C.in[17][h], fb = C.in[18][h]; const int l = C.lane;
    float li0 = GT[(row0 + 2 * l) * 8 + h] + ib, li1 = GT[(row0 + 2 * l + 1) * 8 + h] + ib;
    float x0 = GT[(row0 + 2 * l) * 8 + 4 + h] + fb, x1 = GT[(row0 + 2 * l + 1) * 8 + 4 + h] + fb;
    x0 = fminf(x0, 0.f) - log1pf(__expf(-fabsf(x0))); x1 = fminf(x1, 0.f) - log1pf(__expf(-fabsf(x1)));
    const float s = x0 + x1; float inc = s;
#pragma unroll
    for (int d = 1; d < 64; d <<= 1) { const float v = __shfl_up(inc, d); if (l >= d) inc += v; }
    const float b0 = inc - s + x0, b1 = inc; const float c0 = li0 - b0, c1 = li1 - b1;
    float pm = fmaxf(c0, c1);
#pragma unroll
    for (int d = 1; d < 64; d <<= 1) { const float v = __shfl_up(pm, d); if (l >= d) pm = fmaxf(pm, v); }
    const float pmprev = __shfl_up(pm, 1); const float m0 = (l == 0) ? c0 : fmaxf(pmprev, c0);
    aux[2 * l] = b0; aux[2 * l + 1] = b1; aux[128 + 2 * l] = c0; aux[128 + 2 * l + 1] = c1; aux[256 + 2 * l] = m0; aux[256 + 2 * l + 1] = pm;
    const float cm = __shfl(pm, 63); aux[384 + 2 * l] = __expf(c0 - cm); aux[384 + 2 * l + 1] = __expf(c1 - cm);
    btot = __shfl(b1, 63); cmax = cm;
}
__device__ __forceinline__ void mls_aux(Ctx& C) {
    float* AUXG = WSP(float, WS_ROUTE + RT_AUXG);
    for (int unit = C.gw; unit < 512; unit += C.NGW) { const int bh = unit >> 6, c = unit & 63, b = bh >> 2, h = bh & 3; const size_t row0 = (size_t)b * SEQ + (size_t)c * 128;
        float* aux = AUXG + (size_t)unit * 512; float b127, cm; mls_chunk_scans(C, aux, row0, h, b127, cm);
        if (C.lane == 63) { WSP(float, WS_ROUTE + RT_CHG)[unit] = b127; WSP(float, WS_ROUTE + RT_CHA)[unit] = b127 + cm; } }
}
template <int MODE>
__device__ __forceinline__ void chunk_state_unit(Ctx& C, int unit, const bf16* P, const bf16* QKC, float* U) {
    typedef CML<MODE> Lm; constexpr int DK = Lm::DK, DV = Lm::DV, NH = CMT<MODE>::NH, LDP = CMT<MODE>::LDP, ND = DK / 16, NV = DV / 16, TPW = ND * NV / 8;
    LAS unsigned char* L = C.lds + RING_OFF; LAS float* aux = (LAS float*)(L + Lm::AUX);
    const int bh = unit >> 6, c = unit & 63, b = bh / NH, h = bh % NH, t = C.tid, i = C.lane & 15, g = C.lane >> 4, w = C.wave;
    const size_t row0 = (size_t)b * SEQ + (size_t)c * 128;
    StageRegs<128, DK> rK; StageRegs<128, DV> rV;
    stage_ld<128, DK>(rK, MODE == 0 ? P + row0 * LDP + 384 + h * 64 : QKC + row0 * 768 + 384 + h * 96, MODE == 0 ? LDP : 768, t);
    stage_ld<128, DV>(rV, P + row0 * LDP + 768 + h * DV, LDP, t);
    float wsc = 0.f; if (MODE == 1 && t < 128) wsc = WSP(float, WS_ROUTE + RT_AUXG)[(size_t)unit * 512 + 384 + t];
    __syncthreads();
    if (MODE == 0) { if (t < 128) { const float l2g = log2f(1.0f - exp2f(-5.0f - (float)h)); aux[384 + t] = 0.125f * exp2f((float)(127 - t) * l2g); } }
    else { if (t < 128) aux[384 + t] = wsc; }
    __syncthreads();
    stage_st<128, DK, true>(rK, L + Lm::K, Lm::LDQK, aux + 384, 1.0f, t);
    stage_st<128, DV, false>(rV, L + Lm::V, Lm::LDV, nullptr, 1.0f, t);
    __syncthreads();
#pragma unroll 1
    for (int n = 0; n < TPW; ++n) { const int id = w * TPW + n, dt = id / NV, vt = id % NV;
        f32x4 acc = (f32x4){0.f, 0.f, 0.f, 0.f};
#pragma unroll
        for (int ks = 0; ks < 4; ++ks) acc = MFMA16(frag_tr(L + Lm::K, Lm::LDQK, 32 * ks, 32 * dt, i, g, false), frag_tr(L + Lm::V, Lm::LDV, 32 * ks, 32 * vt, i, g, false), acc);
        float* up = U + (size_t)unit * DK * DV + (size_t)(16 * dt + 4 * g) * DV + 16 * vt + i;
#pragma unroll
        for (int r = 0; r < 4; ++r) up[r * DV] = acc[r]; }
    if (MODE == 1 && t < 4 * DK) { const int dcol = t >> 2, part = t & 3; float s0 = 0.f, s1 = 0.f;
#pragma unroll 8
        for (int j = 0; j < 32; j += 2) { s0 += bflo((unsigned)*(const LAS unsigned short*)(L + Lm::K + (part * 32 + j) * Lm::LDQK + 2 * dcol)); s1 += bflo((unsigned)*(const LAS unsigned short*)(L + Lm::K + (part * 32 + j + 1) * Lm::LDQK + 2 * dcol)); }
        float s = s0 + s1; s += __shfl_xor(s, 1); s += __shfl_xor(s, 2);
        if (part == 0) WSP(float, WS_ROUTE + RT_NLOC)[(size_t)unit * 96 + dcol] = s; }
}
__device__ __forceinline__ void ret_scan(Ctx& C, const float* U, bf16* SIN) {
    const int gt = C.bid * 512 + C.tid, nthr = C.G * 512;
    for (int e = gt; e < 12 * 8192; e += nthr) { const int bh = e >> 13, idx = e & 8191, h = bh % 6;
        const float gL = exp2f(128.0f * log2f(1.0f - exp2f(-5.0f - (float)h))); float S = 0.f;
        const float* up = U + (size_t)bh * 64 * 8192 + idx; bf16* sp = SIN + (size_t)bh * 64 * 8192 + idx;
        float u[64];
#pragma unroll
        for (int c = 0; c < 64; ++c) u[c] = up[(size_t)c * 8192];
#pragma unroll
        for (int c = 0; c < 64; ++c) { sp[(size_t)c * 8192] = (bf16)f2bf(S); S = gL * S + u[c]; } }
}
__device__ __forceinline__ void mls_scan(Ctx& C, const float* U, bf16* CIN) {
    constexpr int NC = 96 * 192, SEG = NC / 1024;
    typedef float f32x2 __attribute__((ext_vector_type(2)));
    const float* CHG = WSP(float, WS_ROUTE + RT_CHG); const float* CHA = WSP(float, WS_ROUTE + RT_CHA); float* MIN_ = WSP(float, WS_ROUTE + RT_MIN);
    const float* NLOC = WSP(float, WS_ROUTE + RT_NLOC); float* NIN = WSP(float, WS_ROUTE + RT_NIN);
    LAS float* sc = (LAS float*)(C.lds + RING_OFF);
    for (int task = C.bid; task < 8 * (SEG + 1); task += C.G) { const int bh = task / (SEG + 1), seg = task % (SEG + 1);
        __syncthreads();
        if (C.wave == 0) { const float gg = CHG[bh * 64 + C.lane], aa = CHA[bh * 64 + C.lane]; float m = 0.f, dmine = 0.f, wmine = 0.f, mmine = 0.f;
            for (int c = 0; c < 64; ++c) { const float g1 = __shfl(gg, c), a1 = __shfl(aa, c); const float mn = fmaxf(g1 + m, a1); const float dd = __expf(g1 + m - mn), ww = __expf(a1 - mn);
                if (C.lane == c) { dmine = dd; wmine = ww; mmine = m; } m = mn; }
            sc[C.lane] = dmine; sc[64 + C.lane] = wmine; if (seg == SEG) MIN_[bh * 64 + C.lane] = mmine; }
        __syncthreads();
        if (seg < SEG) { const int idx = seg * 1024 + 2 * C.tid; const float* src = U + (size_t)bh * 64 * NC + idx; bf16* dst = CIN + (size_t)bh * 64 * NC + idx;
            f32x2 u[64];
#pragma unroll
            for (int c = 0; c < 64; ++c) u[c] = *(const GAS f32x2*)(src + (size_t)c * NC);
            float v0 = 0.f, v1 = 0.f;
#pragma unroll
            for (int c = 0; c < 64; ++c) { *(GAS unsigned*)(dst + (size_t)c * NC) = pk2(v0, v1); const float dd = sc[c], ww = sc[64 + c]; v0 = dd * v0 + ww * u[c].x; v1 = dd * v1 + ww * u[c].y; } }
        else if (C.tid < 96) { const float* src = NLOC + (size_t)bh * 64 * 96 + C.tid; float u[64];
#pragma unroll
            for (int c = 0; c < 64; ++c) u[c] = src[(size_t)c * 96];
            float val = 0.f;
#pragma unroll
            for (int c = 0; c < 64; ++c) { NIN[(size_t)(bh * 64 + c) * 96 + C.tid] = val; val = sc[c] * val + sc[64 + c] * u[c]; } }
    }
}
template <int MODE>
__device__ __forceinline__ void chunk_out_unit(Ctx& C, int unit, const bf16* P, const bf16* QKC, const bf16* SIN, bf16* MIX) {
    typedef CML<MODE> Lm; constexpr int DK = Lm::DK, DV = Lm::DV, NH = CMT<MODE>::NH, LDP = CMT<MODE>::LDP, NV = DV / 16, NKS = DK / 32;
    LAS unsigned char* L = C.lds + RING_OFF; LAS float* aux = (LAS float*)(L + Lm::AUX);
    const int bh = unit >> 6, c = unit & 63, b = bh / NH, h = bh % NH, t = C.tid, i = C.lane & 15, g = C.lane >> 4, w = C.wave;
    const size_t row0 = (size_t)b * SEQ + (size_t)c * 128;
    StageRegs<128, DK> rQ, rK; StageRegs<128, DV> rV; StageRegs<DK, DV> rS;
    stage_ld<128, DK>(rQ, MODE == 0 ? P + row0 * LDP + h * 64 : QKC + row0 * 768 + h * 96, MODE == 0 ? LDP : 768, t);
    stage_ld<128, DK>(rK, MODE == 0 ? P + row0 * LDP + 384 + h * 64 : QKC + row0 * 768 + 384 + h * 96, MODE == 0 ? LDP : 768, t);
    stage_ld<128, DV>(rV, P + row0 * LDP + 768 + h * DV, LDP, t);
    stage_ld<DK, DV>(rS, SIN + (size_t)unit * DK * DV, DV, t);
    float auxv = 0.f; if (MODE == 1) { if (t < 384) auxv = WSP(float, WS_ROUTE + RT_AUXG)[(size_t)unit * 512 + t]; else if (t < 384 + 96) auxv = WSP(float, WS_ROUTE + RT_NIN)[(size_t)unit * 96 + t - 384]; }
    f32x4 gnv = (f32x4){0.f, 0.f, 0.f, 0.f}; if (MODE == 1 && t < 48) gnv = *(const GAS f32x4*)(C.in[19] + h * DV + 4 * t);
    __syncthreads();
    if (MODE == 1) { if (t < 384) aux[t] = auxv; else if (t < 384 + 96) aux[512 + t - 384] = auxv; if (t < 48) *(LAS f32x4*)(aux + 640 + 4 * t) = gnv; }
    stage_st<128, DK, false>(rQ, L + Lm::Q, Lm::LDQK, nullptr, 1.0f, t);
    if (MODE == 0) stage_st<128, DK, true>(rK, L + Lm::K, Lm::LDQK, nullptr, 0.125f, t); else stage_st<128, DK, false>(rK, L + Lm::K, Lm::LDQK, nullptr, 1.0f, t);
    stage_st<128, DV, false>(rV, L + Lm::V, Lm::LDV, nullptr, 1.0f, t);
    stage_st<DK, DV, false>(rS, L + Lm::S, Lm::LDV, nullptr, 1.0f, t);
    __syncthreads();
    const int qt = w < 4 ? w : 11 - w;
    const int iq = 16 * qt + i;
    v2u gwv[NV];
    { const bf16* gp0 = P + (row0 + iq) * LDP + 1536 + h * DV + 4 * g;
#pragma unroll
      for (int vt = 0; vt < NV; ++vt) gwv[vt] = *(const GAS v2u*)(gp0 + 16 * vt); }
    float m_in_early = 0.f; if (MODE == 1) m_in_early = WSP(float, WS_ROUTE + RT_MIN)[unit];
    bf16x8 qf[NKS];
#pragma unroll
    for (int s = 0; s < NKS; ++s) qf[s] = frag_rows(L + Lm::Q, Lm::LDQK, 16 * qt, 64 * s, i, g);
    f32x4 o[NV];
#pragma unroll
    for (int vt = 0; vt < NV; ++vt) { o[vt] = (f32x4){0.f, 0.f, 0.f, 0.f};
#pragma unroll
        for (int s = 0; s < NKS; ++s) o[vt] = MFMA16(frag_tr(L + Lm::S, Lm::LDV, 32 * s, 32 * vt, i, g, false), qf[s], o[vt]); }
    float colscale, ri = 0.f, emi = 1.f, den = 0.f;
    const float l2g = MODE == 0 ? log2f(1.0f - exp2f(-5.0f - (float)h)) : 0.f;
    if (MODE == 0) colscale = exp2f((float)(iq + 1) * l2g);
    else { const float m_in = m_in_early; const float bi = aux[iq], mxc = fmaxf(m_in, aux[256 + iq]);
        ri = -mxc; colscale = __expf(m_in - mxc); emi = __expf(-(bi + mxc));
        float nq = 0.f;
#pragma unroll
        for (int s = 0; s < NKS; ++s) { const v4u qw = __builtin_bit_cast(v4u, qf[s]); const f32x4 n0 = *(const LAS f32x4*)(aux + 512 + 32 * s + 8 * g), n1 = *(const LAS f32x4*)(aux + 512 + 32 * s + 8 * g + 4);
            nq += bflo(qw.x) * n0[0] + bfhi(qw.x) * n0[1] + bflo(qw.y) * n0[2] + bfhi(qw.y) * n0[3] + bflo(qw.z) * n1[0] + bfhi(qw.z) * n1[1] + bflo(qw.w) * n1[2] + bfhi(qw.w) * n1[3]; }
        nq += __shfl_xor(nq, 16); nq += __shfl_xor(nq, 32);
        den = colscale * nq; }
#pragma unroll
    for (int vt = 0; vt < NV; ++vt) o[vt] = o[vt] * colscale;
    float dsum = 0.f;
#pragma unroll
    for (int pr = 0; pr < 4; ++pr) {
        if (2 * pr <= qt) {
            f32x4 st[2];
#pragma unroll
            for (int u = 0; u < 2; ++u) { const int tt = 2 * pr + u; st[u] = (f32x4){0.f, 0.f, 0.f, 0.f};
#pragma unroll
                for (int s = 0; s < NKS; ++s) st[u] = MFMA16(frag_rows(L + Lm::K, Lm::LDQK, 16 * tt, 64 * s, i, g), qf[s], st[u]);
                f32x4 cj; if (MODE == 1) cj = *(const LAS f32x4*)(aux + 128 + 16 * tt + 4 * g);
#pragma unroll
                for (int r = 0; r < 4; ++r) { const int j = 16 * tt + 4 * g + r; const bool valid = j <= iq;
                    const float wgt = MODE == 0 ? __builtin_amdgcn_exp2f((float)(iq - j) * l2g) : __expf(fminf(ri + cj[r], 0.f));
                    st[u][r] = valid ? st[u][r] * wgt : 0.f; dsum += st[u][r]; } }
            const bf16x8 pb = pack_acc2(st[0], st[1]);
#pragma unroll
            for (int vt = 0; vt < NV; ++vt) o[vt] = MFMA16(frag_tr(L + Lm::V, Lm::LDV, 32 * pr, 32 * vt, i, g, true), pb, o[vt]);
        }
    }
    const size_t tok = row0 + iq; float ss = 0.f;
    if (MODE == 1) { dsum += __shfl_xor(dsum, 16); dsum += __shfl_xor(dsum, 32); den += dsum; const float inv = __builtin_amdgcn_rcpf(fmaxf(fabsf(den), emi));
#pragma unroll
        for (int vt = 0; vt < NV; ++vt) o[vt] = o[vt] * inv; }
#pragma unroll
    for (int vt = 0; vt < NV; ++vt) ss += (o[vt][0] * o[vt][0] + o[vt][1] * o[vt][1]) + (o[vt][2] * o[vt][2] + o[vt][3] * o[vt][3]);
    ss += __shfl_xor(ss, 16); ss += __shfl_xor(ss, 32);
    const float rs = __builtin_amdgcn_rsqf(ss * (1.0f / DV) + 1e-6f);
    bf16* op = MIX + tok * D + h * DV + 4 * g;
#pragma unroll
    for (int vt = 0; vt < NV; ++vt) { const v2u gw = gwv[vt]; float gv[4] = {bflo(gw.x), bfhi(gw.x), bflo(gw.y), bfhi(gw.y)}; float r4[4];
        if (MODE == 0) {
#pragma unroll
            for (int r = 0; r < 4; ++r) r4[r] = silu1(gv[r]) * o[vt][r] * rs; }
        else { const f32x4 gn = *(const LAS f32x4*)(aux + 640 + 16 * vt + 4 * g);
#pragma unroll
            for (int r = 0; r < 4; ++r) r4[r] = sigmoid1(gv[r]) * o[vt][r] * rs * gn[r]; }
        v2u wv; wv.x = cvtpk(r4[0], r4[1]); wv.y = cvtpk(r4[2], r4[3]); *(GAS v2u*)(op + 16 * vt) = wv; }
}

struct Args { const float* in[27]; float* out; unsigned char* ws; int ph_lo, ph_hi; };
static_assert(sizeof(Args) == 27 * 8 + 8 + 8 + 8, "Args has no padding");

#define GEMM_CALL(EpiT, SchedT, g, S, E) pg8::gemm_phase<EpiT, SchedT, true, true>(C.lds + RING_OFF, g, S, E)

__global__ void __launch_bounds__(NWAVES * 64, 2) trunk_fwd(Args args) {
    extern __shared__ __attribute__((aligned(16))) unsigned char lds_raw[];
    Ctx C;
    C.lds = (LAS unsigned char*)lds_raw;
    C.tid = threadIdx.x; C.lane = C.tid & 63; C.wave = __builtin_amdgcn_readfirstlane(C.tid >> 6);
    C.G = gridDim.x; C.bid = blockIdx.x; C.gw = C.bid * NWAVES + C.wave; C.NGW = C.G * NWAVES;
#pragma unroll
    for (int i = 0; i < 27; ++i) C.in[i] = args.in[i];
    C.out = args.out; C.ws = args.ws; C.pacc = 0ull; C.pt0 = 0ull;
    volatile LAS unsigned* MISC = (volatile LAS unsigned*)(C.lds + MISC_OFF);
    for (int u = C.tid; u < (LDS_BYTES - LDSCTL_OFF) / 4; u += NWAVES * 64) ((LAS unsigned*)(C.lds + LDSCTL_OFF))[u] = 0u;
    __syncthreads();
    XcdBarrier bar; bar.bar = (unsigned*)(C.ws + WS_CTL) + CW_BAR; bar.x = 0; bar.st = nullptr;
    if (MK_SINGLE) bar = xcd_barrier_post((unsigned*)(C.ws + WS_CTL) + CW_BAR, MISC + 8);
    const int lo = args.ph_lo, hi = args.ph_hi;
#define IN(k) (lo <= (k) && (k) < hi)
#define DBL(k) (((DBL_MASK >> (k)) & 1ull) != 0ull)
#define SEAM(k) do { if (MK_SINGLE && IN((k) + 1)) xcd_barrier(bar); } while (0)
#define PH(k, ...) if (IN(k)) { if ((PROF_MASK >> (k)) & 1ull) C.pt0 = rt(); __VA_ARGS__ if (DBL(k)) { for (int rep_ = 0; rep_ < DBL_REPS; ++rep_) { if (MK_SINGLE) xcd_barrier(bar); __VA_ARGS__ } } if ((PROF_MASK >> (k)) & 1ull) C.pacc += rt() - C.pt0; }

    bf16* HB = WSP(bf16, WS_HB); float* SS = WSP(float, WS_SS); bf16* Pb = WSP(bf16, WS_BIG + BIG_P); bf16* MIX = WSP(bf16, WS_BIG + BIG_MIX);
    float* SCR1 = WSP(float, WS_BIG + BIG_SCR1); bf16* QKC = WSP(bf16, WS_BIG + BIG_SCR2); bf16* SIN = WSP(bf16, WS_BIG + BIG_SCR2 + SCR2_STATE); bf16* HID = WSP(bf16, WS_BIG);
    const int* PANEL = WSP(int, WS_ROUTE + RT_PANEL); const int* NPp = WSP(int, WS_ROUTE + RT_NP); const float* SLOTRS = WSP(float, WS_ROUTE + RT_SLOTRS);

#define G_INPROJ(layer, NN) { pg8::Gemm g{HB, WSP(bf16, WS_WIN + WIN_OFF[layer]), M, NN, D}; pg8::StaticOrder S; S.init(M, NN, C.G, C.bid); \
        pg8::EpiScaleBf16 E{Pb, NN, SS, (const PG8_LAS float*)(C.lds + 131072)}; GEMM_CALL(pg8::EpiScaleBf16, pg8::StaticOrder, g, S, E); }
#define G_OUTPROJ(layer) { pg8::Gemm g{MIX, WSP(bf16, WS_WOUT + (size_t)(layer) * 2 * MiB), M, D, D}; pg8::StaticOrder S; S.init(M, D, C.G, C.bid); \
        pg8::EpiResid E{HB, SS, (PG8_LAS float*)(C.lds + 131072)}; GEMM_CALL(pg8::EpiResid, pg8::StaticOrder, g, S, E); }
#define G_GATEUP_DENSE(j) { pg8::Gemm g{HB, WSP(bf16, WS_WFD + (j) * FD_STRIDE), M, 2 * FF, D}; pg8::StaticOrder S; S.init(M, 2 * FF, C.G, C.bid); \
        pg8::EpiSwiglu<false> E{HID, SS, (const PG8_LAS float*)(C.lds + 131072)}; GEMM_CALL(pg8::EpiSwiglu<false>, pg8::StaticOrder, g, S, E); }
#define G_DOWN_DENSE(j) { pg8::Gemm g{HID, WSP(bf16, WS_WFD + (j) * FD_STRIDE + FD_WD), M, D, FF}; pg8::StaticOrder S; S.init(M, D, C.G, C.bid); \
        pg8::EpiResid E{HB, SS, (PG8_LAS float*)(C.lds + 131072)}; GEMM_CALL(pg8::EpiResid, pg8::StaticOrder, g, S, E); }
#define G_GATEUP_MOE(j) { pg8::Gemm g{HB, WSP(bf16, WS_WMOE + (j) * MOE_STRIDE), MAXSLOT, NE * 2 * FF, D, WSP(int, WS_ROUTE + RT_ROWTOK)}; pg8::MoeOrder S; S.init(NPp, PANEL, 28, C.G, C.bid); \
        pg8::EpiSwiglu<true> E{HID, SLOTRS, (const PG8_LAS float*)(C.lds + 131072 + 4096)}; pg8::gemm_phase<pg8::EpiSwiglu<true>, pg8::MoeOrder, true, true, true>(C.lds + RING_OFF, g, S, E); }
#define G_DOWN_MOE(j) { pg8::Gemm g{HID, WSP(bf16, WS_WMOE + (j) * MOE_STRIDE + MOE_WD), MAXSLOT, NE * D, FF}; pg8::MoeOrder S; S.init(NPp, PANEL, 4, C.G, C.bid); \
        if (C.G == 256) S.max_rounds = 2; pg8::EpiYBf16 E{WSP(bf16, WS_Y)}; GEMM_CALL(pg8::EpiYBf16, pg8::MoeOrder, g, S, E); } \
    if (C.G == 256) { const int tail = C.bid / 7, ks = C.bid % 7; \
        pg8::Gemm g{HID + ks * 512, WSP(bf16, WS_WMOE + (j) * MOE_STRIDE + MOE_WD) + ks * 512, MAXSLOT, NE * D, 512, nullptr, FF}; \
        pg8::MoeOrder S; S.init(NPp, PANEL, 4, C.G, tail); S.first_round = 2; S.max_rounds = (C.bid < 224) ? 3 : 0; \
        pg8::EpiSlab E{WSP(float, WS_SLAB), WSP(int, WS_ROUTE + RT_TAILIDX), tail, ks}; GEMM_CALL(pg8::EpiSlab, pg8::MoeOrder, g, S, E); }
#define G_MEMKV() { pg8::Gemm g{WSP(bf16, WS_MEMN), WSP(bf16, WS_WMEM), MROWS, 2048, D}; pg8::StaticOrder S; S.init(MROWS, 2048, C.G, (C.bid + 16) % C.G); \
        pg8::EpiPlainBf16 E{WSP(bf16, WS_MKV), 2048}; GEMM_CALL(pg8::EpiPlainBf16, pg8::StaticOrder, g, S, E); }
#define MEMATTN(layer, NN) { TB(102); for (int u = C.bid; u < 256; u += C.G) attn_mem_pair(C, u, Pb, NN, C.in[5] + (layer) * 64, C.in[6] + (layer) * 64, layer, MIX); TE(102); }
#define FFN_DENSE(k, j) PH(k, G_GATEUP_DENSE(j) SEAM(k);) PH((k) + 1, G_DOWN_DENSE(j) SEAM((k) + 1);)
#define FFN_MOE(k, j, layer) PH(k, moe_route1(C, j, layer); SEAM(k);) PH((k) + 1, moe_route2(C); SEAM((k) + 1);) PH((k) + 2, G_GATEUP_MOE(j) SEAM((k) + 2);) \
        PH((k) + 3, G_DOWN_MOE(j) SEAM((k) + 3);) PH((k) + 4, moe_combine<(layer) == 3>(C); SEAM((k) + 4);)

    PH(0, p_prologue(C); SEAM(0);)
    PH(1, G_MEMKV() G_INPROJ(0, N_SWA) SEAM(1);)
    PH(2, for (int u = C.bid; u < 512; u += C.G) { if (u == C.bid) TB(100); else TB(101); attn_swa_unit(C, u, Pb, N_SWA, C.in[10], C.in[11], C.in[12], 768, 1024, MIX); if (u == C.bid) TE(100); else TE(101); }
          MEMATTN(0, N_SWA) SEAM(2);)
    PH(3, G_OUTPROJ(0) SEAM(3);)
    FFN_DENSE(4, 0)
#define IDLE_TP(win) if (C.G == 256 && C.bid >= 128) tp_run(C, TP_MOVED_LO + (win) * TP_WIN_N + C.bid - 128, 128, TP_MOVED_LO + ((win) + 1) * TP_WIN_N, 1 << 30, 0);
    PH(6, G_INPROJ(1, N_RET) IDLE_TP(0) SEAM(6);)
    PH(7, for (int u = C.bid; u < 768; u += C.G) chunk_state_unit<0>(C, u, Pb, nullptr, SCR1); MEMATTN(1, N_RET) SEAM(7);)
    PH(8, ret_scan(C, SCR1, SIN); SEAM(8);)
    PH(9, for (int u = C.bid; u < 768; u += C.G) { TB(121); chunk_out_unit<0>(C, u, Pb, nullptr, SIN, MIX); TE(121); } SEAM(9);)
    PH(10, G_OUTPROJ(1) SEAM(10);)
    FFN_MOE(11, 0, 1)
    PH(16, G_INPROJ(2, N_MLS) mls_gates(C); IDLE_TP(1) SEAM(16);)
    PH(17, mls_aux(C); mls_conv(C, Pb, QKC); SEAM(17);)
    PH(18, for (int u = C.bid; u < 512; u += C.G) chunk_state_unit<1>(C, u, Pb, QKC, SCR1); MEMATTN(2, N_MLS) SEAM(18);)
    PH(19, mls_scan(C, SCR1, SIN); SEAM(19);)
    PH(20, for (int u = C.bid; u < 512; u += C.G) { TB(120); chunk_out_unit<1>(C, u, Pb, QKC, SIN, MIX); TE(120); } SEAM(20);)
    PH(21, G_OUTPROJ(2) SEAM(21);)
    FFN_DENSE(22, 1)
    PH(24, G_INPROJ(3, N_SWA) IDLE_TP(2) SEAM(24);)
    PH(25, for (int u = C.bid; u < 512; u += C.G) { if (u == C.bid) TB(100); else TB(101); attn_swa_unit(C, u, Pb, N_SWA, C.in[10] + 64, C.in[11] + 64, C.in[12] + 12, 768, 1024, MIX); if (u == C.bid) TE(100); else TE(101); }
           MEMATTN(3, N_SWA) SEAM(25);)
    PH(26, G_OUTPROJ(3) SEAM(26);)
    FFN_MOE(27, 1, 3)
    if (PROF_MASK != 0ull || PROF_SEC >= 0) { const unsigned long long te_ = rt() + (unsigned long long)PROF_AMP * C.pacc; while (rt() < te_) __builtin_amdgcn_s_sleep(16); }
#undef IN
}

extern "C" void kernel_launch(void* const* d_in, const int* in_sizes, int n_in, void* d_out, int out_size, void* d_ws, size_t ws_size, hipStream_t stream) {
    static int grid = 0;
    if (grid == 0) {
        if (n_in != 27 || in_sizes[0] != M * D || out_size != M * D || ws_size < WS_END) { fprintf(stderr, "kernel_launch: unexpected shapes (n_in %d, in0 %d, out %d, ws %zu < %zu)\n", n_in, n_in > 0 ? in_sizes[0] : -1, out_size, ws_size, (size_t)WS_END); grid = -1; return; }
        int dev = 0, cus = 0, per_cu = 0;
        if (hipGetDevice(&dev) != hipSuccess || hipDeviceGetAttribute(&cus, hipDeviceAttributeMultiprocessorCount, dev) != hipSuccess) { grid = -1; return; }
        if (hipFuncSetAttribute((const void*)trunk_fwd, hipFuncAttributeMaxDynamicSharedMemorySize, LDS_BYTES) != hipSuccess) { fprintf(stderr, "kernel_launch: hipFuncSetAttribute failed\n"); grid = -1; return; }
        if (hipOccupancyMaxActiveBlocksPerMultiprocessor(&per_cu, (const void*)trunk_fwd, NWAVES * 64, LDS_BYTES) != hipSuccess || per_cu < 1) fprintf(stderr, "kernel_launch: occupancy query says %d\n", per_cu);
        (void)hipGetLastError();
        grid = cus;
    }
    if (grid < 0) return;
    if (hipMemsetAsync((char*)d_ws + WS_CTL, 0, CTL_ZERO_BYTES, stream) != hipSuccess) return;
    Args a{};
    for (int i = 0; i < 27; ++i) a.in[i] = (const float*)d_in[i];
    a.out = (float*)d_out; a.ws = (unsigned char*)d_ws;
    if (MK_SINGLE) { a.ph_lo = 0; a.ph_hi = NPHASE; hipLaunchKernelGGL(trunk_fwd, dim3(grid), dim3(NWAVES * 64), LDS_BYTES, stream, a); }
    else for (int p = 0; p < NPHASE; ++p) { a.ph_lo = p; a.ph_hi = p + 1; hipLaunchKernelGGL(trunk_fwd, dim3(grid), dim3(NWAVES * 64), LDS_BYTES, stream, a); }
}
```
